# Optimizing an MI355X kernel written in HIP

```python
import math
import jax, jax.numpy as jnp
from jax import lax
import numpy as np

D_MODEL = 2048
BATCH = 4
SEQ = 2048
DEPTH = 2
DEC_BATCH = 128
DEC_SEQ = 4
PAST_LEN = 16384
PAGE_SIZE = 128

D_MIX = 2 * D_MODEL
W_A = D_MIX // 2
S5_CH = 16
S5_GROUPS = W_A // S5_CH
S5_P = 64
W_S = D_MIX - W_A
SSD_HEADDIM = 64
SSD_HEADS = W_S // SSD_HEADDIM
SSD_GROUPS = 8
SSD_N = 128
CONV_K = 4
CONV_DIM = W_S + 2 * SSD_GROUPS * SSD_N
IN_COLS = 2 * W_A + CONV_DIM + W_S + SSD_HEADS
SSD_CHUNK = 128
EPS = 1e-5
DT_MIN = 1e-3
DT_MAX = 1e-1
LAMBDA_RE_MAX = -1e-4

kernel_name = "hymba_s5_ssd_hybrid_step"


def rmsnorm(x, w):
    xf = x.astype(jnp.float32)
    y = xf * lax.rsqrt(jnp.mean(xf * xf, axis=-1, keepdims=True) + EPS)
    return (y * w.astype(jnp.float32)).astype(x.dtype)


def s5_branch(u, h0_re, h0_im, lam_re, lam_im, log_step, b_re, b_im, c_re, c_im, d):
    f32 = jnp.float32
    bsz, L, _ = u.shape
    lr = jnp.minimum(lam_re.astype(f32), LAMBDA_RE_MAX)
    li = lam_im.astype(f32)
    step = jnp.exp(log_step.astype(f32))[:, None]
    mag = jnp.exp(lr * step)
    ab_re = mag * jnp.cos(li * step)
    ab_im = mag * jnp.sin(li * step)
    den = lr * lr + li * li
    nr = ab_re - 1.0
    g_re = (nr * lr + ab_im * li) / den
    g_im = (ab_im * lr - nr * li) / den
    br = b_re.astype(f32)
    bi = b_im.astype(f32)
    bb_re = g_re[..., None] * br - g_im[..., None] * bi
    bb_im = g_re[..., None] * bi + g_im[..., None] * br
    uf = u.astype(f32)
    ug = uf.reshape(bsz, L, S5_GROUPS, S5_CH)
    bu_re = jnp.einsum("blgc,gpc->lbgp", ug, bb_re)
    bu_im = jnp.einsum("blgc,gpc->lbgp", ug, bb_im)
    h0r = h0_re.astype(f32)
    h0i = h0_im.astype(f32)
    bu_re = bu_re.at[0].add(ab_re * h0r - ab_im * h0i)
    bu_im = bu_im.at[0].add(ab_re * h0i + ab_im * h0r)
    a_re = jnp.broadcast_to(ab_re, (L, 1, S5_GROUPS, S5_P))
    a_im = jnp.broadcast_to(ab_im, (L, 1, S5_GROUPS, S5_P))

    def combine(e1, e2):
        a1r, a1i, b1r, b1i = e1
        a2r, a2i, b2r, b2i = e2
        return (a2r * a1r - a2i * a1i,
                a2r * a1i + a2i * a1r,
                a2r * b1r - a2i * b1i + b2r,
                a2r * b1i + a2i * b1r + b2i)

    _, _, hr, hi = lax.associative_scan(combine, (a_re, a_im, bu_re, bu_im), axis=0)
    y = (jnp.einsum("lbgp,gcp->blgc", hr, c_re.astype(f32))
         - jnp.einsum("lbgp,gcp->blgc", hi, c_im.astype(f32)))
    y = y.reshape(bsz, L, W_A) + d.astype(f32) * uf
    return y.astype(u.dtype), hr[-1], hi[-1]


def causal_conv(xbc, buf, w, b):
    L = xbc.shape[1]
    xp = jnp.concatenate([buf.astype(xbc.dtype), xbc], axis=1)
    out = b
    for k in range(CONV_K):
        out = out + xp[:, k:k + L] * w[k]
    return jax.nn.silu(out), xp[:, L:]


def segsum(a):
    T = a.shape[-1]
    cs = jnp.cumsum(a, axis=-1)
    diff = cs[..., :, None] - cs[..., None, :]
    mask = jnp.tril(jnp.ones((T, T), dtype=bool))
    return jnp.where(mask, diff, -jnp.inf)


def ssd_scan(x, dt, a, bm, cm, h0):
    f32 = jnp.float32
    bsz, L = x.shape[:2]
    T = math.gcd(L, SSD_CHUNK)
    nc = L // T
    R = SSD_HEADS // SSD_GROUPS
    xd = (x.astype(f32) * dt[..., None]).reshape(bsz, nc, T, SSD_GROUPS, R, SSD_HEADDIM)
    da = (dt * a).reshape(bsz, nc, T, SSD_GROUPS, R).transpose(0, 3, 4, 1, 2)
    bc = bm.astype(f32).reshape(bsz, nc, T, SSD_GROUPS, SSD_N)
    cc = cm.astype(f32).reshape(bsz, nc, T, SSD_GROUPS, SSD_N)
    da_cs = jnp.cumsum(da, axis=-1)
    decay = jnp.exp(segsum(da))
    cb = jnp.einsum("bctgn,bcsgn->bgcts", cc, bc)
    y_diag = jnp.einsum("bgcts,bgrcts,bcsgrp->bctgrp", cb, decay, xd)
    decay_states = jnp.exp(da_cs[..., -1:] - da_cs)
    states = jnp.einsum("bctgn,bgrct,bctgrp->bcgrpn", bc, decay_states, xd)
    h0r = h0.astype(f32).reshape(bsz, 1, SSD_GROUPS, R, SSD_HEADDIM, SSD_N)
    states = jnp.concatenate([h0r, states], axis=1)
    chunk_ends = jnp.pad(da_cs[..., -1], ((0, 0), (0, 0), (0, 0), (1, 0)))
    chunk_decay = jnp.exp(segsum(chunk_ends))
    states = jnp.einsum("bgrzc,bcgrpn->bzgrpn", chunk_decay, states)
    prev_states, final = states[:, :-1], states[:, -1]
    y_off = jnp.einsum("bctgn,bcgrpn,bgrct->bctgrp", cc, prev_states, jnp.exp(da_cs))
    y = (y_diag + y_off).reshape(bsz, L, SSD_HEADS, SSD_HEADDIM)
    return y, final.reshape(bsz, SSD_HEADS, SSD_HEADDIM, SSD_N)


def mixer_layer(x, s5_h_re, s5_h_im, ssd_h, conv_buf,
                norm_w, w_in, lam_re, lam_im, log_step, b_re, b_im, c_re, c_im, s5_d,
                glu_w, glu_b, s5_norm_w, conv_w, conv_b, dt_bias, a_log, ssd_d, ssd_norm_w, w_out):
    bsz, L, _ = x.shape
    f32 = jnp.float32
    h = rmsnorm(x, norm_w)
    proj = h @ w_in
    u_a, z_a, xbc, z_s, dt_raw = jnp.split(
        proj, [W_A, 2 * W_A, 2 * W_A + CONV_DIM, 2 * W_A + CONV_DIM + W_S], axis=-1)

    y_a, s5_re, s5_im = s5_branch(u_a, s5_h_re, s5_h_im, lam_re, lam_im, log_step,
                                  b_re, b_im, c_re, c_im, s5_d)
    g = jax.nn.gelu(y_a)
    y_a = g * jax.nn.sigmoid(g @ glu_w + glu_b)
    y_a = rmsnorm(y_a * jax.nn.silu(z_a), s5_norm_w).astype(x.dtype)

    xbc, conv_new = causal_conv(xbc, conv_buf, conv_w, conv_b)
    xs, bm, cm = jnp.split(xbc, [W_S, W_S + SSD_GROUPS * SSD_N], axis=-1)
    dt = jax.nn.softplus(dt_raw.astype(f32) + dt_bias.astype(f32))
    a = -jnp.exp(a_log.astype(f32))
    xs_h = xs.reshape(bsz, L, SSD_HEADS, SSD_HEADDIM)
    y_s, ssd_new = ssd_scan(xs_h, dt, a,
                            bm.reshape(bsz, L, SSD_GROUPS, SSD_N),
                            cm.reshape(bsz, L, SSD_GROUPS, SSD_N), ssd_h)
    y_s = y_s + ssd_d.astype(f32)[:, None] * xs_h.astype(f32)
    y_s = y_s.reshape(bsz, L, W_S) * jax.nn.silu(z_s.astype(f32))
    y_s = rmsnorm(y_s, ssd_norm_w).astype(x.dtype)

    out = jnp.concatenate([y_a, y_s], axis=-1) @ w_out
    sd = s5_h_re.dtype
    return (x + out, s5_re.astype(sd), s5_im.astype(sd),
            ssd_new.astype(ssd_h.dtype), conv_new.astype(conv_buf.dtype))


def setup_inputs(seed: int = 0) -> dict:
    key = jax.random.key(seed)
    ks = iter(jax.random.split(key, 40))
    f32 = jnp.float32

    def nrm(shape, s):
        return jax.random.normal(next(ks), shape, f32) * s

    x_prompt = nrm((BATCH, SEQ, D_MODEL), 1.0)
    x_sample = nrm((DEC_BATCH, DEC_SEQ, D_MODEL), 1.0)
    state_s5_re = nrm((DEPTH, DEC_BATCH, S5_GROUPS, S5_P), 0.3)
    state_s5_im = nrm((DEPTH, DEC_BATCH, S5_GROUPS, S5_P), 0.3)
    state_ssd = nrm((DEPTH, DEC_BATCH, SSD_HEADS, SSD_HEADDIM, SSD_N), 0.3)
    cache_conv = nrm((DEPTH, DEC_BATCH, CONV_K - 1, CONV_DIM), 1.0)

    norm_w = 1.0 + nrm((DEPTH, D_MODEL), 0.02)
    w_in = nrm((DEPTH, D_MODEL, IN_COLS), D_MODEL ** -0.5)
    n_idx = jnp.arange(S5_P, dtype=f32)
    s5_lambda_re = -0.5 + nrm((DEPTH, S5_GROUPS, S5_P), 0.01)
    s5_lambda_im = math.pi * n_idx + nrm((DEPTH, S5_GROUPS, S5_P), 0.01)
    s5_log_step = jax.random.uniform(next(ks), (DEPTH, S5_GROUPS), f32,
                                     math.log(DT_MIN), math.log(DT_MAX))
    s5_b_re = nrm((DEPTH, S5_GROUPS, S5_P, S5_CH), (2 * S5_CH) ** -0.5)
    s5_b_im = nrm((DEPTH, S5_GROUPS, S5_P, S5_CH), (2 * S5_CH) ** -0.5)
    s5_c_re = nrm((DEPTH, S5_GROUPS, S5_CH, S5_P), S5_P ** -0.5)
    s5_c_im = nrm((DEPTH, S5_GROUPS, S5_CH, S5_P), S5_P ** -0.5)
    s5_d = nrm((DEPTH, W_A), 1.0)
    s5_glu_w = nrm((DEPTH, W_A, W_A), W_A ** -0.5)
    s5_glu_b = nrm((DEPTH, W_A), 0.01)
    s5_norm_w = 1.0 + nrm((DEPTH, W_A), 0.02)
    conv_w = nrm((DEPTH, CONV_K, CONV_DIM), CONV_K ** -0.5)
    conv_b = nrm((DEPTH, CONV_DIM), 0.01)
    dt0 = jnp.exp(jax.random.uniform(next(ks), (DEPTH, SSD_HEADS), f32,
                                     math.log(DT_MIN), math.log(DT_MAX)))
    dt_bias = dt0 + jnp.log(-jnp.expm1(-dt0))
    a_log = jnp.log(jax.random.uniform(next(ks), (DEPTH, SSD_HEADS), f32, 1.0, 16.0))
    ssd_d = 1.0 + nrm((DEPTH, SSD_HEADS), 0.02)
    ssd_norm_w = 1.0 + nrm((DEPTH, W_S), 0.02)
    w_out = nrm((DEPTH, D_MIX, D_MODEL), D_MIX ** -0.5)
    final_norm_w = 1.0 + nrm((D_MODEL,), 0.02)
    return {
        "x_prompt": x_prompt, "x_sample": x_sample,
        "state_s5_re": state_s5_re, "state_s5_im": state_s5_im,
        "state_ssd": state_ssd, "cache_conv": cache_conv,
        "norm_w": norm_w, "w_in": w_in,
        "s5_lambda_re": s5_lambda_re, "s5_lambda_im": s5_lambda_im,
        "s5_log_step": s5_log_step, "s5_b_re": s5_b_re, "s5_b_im": s5_b_im,
        "s5_c_re": s5_c_re, "s5_c_im": s5_c_im, "s5_d": s5_d,
        "s5_glu_w": s5_glu_w, "s5_glu_b": s5_glu_b, "s5_norm_w": s5_norm_w,
        "conv_w": conv_w, "conv_b": conv_b, "dt_bias": dt_bias, "a_log": a_log,
        "ssd_d": ssd_d, "ssd_norm_w": ssd_norm_w, "w_out": w_out,
        "final_norm_w": final_norm_w,
    }


def reference(x_prompt, x_sample, state_s5_re, state_s5_im, state_ssd, cache_conv,
              norm_w, w_in, s5_lambda_re, s5_lambda_im, s5_log_step, s5_b_re, s5_b_im,
              s5_c_re, s5_c_im, s5_d, s5_glu_w, s5_glu_b, s5_norm_w,
              conv_w, conv_b, dt_bias, a_log, ssd_d, ssd_norm_w, w_out, final_norm_w):
    bp = x_prompt.shape[0]
    dtp = x_prompt.dtype
    z_s5 = jnp.zeros((bp, S5_GROUPS, S5_P), dtp)
    z_ssd = jnp.zeros((bp, SSD_HEADS, SSD_HEADDIM, SSD_N), dtp)
    z_conv = jnp.zeros((bp, CONV_K - 1, CONV_DIM), dtp)
    hp, hs = x_prompt, x_sample
    p_re, p_im, p_ssd, p_conv = [], [], [], []
    s_re, s_im, s_ssd, s_conv = [], [], [], []
    for l in range(DEPTH):
        lw = (norm_w[l], w_in[l], s5_lambda_re[l], s5_lambda_im[l], s5_log_step[l],
              s5_b_re[l], s5_b_im[l], s5_c_re[l], s5_c_im[l], s5_d[l],
              s5_glu_w[l], s5_glu_b[l], s5_norm_w[l], conv_w[l], conv_b[l],
              dt_bias[l], a_log[l], ssd_d[l], ssd_norm_w[l], w_out[l])
        hp, a1, a2, a3, a4 = mixer_layer(hp, z_s5, z_s5, z_ssd, z_conv, *lw)
        hs, b1, b2, b3, b4 = mixer_layer(hs, state_s5_re[l], state_s5_im[l],
                                         state_ssd[l], cache_conv[l], *lw)
        p_re.append(a1); p_im.append(a2); p_ssd.append(a3); p_conv.append(a4)
        s_re.append(b1); s_im.append(b2); s_ssd.append(b3); s_conv.append(b4)
    y_prompt = rmsnorm(hp, final_norm_w)
    y_sample = rmsnorm(hs, final_norm_w)
    return (y_prompt, y_sample,
            jnp.stack(p_re), jnp.stack(p_im), jnp.stack(p_ssd), jnp.stack(p_conv),
            jnp.stack(s_re), jnp.stack(s_im), jnp.stack(s_ssd), jnp.stack(s_conv))
```

```cpp
#include <hip/hip_runtime.h>
#include <hip/hip_cooperative_groups.h>
#include <cstdio>
#include <cstdint>
namespace cg = cooperative_groups;

typedef unsigned short bf16_t;
typedef short bf16x8 __attribute__((ext_vector_type(8)));
typedef float f32x4 __attribute__((ext_vector_type(4)));
typedef float f32x2 __attribute__((ext_vector_type(2)));
typedef unsigned u32x4 __attribute__((ext_vector_type(4)));
typedef unsigned u32x2 __attribute__((ext_vector_type(2)));

constexpr int DM = 2048, MP = 8192, MS = 512, MT = MP + MS;
constexpr int SEQ = 2048, NB = 4, DB = 128, DSEQ = 4;
constexpr int INC = 10272, NPROJ = 10240, NPAD = 10368;
constexpr int WA = 2048, NG = 128, NP = 64, NCH = 16;
constexpr int NH = 32, HD = 64, SN = 128, CONVD = 4096;
constexpr float EPS = 1e-5f;

constexpr size_t al256(size_t x) { return (x + 255) & ~(size_t)255; }
constexpr size_t WS_WIN = 0;
constexpr size_t WS_WGLU = WS_WIN + al256((size_t)2 * NPAD * DM * 2);
constexpr size_t WS_WOUT = WS_WGLU + al256((size_t)2 * 2048 * 2048 * 2);
constexpr size_t WS_PROJ = WS_WOUT + al256((size_t)2 * 2048 * 4096 * 2);
constexpr size_t WS_DT = WS_PROJ + al256((size_t)MT * NPROJ * 2);
constexpr size_t WS_G = WS_DT + al256((size_t)MT * 32 * 4);
constexpr size_t WS_ACT = WS_G + al256((size_t)MT * 2048 * 2);
constexpr size_t WS_XRES = WS_ACT + al256((size_t)MT * 4096 * 2);
constexpr size_t WS_XB = WS_XRES + al256((size_t)MT * 2048 * 4);
constexpr size_t WS_SS = WS_XB + al256((size_t)MT * 2048 * 2);
constexpr size_t WS_AB = WS_SS + al256((size_t)9 * MT * 4);
constexpr size_t WS_BBF = WS_AB + al256((size_t)2 * 2 * NG * NP * 4);
constexpr size_t WS_CCF = WS_BBF + al256((size_t)2 * NG * 8 * 64 * 8 * 2);
constexpr size_t WS_CNT = WS_CCF + al256((size_t)2 * NG * 4 * 64 * 8 * 2);
constexpr size_t WS_FLG = WS_CNT + 256;
constexpr size_t WS_XC = WS_FLG + al256((size_t)2 * 2 * 34 * 64);
constexpr size_t WS_DTV = WS_XC + al256((size_t)MT * CONVD * 2);
constexpr size_t WS_END = WS_DTV + al256((size_t)MT * 32 * 4);

constexpr int LDS_BYTES = 73728;
#ifndef PROBE_BITS
#define PROBE_BITS 0
#endif

struct Params {
  const float *x_prompt, *x_sample, *st_s5_re, *st_s5_im, *st_ssd, *cache_conv;
  const float *norm_w, *w_in, *lam_re, *lam_im, *log_step, *b_re, *b_im, *c_re, *c_im, *s5_d;
  const float *glu_w, *glu_b, *s5_norm_w, *conv_w, *conv_b, *dt_bias, *a_log, *ssd_d, *ssd_norm_w, *w_out, *final_w;
  float* out; unsigned char* ws; int ph_lo, ph_hi, probe, pad_;
};

constexpr size_t O_YP = 0;
constexpr size_t O_YS = O_YP + (size_t)MP * DM;
constexpr size_t O_S5RP = O_YS + (size_t)MS * DM;
constexpr size_t O_S5IP = O_S5RP + (size_t)2 * NB * NG * NP;
constexpr size_t O_SSDP = O_S5IP + (size_t)2 * NB * NG * NP;
constexpr size_t O_CONVP = O_SSDP + (size_t)2 * NB * NH * HD * SN;
constexpr size_t O_S5RS = O_CONVP + (size_t)2 * NB * 3 * CONVD;
constexpr size_t O_S5IS = O_S5RS + (size_t)2 * DB * NG * NP;
constexpr size_t O_SSDS = O_S5IS + (size_t)2 * DB * NG * NP;
constexpr size_t O_CONVS = O_SSDS + (size_t)2 * DB * NH * HD * SN;

typedef __bf16 bf16n2 __attribute__((ext_vector_type(2)));
__device__ __forceinline__ unsigned pk2(float lo, float hi) { const f32x2 v = {lo, hi}; return __builtin_bit_cast(unsigned, __builtin_convertvector(v, bf16n2)); }
__device__ __forceinline__ float bflo(unsigned w) { return __uint_as_float(w << 16); }
__device__ __forceinline__ float bfhi(unsigned w) { return __uint_as_float(w & 0xffff0000u); }
__device__ __forceinline__ float bf1(bf16_t h) { return __uint_as_float((unsigned)h << 16); }
__device__ __forceinline__ float sigmoidf_(float x) { return __builtin_amdgcn_rcpf(1.f + __expf(-x)); }
__device__ __forceinline__ float siluf_(float x) { return x * __builtin_amdgcn_rcpf(1.f + __expf(-x)); }
__device__ __forceinline__ float gelu_tanh(float y) { const float z = 0.7978845608028654f * (y + 0.044715f * y * y * y); return y * __builtin_amdgcn_rcpf(1.f + __expf(-2.f * z)); }
__device__ __forceinline__ float wave_sum(float v) {
#pragma unroll
  for (int o = 1; o < 64; o <<= 1) v += __shfl_xor(v, o);
  return v;
}
__device__ __forceinline__ int opaque_tid() { int t = threadIdx.x; asm volatile("" : "+v"(t)); return t; }
__device__ __forceinline__ void st_wt8(void* p, u32x2 v) {
  __hip_atomic_store((unsigned long long*)p, ((unsigned long long)v.y << 32) | v.x, __ATOMIC_RELAXED, __HIP_MEMORY_SCOPE_AGENT);
}
#define LDS_FENCE() asm volatile("s_waitcnt lgkmcnt(0)" ::: "memory")
#define MFMA16(a, b, c) __builtin_amdgcn_mfma_f32_16x16x32_bf16((a), (b), (c), 0, 0, 0)

__device__ __forceinline__ int next_task(int* counter, int* slot) {
  __syncthreads();
  if (threadIdx.x == 0) *slot = atomicAdd(counter, 1);
  __syncthreads();
  return *slot;
}

__device__ __forceinline__ void transpose_tile(const float* W, int K, int N, bf16_t* WT, const float* sc0, const float* sc1, int tile, float* tl) {
  const int tid = opaque_tid();
  const int nkb = K / 64, kb = tile % nkb, nb = tile / nkb, k0 = kb * 64, n0 = nb * 64;
#pragma unroll
  for (int i = 0; i < 4; ++i) {
    const int idx = tid + i * 256, kk = idx >> 4, n4 = (idx & 15) * 4, k = k0 + kk, n = n0 + n4;
    f32x4 v = {0.f, 0.f, 0.f, 0.f};
    if (n < N) { v = *(const f32x4*)(W + (size_t)k * N + n); if (sc0) v *= (k < 2048 ? sc0[k] : sc1[k - 2048]); }
    tl[(n4 + 0) * 65 + kk] = v.x; tl[(n4 + 1) * 65 + kk] = v.y; tl[(n4 + 2) * 65 + kk] = v.z; tl[(n4 + 3) * 65 + kk] = v.w;
  }
  __syncthreads();
  {
    const int n = tid >> 2, kc = (tid & 3) * 16;
    const float* s = tl + n * 65 + kc;
    u32x4 o0, o1;
    o0.x = pk2(s[0], s[1]); o0.y = pk2(s[2], s[3]); o0.z = pk2(s[4], s[5]); o0.w = pk2(s[6], s[7]);
    o1.x = pk2(s[8], s[9]); o1.y = pk2(s[10], s[11]); o1.z = pk2(s[12], s[13]); o1.w = pk2(s[14], s[15]);
    u32x4* dst = (u32x4*)(WT + (size_t)(n0 + n) * K + k0 + kc);
    dst[0] = o0; dst[1] = o1;
  }
  __syncthreads();
}

__device__ __forceinline__ void sincos_own(float ang, float& s, float& c) {
  const float k = rintf(ang * 0.15915494309189535f);
  float r = fmaf(-k, 6.28125f, ang); r = fmaf(-k, 1.9353071795864769e-3f, r);
  const float r2 = r * r;
  float ps = -1.f / 121645100408832000.f;
  ps = fmaf(ps, r2, 1.f / 355687428096000.f);
  ps = fmaf(ps, r2, -1.f / 1307674368000.f);
  ps = fmaf(ps, r2, 1.f / 6227020800.f);
  ps = fmaf(ps, r2, -1.f / 39916800.f);
  ps = fmaf(ps, r2, 1.f / 362880.f);
  ps = fmaf(ps, r2, -1.f / 5040.f);
  ps = fmaf(ps, r2, 1.f / 120.f);
  ps = fmaf(ps, r2, -1.f / 6.f);
  s = fmaf(ps * r2, r, r);
  float pc = 1.f / 2432902008176640000.f;
  pc = fmaf(pc, r2, -1.f / 6402373705728000.f);
  pc = fmaf(pc, r2, 1.f / 20922789888000.f);
  pc = fmaf(pc, r2, -1.f / 87178291200.f);
  pc = fmaf(pc, r2, 1.f / 479001600.f);
  pc = fmaf(pc, r2, -1.f / 3628800.f);
  pc = fmaf(pc, r2, 1.f / 40320.f);
  pc = fmaf(pc, r2, -1.f / 720.f);
  pc = fmaf(pc, r2, 1.f / 24.f);
  pc = fmaf(pc, r2, -0.5f);
  c = fmaf(pc, r2, 1.f);
}

__device__ __forceinline__ void s5_precompute(const Params& P, int l, int g, float* tl) {
  const int tid = opaque_tid();
  float* gre = tl; float* gim = tl + 64;
  if (tid < 64) {
    const int idx = (l * NG + g) * NP + tid;
    const float lr = fminf(P.lam_re[idx], -1e-4f), li = P.lam_im[idx];
    const float step = expf(P.log_step[l * NG + g]);
    const float mag = expf(lr * step);
    float sn, cs; sincos_own(li * step, sn, cs);
    const float abr = mag * cs, abi = mag * sn;
    const float den = lr * lr + li * li, nr = abr - 1.f;
    gre[tid] = (nr * lr + abi * li) / den;
    gim[tid] = (abi * lr - nr * li) / den;
    float* ab = (float*)(P.ws + WS_AB);
    ab[idx] = abr; ab[2 * NG * NP + idx] = abi;
  }
  __syncthreads();
  bf16_t* bbf = (bf16_t*)(P.ws + WS_BBF) + (size_t)(l * NG + g) * 8 * 64 * 8;
  const float* br = P.b_re + (size_t)(l * NG + g) * NP * NCH;
  const float* bi = P.b_im + (size_t)(l * NG + g) * NP * NCH;
  for (int j = 0; j < 16; ++j) {
    const int idx = tid * 16 + j, tile = idx >> 9, lane = (idx >> 3) & 63, e = idx & 7;
    const int pt = tile >> 1, part = tile & 1, p = pt * 16 + (lane & 15), q = lane >> 4, c = q * 8 + e;
    float v = 0.f;
    if (q < 2) { const float a = br[p * NCH + c], b = bi[p * NCH + c]; v = part == 0 ? gre[p] * a - gim[p] * b : gre[p] * b + gim[p] * a; }
    bbf[idx] = (bf16_t)(pk2(v, 0.f) & 0xffff);
  }
  bf16_t* ccf = (bf16_t*)(P.ws + WS_CCF) + (size_t)(l * NG + g) * 4 * 64 * 8;
  const float* cr = P.c_re + (size_t)(l * NG + g) * NCH * NP;
  const float* ci = P.c_im + (size_t)(l * NG + g) * NCH * NP;
  for (int j = 0; j < 8; ++j) {
    const int idx = tid * 8 + j, ks = idx >> 9, lane = (idx >> 3) & 63, e = idx & 7;
    const int c = lane & 15, q = lane >> 4, k = ks * 32 + q * 8 + e, p = k >> 1, part = k & 1;
    const float v = part == 0 ? cr[c * NP + p] : -ci[c * NP + p];
    ccf[idx] = (bf16_t)(pk2(v, 0.f) & 0xffff);
  }
  __syncthreads();
}

__device__ __forceinline__ void phase_prep(const Params& P, unsigned char* lds) {
  float* tl = (float*)(lds + 64);
  const int tid = opaque_tid(), lane = tid & 63, wave = tid >> 6;
  {
    float* ss = (float*)(P.ws + WS_SS);
    for (int i = blockIdx.x * 256 + tid; i < 8 * MT; i += gridDim.x * 256) ss[MT + i] = 0.f;
    if (blockIdx.x == 0 && tid < 64) ((int*)(P.ws + WS_CNT))[tid] = 0;
    if (blockIdx.x == 1) for (int i = tid; i < 2 * 2 * 34 * 16; i += 256) ((int*)(P.ws + WS_FLG))[i] = 0;
  }
  constexpr int T_WIN = 2 * 32 * (NPAD / 64), T_GLU = 2 * 32 * 32, T_OUT = 2 * 64 * 32, T_X = MT / 4, T_S5 = 2 * NG;
  constexpr int T_ALL = T_WIN + T_GLU + T_OUT + T_X + T_S5;
  for (int t = blockIdx.x; t < T_ALL; t += gridDim.x) {
    int r = t;
    if (r < T_WIN) { const int per = 32 * (NPAD / 64), l = r / per; transpose_tile(P.w_in + (size_t)l * DM * INC, DM, INC, (bf16_t*)(P.ws + WS_WIN) + (size_t)l * NPAD * DM, P.norm_w + l * DM, P.norm_w + l * DM, r % per, tl); continue; }
    r -= T_WIN;
    if (r < T_GLU) { const int per = 32 * 32, l = r / per; transpose_tile(P.glu_w + (size_t)l * 2048 * 2048, 2048, 2048, (bf16_t*)(P.ws + WS_WGLU) + (size_t)l * 2048 * 2048, nullptr, nullptr, r % per, tl); continue; }
    r -= T_GLU;
    if (r < T_OUT) { const int per = 64 * 32, l = r / per; transpose_tile(P.w_out + (size_t)l * 4096 * 2048, 4096, 2048, (bf16_t*)(P.ws + WS_WOUT) + (size_t)l * 2048 * 4096, P.s5_norm_w + l * 2048, P.ssd_norm_w + l * 2048, r % per, tl); continue; }
    r -= T_OUT;
    if (r < T_X) {
      const int row = r * 4 + wave;
      const float* src = row < MP ? P.x_prompt + (size_t)row * DM : P.x_sample + (size_t)(row - MP) * DM;
      bf16_t* dst = (bf16_t*)(P.ws + WS_XB) + (size_t)row * DM;
      float s = 0.f;
#pragma unroll
      for (int j = 0; j < 8; ++j) {
        const f32x4 v = *(const f32x4*)(src + (j * 64 + lane) * 4);
        s += v.x * v.x + v.y * v.y + v.z * v.z + v.w * v.w;
        u32x2 o; o.x = pk2(v.x, v.y); o.y = pk2(v.z, v.w);
        *(u32x2*)(dst + (j * 64 + lane) * 4) = o;
      }
      s = wave_sum(s);
      if (lane == 0) ((float*)(P.ws + WS_SS))[row] = s;
      continue;
    }
    r -= T_X;
    s5_precompute(P, r / NG, r % NG, tl);
  }
}

constexpr int G_IN = 0, G_GLU = 1, G_OUT = 2;

__device__ __forceinline__ bool gemm_unit_of(int v, int NT, int& pm, int& pn) {
  const int total = 34 * NT;
  if (v >= total) return false;
  const int ng = NT >> 3, rem = NT & 7;
  if (v < ng * 272) { const int pg = v / 272, w = v % 272; pm = w >> 3; pn = pg * 8 + (w & 7); }
  else { const int w = v - ng * 272; pm = w / rem; pn = ng * 8 + w % rem; }
  return true;
}


struct NextUnit { int kind; int l; int v; };
__device__ __forceinline__ int* panel_flag(const Params& P, int l, int kind, int pm);
__device__ __forceinline__ bool gemm_unit_of(int v, int NT, int& pm, int& pn);
__device__ __forceinline__ void gemm_operands(const Params& P, int mode, int l, const bf16_t*& A, const bf16_t*& Bt, int& ld) {
  if (mode == G_IN) { A = (const bf16_t*)(P.ws + WS_XB); Bt = (const bf16_t*)(P.ws + WS_WIN) + (size_t)l * NPAD * DM; ld = 2048; }
  else if (mode == G_GLU) { A = (const bf16_t*)(P.ws + WS_G); Bt = (const bf16_t*)(P.ws + WS_WGLU) + (size_t)l * 2048 * 2048; ld = 2048; }
  else { A = (const bf16_t*)(P.ws + WS_ACT); Bt = (const bf16_t*)(P.ws + WS_WOUT) + (size_t)l * 2048 * 4096; ld = 4096; }
}
__device__ __forceinline__ void next_decode(const Params& P, const NextUnit& nx, const bf16_t*& A, const bf16_t*& Bt, int& ld, int& pm, int& pn, const int*& flag) {
  if (nx.kind == 1) { gemm_operands(P, G_IN, nx.l, A, Bt, ld); gemm_unit_of(nx.v, 81, pm, pn); flag = nullptr; }
  else {
    const int v = nx.v, l = nx.l;
    if (v < 544) { gemm_unit_of(v, 16, pm, pn); gemm_operands(P, G_GLU, l, A, Bt, ld); flag = nullptr; }
    else if (v < 1088) { gemm_unit_of(v - 544, 16, pm, pn); gemm_operands(P, G_OUT, l, A, Bt, ld); flag = panel_flag(P, l, 0, pm); }
    else { gemm_unit_of(v - 1088, 81, pm, pn); gemm_operands(P, G_IN, l + 1, A, Bt, ld); flag = panel_flag(P, l, 1, pm); }
  }
}

template <int MODE>
__device__ __forceinline__ bool gemm_unit(const Params& P, int l, int pm, int pn, unsigned char* lds, int dummy, bool staged, const NextUnit& nx) {
  constexpr int K = MODE == G_OUT ? 4096 : 2048;
  constexpr int NK = K / 32;
  const bf16_t* A = MODE == G_IN ? (const bf16_t*)(P.ws + WS_XB) : MODE == G_GLU ? (const bf16_t*)(P.ws + WS_G) : (const bf16_t*)(P.ws + WS_ACT);
  const bf16_t* Bt = MODE == G_IN ? (const bf16_t*)(P.ws + WS_WIN) + (size_t)l * NPAD * DM
                   : MODE == G_GLU ? (const bf16_t*)(P.ws + WS_WGLU) + (size_t)l * 2048 * 2048
                                   : (const bf16_t*)(P.ws + WS_WOUT) + (size_t)l * 2048 * 4096;
  const int tid = opaque_tid(), lane = tid & 63, wave = tid >> 6, wr = wave >> 1, wc = wave & 1, fr = lane & 15, fq = lane >> 4;
  unsigned char* base = lds + 64;
  const int grow = tid >> 2, gch = (tid & 3) ^ ((((tid >> 2) >> 3) & 1) << 1);
  const bf16_t* Ag = A + (size_t)(pm * 256 + grow) * K + gch * 8;
  const bf16_t* Bg = Bt + (size_t)(pn * 128 + grow) * K + gch * 8;
  const int swz = (fq ^ ((fr >> 3) << 1)) << 4;
  const int a_rd = (wr * 128 + fr) * 64 + swz;
  const int b_rd = 16384 + (wc * 64 + fr) * 64 + swz;

  f32x4 acc[8][4];
#pragma unroll
  for (int mi = 0; mi < 8; ++mi)
#pragma unroll
    for (int ni = 0; ni < 4; ++ni) acc[mi][ni] = (f32x4){0.f, 0.f, 0.f, 0.f};

  auto stage_tile = [&](int kt, unsigned char* st) __attribute__((always_inline)) {
#pragma unroll
    for (int i = 0; i < 4; ++i) __builtin_amdgcn_global_load_lds((const unsigned*)(Ag + (size_t)i * 64 * K + kt * 32), (unsigned*)(st + (tid + i * 256) * 16), 16, 0, 0);
#pragma unroll
    for (int i = 0; i < 2; ++i) __builtin_amdgcn_global_load_lds((const unsigned*)(Bg + (size_t)i * 64 * K + kt * 32), (unsigned*)(st + 16384 + (tid + i * 256) * 16), 16, 0, 0);
  };
  if (!staged) stage_tile(0, base);
  __syncthreads();
  int* dec = (int*)(lds + 16);

  auto kstep = [&](int kt, bool last) __attribute__((always_inline)) {
    unsigned char* cur = base + (kt & 1) * 24576;
    unsigned char* nxt = base + ((kt & 1) ^ 1) * 24576;
    if (!last) stage_tile(kt + 1, nxt);
    else if (nx.kind && *dec) {
      const bf16_t *nA, *nB; int nld, npm, npn; const int* nflag;
      next_decode(P, nx, nA, nB, nld, npm, npn, nflag);
      const bf16_t* nAg = nA + (size_t)(npm * 256 + grow) * nld + gch * 8;
      const bf16_t* nBg = nB + (size_t)(npn * 128 + grow) * nld + gch * 8;
#pragma unroll
      for (int i = 0; i < 4; ++i) __builtin_amdgcn_global_load_lds((const unsigned*)(nAg + (size_t)i * 64 * nld), (unsigned*)(nxt + (tid + i * 256) * 16), 16, 0, 0);
#pragma unroll
      for (int i = 0; i < 2; ++i) __builtin_amdgcn_global_load_lds((const unsigned*)(nBg + (size_t)i * 64 * nld), (unsigned*)(nxt + 16384 + (tid + i * 256) * 16), 16, 0, 0);
    }
    __builtin_amdgcn_sched_barrier(0);
    if (MODE == G_OUT && kt == NK / 2) {
      const float* ssa = (const float*)(P.ws + WS_SS) + (3 + l) * MT;
      const float* sss = (const float*)(P.ws + WS_SS) + (5 + l) * MT;
#pragma unroll
      for (int mi = 0; mi < 8; ++mi) {
        const int row = pm * 256 + wr * 128 + mi * 16 + fr;
        const float ra = rsqrtf(ssa[row] * (1.f / 2048.f) + EPS), rs = rsqrtf(sss[row] * (1.f / 2048.f) + EPS);
        const float ratio = ra / rs;
#pragma unroll
        for (int ni = 0; ni < 4; ++ni) acc[mi][ni] *= ratio;
      }
    }
    bf16x8 af[8], bfr[4];
#pragma unroll
    for (int ni = 0; ni < 4; ++ni) bfr[ni] = *(const bf16x8*)(cur + b_rd + ni * 1024);
    af[0] = *(const bf16x8*)(cur + a_rd);
    af[1] = *(const bf16x8*)(cur + a_rd + 1024);
    __builtin_amdgcn_sched_barrier(0);
    __builtin_amdgcn_s_setprio(1);
#pragma unroll
    for (int mi = 0; mi < 8; ++mi) {
      if (mi + 2 < 8) af[mi + 2] = *(const bf16x8*)(cur + a_rd + (mi + 2) * 1024);
#pragma unroll
      for (int ni = 0; ni < 4; ++ni) acc[mi][ni] = MFMA16(bfr[ni], af[mi], acc[mi][ni]);
      __builtin_amdgcn_sched_barrier(0);
    }
    __builtin_amdgcn_s_setprio(0);
    __syncthreads();
  };
#pragma unroll 1
  for (int kt = 0; kt < NK - 1; ++kt) {
    if (kt == NK - 2 && tid == 0) {
      int ok = 0;
      if (nx.kind) { const bf16_t *nA, *nB; int nld, npm, npn; const int* nflag; next_decode(P, nx, nA, nB, nld, npm, npn, nflag);
                     ok = nflag == nullptr || __hip_atomic_load(nflag, __ATOMIC_RELAXED, __HIP_MEMORY_SCOPE_AGENT) >= 16; }
      *dec = ok;
    }
    kstep(kt, false);
  }
  kstep(NK - 1, true);

  const int row0 = pm * 256 + wr * 128 + fr, col0 = pn * 128 + wc * 64 + fq * 4;
  if (MODE == G_IN) {
    const float* ssx = (const float*)(P.ws + WS_SS) + l * MT;
    bf16_t* proj = (bf16_t*)(P.ws + WS_PROJ);
    float* dtb = (float*)(P.ws + WS_DT);
#pragma unroll
    for (int mi = 0; mi < 8; ++mi) {
      const int row = row0 + mi * 16;
      const float rs = rsqrtf(ssx[row] * (1.f / 2048.f) + EPS);
#pragma unroll
      for (int ni = 0; ni < 4; ++ni) {
        const f32x4 v = acc[mi][ni] * rs;
        const int col = col0 + ni * 16;
        if (pn < 80) { u32x2 o; o.x = pk2(v.x, v.y); o.y = pk2(v.z, v.w); *(u32x2*)(proj + (size_t)row * NPROJ + col) = o; }
        else if (col < NPROJ + 32) { *(f32x4*)(dtb + (size_t)row * 32 + (col - NPROJ)) = v; }
      }
    }
  } else if (MODE == G_GLU) {
    const bf16_t* gbuf = (const bf16_t*)(P.ws + WS_G);
    const bf16_t* proj = (const bf16_t*)(P.ws + WS_PROJ);
    bf16_t* act = (bf16_t*)(P.ws + WS_ACT);
    float* ssa = (float*)(P.ws + WS_SS) + (dummy ? 7 : 3 + l) * MT;
    const float* gb_ = P.glu_b + l * 2048;
#pragma unroll
    for (int mi = 0; mi < 8; ++mi) {
      const int row = row0 + mi * 16;
      float ss = 0.f;
#pragma unroll
      for (int ni = 0; ni < 4; ++ni) {
        const int col = col0 + ni * 16;
        const f32x4 bv = *(const f32x4*)(gb_ + col);
        const u32x2 gw = *(const u32x2*)(gbuf + (size_t)row * 2048 + col);
        const u32x2 zw = *(const u32x2*)(proj + (size_t)row * NPROJ + 2048 + col);
        const f32x4 a = acc[mi][ni] + bv;
        const float v0 = bflo(gw.x) * sigmoidf_(a.x) * siluf_(bflo(zw.x));
        const float v1 = bfhi(gw.x) * sigmoidf_(a.y) * siluf_(bfhi(zw.x));
        const float v2 = bflo(gw.y) * sigmoidf_(a.z) * siluf_(bflo(zw.y));
        const float v3 = bfhi(gw.y) * sigmoidf_(a.w) * siluf_(bfhi(zw.y));
        ss += v0 * v0 + v1 * v1 + v2 * v2 + v3 * v3;
        u32x2 o; o.x = pk2(v0, v1); o.y = pk2(v2, v3);
        st_wt8(act + (size_t)row * 4096 + col, o);
      }
      ss += __shfl_xor(ss, 16); ss += __shfl_xor(ss, 32);
      if (fq == 0) atomicAdd(ssa + row, ss);
    }
  } else {
    const float* sss = (const float*)(P.ws + WS_SS) + (5 + l) * MT;
    float* ssx = (float*)(P.ws + WS_SS) + (l + 1) * MT;
    float* xres = (float*)(P.ws + WS_XRES);
    bf16_t* xb = (bf16_t*)(P.ws + WS_XB);
#pragma unroll
    for (int mi = 0; mi < 8; ++mi) {
      const int row = row0 + mi * 16;
      const float rs = rsqrtf(sss[row] * (1.f / 2048.f) + EPS);
      const float* xold = l == 0 ? (row < MP ? P.x_prompt + (size_t)row * DM : P.x_sample + (size_t)(row - MP) * DM) : xres + (size_t)row * DM;
      float ss = 0.f;
#pragma unroll
      for (int ni = 0; ni < 4; ++ni) {
        const int col = col0 + ni * 16;
        const f32x4 xo = *(const f32x4*)(xold + col);
        const f32x4 v = xo + acc[mi][ni] * rs;
        ss += v.x * v.x + v.y * v.y + v.z * v.z + v.w * v.w;
        st_wt8(xres + (size_t)row * DM + col, (u32x2){__float_as_uint(v.x), __float_as_uint(v.y)});
        st_wt8(xres + (size_t)row * DM + col + 2, (u32x2){__float_as_uint(v.z), __float_as_uint(v.w)});
        u32x2 o; o.x = pk2(v.x, v.y); o.y = pk2(v.z, v.w);
        st_wt8(xb + (size_t)row * DM + col, o);
      }
      ss += __shfl_xor(ss, 16); ss += __shfl_xor(ss, 32);
      if (fq == 0) atomicAdd(ssx + row, ss);
    }
  }
  return nx.kind && *dec != 0;
}

template <int MODE>
__device__ __forceinline__ void phase_gemm(const Params& P, int l, unsigned char* lds, int dummy = 0) {
  constexpr int NT = MODE == G_IN ? 81 : 16;
  const int slots = gridDim.x >> 3, xcd = blockIdx.x & 7, slot = blockIdx.x >> 3;
  bool staged = false;
  for (int i = 0;; ++i) {
    const int v = (i * 8 + xcd) * slots + slot;
    int pm, pn;
    if (!gemm_unit_of(v, NT, pm, pn)) break;
    NextUnit nx{};
    nx.v = ((i + 1) * 8 + xcd) * slots + slot; nx.l = l; nx.kind = nx.v < 34 * NT ? 1 : 0;
    staged = gemm_unit<MODE>(P, l, pm, pn, lds, dummy, staged, nx);
  }
}


__device__ __forceinline__ int* panel_flag(const Params& P, int l, int kind, int pm) { return (int*)(P.ws + WS_FLG) + ((l * 2 + kind) * 34 + pm) * 16; }
__device__ __forceinline__ void panel_wait(int* flag, int need) {
  if (threadIdx.x == 0) { while (__hip_atomic_load(flag, __ATOMIC_RELAXED, __HIP_MEMORY_SCOPE_AGENT) < need) __builtin_amdgcn_s_sleep(4); }
  __syncthreads();
  asm volatile("" ::: "memory");
}
__device__ __forceinline__ void panel_signal(int* flag) {
  asm volatile("s_waitcnt vmcnt(0)" ::: "memory");
  __syncthreads();
  if (threadIdx.x == 0) __hip_atomic_fetch_add(flag, 1, __ATOMIC_RELAXED, __HIP_MEMORY_SCOPE_AGENT);
}
__device__ __forceinline__ void chain_decode(const Params& P, int l, int v, int nGLU, int nOUT, int total, int& mode, int& pm, int& pn, const int*& flag) {
  if (v < nGLU) { mode = G_GLU; gemm_unit_of(v, 16, pm, pn); flag = nullptr; }
  else if (v < nGLU + nOUT) { mode = G_OUT; gemm_unit_of(v - nGLU, 16, pm, pn); flag = panel_flag(P, l, 0, pm); }
  else { mode = G_IN; gemm_unit_of(v - nGLU - nOUT, 81, pm, pn); flag = panel_flag(P, l, 1, pm); }
}
template <int l>
__device__ __forceinline__ void phase_chain(const Params& P, unsigned char* lds) {
  constexpr int nGLU = 34 * 16, nOUT = 34 * 16, nIN = l == 0 ? 34 * 81 : 0, total = nGLU + nOUT + nIN;
  const int slots = gridDim.x >> 3, xcd = blockIdx.x & 7, slot = blockIdx.x >> 3;
  bool staged = false;
  for (int i = 0;; ++i) {
    const int v = (i * 8 + xcd) * slots + slot;
    if (v >= total) break;
    int mode, pm, pn; const int* flag;
    chain_decode(P, l, v, nGLU, nOUT, total, mode, pm, pn, flag);
    NextUnit nx{};
    nx.v = ((i + 1) * 8 + xcd) * slots + slot; nx.l = l; nx.kind = nx.v < total ? 2 : 0;
    if (mode == G_GLU) {
      staged = gemm_unit<G_GLU>(P, l, pm, pn, lds, 0, staged, nx);
      panel_signal(panel_flag(P, l, 0, pm));
    } else if (mode == G_OUT) {
      if (!staged) panel_wait(panel_flag(P, l, 0, pm), 16);
      staged = gemm_unit<G_OUT>(P, l, pm, pn, lds, 0, staged, nx);
      panel_signal(panel_flag(P, l, 1, pm));
    } else if (l == 0) {
      if (!staged) panel_wait(panel_flag(P, l, 1, pm), 16);
      staged = gemm_unit<G_IN>(P, l + 1, pm, pn, lds, 0, staged, nx);
    }
  }
}

__device__ __forceinline__ void conv8(const u32x4* r, int i, const f32x4* w, const f32x4* bias, float* o) {
#pragma unroll
  for (int hf = 0; hf < 2; ++hf) {
    f32x4 a = bias[hf];
#pragma unroll
    for (int k = 0; k < 4; ++k) {
      const u32x4 rv = r[i + k];
      const unsigned w0 = hf == 0 ? rv.x : rv.z, w1 = hf == 0 ? rv.y : rv.w;
      const f32x4 wk = w[k * 2 + hf];
      a.x = fmaf(wk.x, bflo(w0), a.x); a.y = fmaf(wk.y, bfhi(w0), a.y);
      a.z = fmaf(wk.z, bflo(w1), a.z); a.w = fmaf(wk.w, bfhi(w1), a.w);
    }
    o[hf * 4 + 0] = siluf_(a.x); o[hf * 4 + 1] = siluf_(a.y); o[hf * 4 + 2] = siluf_(a.z); o[hf * 4 + 3] = siluf_(a.w);
  }
}
__device__ __forceinline__ void store8f(float* dst, u32x4 v) {
  *(f32x4*)dst = (f32x4){bflo(v.x), bfhi(v.x), bflo(v.y), bfhi(v.y)};
  *(f32x4*)(dst + 4) = (f32x4){bflo(v.z), bfhi(v.z), bflo(v.w), bfhi(v.w)};
}

__device__ __forceinline__ void phase_conv(const Params& P, int l) {
  const int tid = opaque_tid();
  const int gsz = gridDim.x * 256, gid = blockIdx.x * 256 + tid;
  const bf16_t* proj = (const bf16_t*)(P.ws + WS_PROJ);
  bf16_t* xc = (bf16_t*)(P.ws + WS_XC);
  const float* cw = P.conv_w + (size_t)l * 4 * CONVD;
  const float* cb = P.conv_b + (size_t)l * CONVD;
#pragma unroll 1
  for (int it = gid; it < (MP / 8) * 512; it += gsz) {
    const int ch0 = (it & 511) * 8, row0 = (it >> 9) * 8, t0 = row0 & (SEQ - 1);
    u32x4 r[11];
#pragma unroll
    for (int j = 0; j < 11; ++j) {
      r[j] = (u32x4){0u, 0u, 0u, 0u};
      if (t0 - 3 + j >= 0) r[j] = *(const u32x4*)(proj + (size_t)(row0 - 3 + j) * NPROJ + 4096 + ch0);
    }
    f32x4 w[8], bias[2];
#pragma unroll
    for (int k = 0; k < 4; ++k) { w[k * 2] = *(const f32x4*)(cw + k * CONVD + ch0); w[k * 2 + 1] = *(const f32x4*)(cw + k * CONVD + ch0 + 4); }
    bias[0] = *(const f32x4*)(cb + ch0); bias[1] = *(const f32x4*)(cb + ch0 + 4);
#pragma unroll
    for (int i = 0; i < 8; ++i) {
      float o[8]; conv8(r, i, w, bias, o);
      u32x4 q; q.x = pk2(o[0], o[1]); q.y = pk2(o[2], o[3]); q.z = pk2(o[4], o[5]); q.w = pk2(o[6], o[7]);
      *(u32x4*)(xc + (size_t)(row0 + i) * CONVD + ch0) = q;
    }
    if (t0 == SEQ - 8) {
      const int bb = row0 >> 11;
#pragma unroll
      for (int j = 0; j < 3; ++j) store8f(P.out + O_CONVP + ((size_t)(l * NB + bb) * 3 + j) * CONVD + ch0, r[8 + j]);
    }
  }
#pragma unroll 1
  for (int it = gid; it < DB * 512; it += gsz) {
    const int ch0 = (it & 511) * 8, bb = it >> 9, row0 = MP + bb * 4;
    u32x4 r[7];
#pragma unroll
    for (int j = 0; j < 3; ++j) {
      const float* cp = P.cache_conv + ((size_t)(l * DB + bb) * 3 + j) * CONVD + ch0;
      const f32x4 c0 = *(const f32x4*)cp, c1 = *(const f32x4*)(cp + 4);
      r[j].x = pk2(c0.x, c0.y); r[j].y = pk2(c0.z, c0.w); r[j].z = pk2(c1.x, c1.y); r[j].w = pk2(c1.z, c1.w);
    }
#pragma unroll
    for (int j = 0; j < 4; ++j) r[3 + j] = *(const u32x4*)(proj + (size_t)(row0 + j) * NPROJ + 4096 + ch0);
    f32x4 w[8], bias[2];
#pragma unroll
    for (int k = 0; k < 4; ++k) { w[k * 2] = *(const f32x4*)(cw + k * CONVD + ch0); w[k * 2 + 1] = *(const f32x4*)(cw + k * CONVD + ch0 + 4); }
    bias[0] = *(const f32x4*)(cb + ch0); bias[1] = *(const f32x4*)(cb + ch0 + 4);
#pragma unroll
    for (int i = 0; i < 4; ++i) {
      float o[8]; conv8(r, i, w, bias, o);
      u32x4 q; q.x = pk2(o[0], o[1]); q.y = pk2(o[2], o[3]); q.z = pk2(o[4], o[5]); q.w = pk2(o[6], o[7]);
      *(u32x4*)(xc + (size_t)(row0 + i) * CONVD + ch0) = q;
    }
#pragma unroll
    for (int j = 0; j < 3; ++j) store8f(P.out + O_CONVS + ((size_t)(l * DB + bb) * 3 + j) * CONVD + ch0, r[4 + j]);
  }
  {
    const float* dtb = (const float*)(P.ws + WS_DT);
    float* dtv = (float*)(P.ws + WS_DTV);
    for (int i = gid; i < MT * 32; i += gsz) {
      const float x = dtb[i] + P.dt_bias[l * NH + (i & 31)];
      dtv[i] = fmaxf(x, 0.f) + log1pf(__expf(-fabsf(x)));
    }
  }
}

template <int MODE>
__device__ __forceinline__ void s5_wave(const Params& P, int l, int g, int rowbase, int nchunks, unsigned char* wl, float& hr, float& hi,
                                        const bf16x8 (&bbf)[8], const bf16x8 (&ccf)[4], float ar, float ai) {
  const int lane = opaque_tid() & 63, fr = lane & 15, fq = lane >> 4;
  unsigned char* bu = wl; unsigned char* Hb = wl + 8192;
  const bf16_t* proj = (const bf16_t*)(P.ws + WS_PROJ);
  bf16_t* gbuf = (bf16_t*)(P.ws + WS_G);
  f32x4 dv = {0.f, 0.f, 0.f, 0.f};
  if (MODE != 0) dv = *(const f32x4*)(P.s5_d + l * WA + g * NCH + fq * 4);
  const bf16x8 zero8 = {0, 0, 0, 0, 0, 0, 0, 0};
  bf16x8 uf = zero8;
  if (fq < 2) uf = *(const bf16x8*)(proj + (size_t)(rowbase + fr) * NPROJ + g * NCH + fq * 8);
#pragma unroll 1
  for (int c = 0; c < nchunks; ++c) {
    const int row0 = rowbase + c * 16;
    f32x4 t[8];
#pragma unroll
    for (int i = 0; i < 8; ++i) t[i] = MFMA16(uf, bbf[i], ((f32x4){0.f, 0.f, 0.f, 0.f}));
    u32x2 uw = {0u, 0u};
    if (MODE != 0) uw = *(const u32x2*)(proj + (size_t)(row0 + fr) * NPROJ + g * NCH + fq * 4);
    if (c + 1 < nchunks) { if (fq < 2) uf = *(const bf16x8*)(proj + (size_t)(row0 + 16 + fr) * NPROJ + g * NCH + fq * 8); }
#pragma unroll
    for (int pt = 0; pt < 4; ++pt)
#pragma unroll
      for (int r = 0; r < 4; ++r) {
        f32x2 v; v.x = t[2 * pt][r]; v.y = t[2 * pt + 1][r];
        *(f32x2*)(bu + (fq * 4 + r) * 512 + (pt * 16 + fr) * 8) = v;
      }
    LDS_FENCE();
#pragma unroll
    for (int tt = 0; tt < 16; ++tt) {
      if (MODE == 2 && (tt & 3) == 0) {
        const int b = ((row0 - MP) >> 2) + (tt >> 2);
        hr = P.st_s5_re[((size_t)(l * DB + b) * NG + g) * NP + lane];
        hi = P.st_s5_im[((size_t)(l * DB + b) * NG + g) * NP + lane];
      }
      const f32x2 bv = *(const f32x2*)(bu + tt * 512 + lane * 8);
      const float nr = fmaf(ar, hr, fmaf(-ai, hi, bv.x));
      const float ni = fmaf(ar, hi, fmaf(ai, hr, bv.y));
      hr = nr; hi = ni;
      if (MODE != 0) *(unsigned*)(Hb + tt * 272 + lane * 4) = pk2(hr, hi);
      if (MODE == 2 && (tt & 3) == 3) {
        const int b = ((row0 - MP) >> 2) + (tt >> 2);
        P.out[O_S5RS + ((size_t)(l * DB + b) * NG + g) * NP + lane] = hr;
        P.out[O_S5IS + ((size_t)(l * DB + b) * NG + g) * NP + lane] = hi;
      }
    }
    LDS_FENCE();
    if (MODE != 0) {
      f32x4 y = {0.f, 0.f, 0.f, 0.f};
#pragma unroll
      for (int ks = 0; ks < 4; ++ks) {
        const bf16x8 hf = *(const bf16x8*)(Hb + fr * 272 + ks * 64 + fq * 16);
        y = MFMA16(ccf[ks], hf, y);
      }
      LDS_FENCE();
      const float y0 = gelu_tanh(y.x + dv.x * bflo(uw.x)), y1 = gelu_tanh(y.y + dv.y * bfhi(uw.x));
      const float y2 = gelu_tanh(y.z + dv.z * bflo(uw.y)), y3 = gelu_tanh(y.w + dv.w * bfhi(uw.y));
      u32x2 o; o.x = pk2(y0, y1); o.y = pk2(y2, y3);
      *(u32x2*)(gbuf + (size_t)(row0 + fr) * 2048 + g * NCH + fq * 4) = o;
    }
  }
}

constexpr int L_S5X = 64 + 4 * 12544;
template <bool SAMPLE>
__device__ __forceinline__ void s5_block_task(const Params& P, int l, int g, int b, unsigned char* lds) {
  const int tid = opaque_tid(), lane = tid & 63, wave = tid >> 6;
  const bf16x8* bbp = (const bf16x8*)((const bf16_t*)(P.ws + WS_BBF) + (size_t)(l * NG + g) * 8 * 64 * 8);
  const bf16x8* ccp = (const bf16x8*)((const bf16_t*)(P.ws + WS_CCF) + (size_t)(l * NG + g) * 4 * 64 * 8);
  bf16x8 bbf[8], ccf[4];
#pragma unroll
  for (int i = 0; i < 8; ++i) bbf[i] = bbp[i * 64 + lane];
#pragma unroll
  for (int i = 0; i < 4; ++i) ccf[i] = ccp[i * 64 + lane];
  const float* ab = (const float*)(P.ws + WS_AB);
  const float ar = ab[(l * NG + g) * NP + lane], ai = ab[2 * NG * NP + (l * NG + g) * NP + lane];
  unsigned char* wl = lds + 64 + wave * 12544;
  float hr = 0.f, hi = 0.f;
  if (SAMPLE) {
    s5_wave<2>(P, l, g, MP + wave * 128, 8, wl, hr, hi, bbf, ccf, ar, ai);
  } else {
    const int rowbase = b * SEQ + (wave < 3 ? wave * 448 : 1344), nch = wave < 3 ? 28 : 44;
    if (wave < 3) s5_wave<0>(P, l, g, rowbase, 28, wl, hr, hi, bbf, ccf, ar, ai);
    f32x2* xch = (f32x2*)(lds + L_S5X);
    xch[wave * 64 + lane] = (f32x2){hr, hi};
    float pr = ar, pi = ai;
#pragma unroll
    for (int i = 0; i < 6; ++i) { const float nr = pr * pr - pi * pi, ni = 2.f * pr * pi; pr = nr; pi = ni; }
    const float q64r = pr, q64i = pi;
    { const float nr = pr * pr - pi * pi, ni = 2.f * pr * pi; pr = nr; pi = ni; }
    const float q128r = pr, q128i = pi;
    { const float nr = pr * pr - pi * pi, ni = 2.f * pr * pi; pr = nr; pi = ni; }
    { const float tr = pr * q128r - pi * q128i, ti = pr * q128i + pi * q128r; pr = tr * q64r - ti * q64i; pi = tr * q64i + ti * q64r; }
    __syncthreads();
    hr = 0.f; hi = 0.f;
    for (int j = 0; j < wave; ++j) {
      const f32x2 e = xch[j * 64 + lane];
      const float nr = fmaf(pr, hr, fmaf(-pi, hi, e.x)), ni = fmaf(pr, hi, fmaf(pi, hr, e.y));
      hr = nr; hi = ni;
    }
    s5_wave<1>(P, l, g, rowbase, nch, wl, hr, hi, bbf, ccf, ar, ai);
    if (wave == 3) {
      P.out[O_S5RP + ((size_t)(l * NB + b) * NG + g) * NP + lane] = hr;
      P.out[O_S5IP + ((size_t)(l * NB + b) * NG + g) * NP + lane] = hi;
    }
  }
}

constexpr int L_CN = 64, L_BN = L_CN + 17408, L_BT = L_BN + 17408, L_XT = L_BT + 18432, L_MM = L_XT + 9216, L_DT = L_MM + 9216, L_CS = L_DT + 256;

__device__ __forceinline__ void ssd_prompt_task(const Params& P, int l, int b, int h, unsigned char* lds, int dummy) {
  const int tid = opaque_tid(), lane = tid & 63, wave = tid >> 6, fr = lane & 15, fq = lane >> 4;
  const int gi = h >> 2, pw = wave * 16;
  const bf16_t* proj = (const bf16_t*)(P.ws + WS_PROJ);
  const bf16_t* xc = (const bf16_t*)(P.ws + WS_XC);
  const float* dtvb = (const float*)(P.ws + WS_DTV);
  bf16_t* act = (bf16_t*)(P.ws + WS_ACT);
  float* sss = (float*)(P.ws + WS_SS) + (dummy ? 8 : 5 + l) * MT;
  const float a_h = -expf(P.a_log[l * NH + h]), dsk = P.ssd_d[l * NH + h];
  f32x4 S[8];
#pragma unroll
  for (int i = 0; i < 8; ++i) S[i] = (f32x4){0.f, 0.f, 0.f, 0.f};
  const int crow = tid >> 4, cch = tid & 15;
  u32x4 pc[4], pb[4], px[2]; float pdt;
  {
    const bf16_t* base = xc + (size_t)(b * SEQ) * CONVD;
#pragma unroll
    for (int i = 0; i < 4; ++i) pc[i] = *(const u32x4*)(base + (size_t)(i * 16 + crow) * CONVD + 3072 + gi * 128 + cch * 8);
#pragma unroll
    for (int i = 0; i < 2; ++i) {
      pb[i * 2] = *(const u32x4*)(base + (size_t)((i * 16 + crow) * 2) * CONVD + 2048 + gi * 128 + cch * 8);
      pb[i * 2 + 1] = *(const u32x4*)(base + (size_t)((i * 16 + crow) * 2 + 1) * CONVD + 2048 + gi * 128 + cch * 8);
    }
    px[0] = *(const u32x4*)(base + (size_t)((tid >> 3) * 2) * CONVD + h * 64 + (tid & 7) * 8);
    px[1] = *(const u32x4*)(base + (size_t)((tid >> 3) * 2 + 1) * CONVD + h * 64 + (tid & 7) * 8);
    pdt = dtvb[(size_t)(b * SEQ + lane) * 32 + h];
  }
#pragma unroll 1
  for (int c = 0; c < SEQ / 64; ++c) {
    const int rowc = b * SEQ + c * 64;
    float* DTs = (float*)(lds + L_DT + (c & 1) * 512); float* CSs = DTs + 64;
    {
      float cs = pdt * a_h;
#pragma unroll
      for (int o = 1; o < 64; o <<= 1) { const float v = __shfl_up(cs, o); if (lane >= o) cs += v; }
      if (wave == 0) { DTs[lane] = pdt; CSs[lane] = cs; }
    }
    __syncthreads();
    const float cs_end = CSs[63];
    {
#pragma unroll
      for (int i = 0; i < 4; ++i) *(u32x4*)(lds + L_CN + (i * 16 + crow) * 272 + cch * 16) = pc[i];
#pragma unroll
      for (int i = 0; i < 2; ++i) {
        const int t0 = (i * 16 + crow) * 2;
        const u32x4 v0 = pb[i * 2], v1 = pb[i * 2 + 1];
        *(u32x4*)(lds + L_BN + t0 * 272 + cch * 16) = v0;
        *(u32x4*)(lds + L_BN + (t0 + 1) * 272 + cch * 16) = v1;
        const float d0 = __expf(cs_end - CSs[t0]) * DTs[t0], d1 = __expf(cs_end - CSs[t0 + 1]) * DTs[t0 + 1];
        unsigned char* bt = lds + L_BT + (cch * 8) * 144 + t0 * 2;
        *(unsigned*)(bt + 0 * 144) = pk2(bflo(v0.x) * d0, bflo(v1.x) * d1);
        *(unsigned*)(bt + 1 * 144) = pk2(bfhi(v0.x) * d0, bfhi(v1.x) * d1);
        *(unsigned*)(bt + 2 * 144) = pk2(bflo(v0.y) * d0, bflo(v1.y) * d1);
        *(unsigned*)(bt + 3 * 144) = pk2(bfhi(v0.y) * d0, bfhi(v1.y) * d1);
        *(unsigned*)(bt + 4 * 144) = pk2(bflo(v0.z) * d0, bflo(v1.z) * d1);
        *(unsigned*)(bt + 5 * 144) = pk2(bfhi(v0.z) * d0, bfhi(v1.z) * d1);
        *(unsigned*)(bt + 6 * 144) = pk2(bflo(v0.w) * d0, bflo(v1.w) * d1);
        *(unsigned*)(bt + 7 * 144) = pk2(bfhi(v0.w) * d0, bfhi(v1.w) * d1);
      }
      {
        const u32x4 v0 = px[0], v1 = px[1];
        unsigned char* xt = lds + L_XT + ((tid & 7) * 8) * 144 + (tid >> 3) * 4;
        *(unsigned*)(xt + 0 * 144) = (v0.x & 0xffffu) | (v1.x << 16);
        *(unsigned*)(xt + 1 * 144) = (v0.x >> 16) | (v1.x & 0xffff0000u);
        *(unsigned*)(xt + 2 * 144) = (v0.y & 0xffffu) | (v1.y << 16);
        *(unsigned*)(xt + 3 * 144) = (v0.y >> 16) | (v1.y & 0xffff0000u);
        *(unsigned*)(xt + 4 * 144) = (v0.z & 0xffffu) | (v1.z << 16);
        *(unsigned*)(xt + 5 * 144) = (v0.z >> 16) | (v1.z & 0xffff0000u);
        *(unsigned*)(xt + 6 * 144) = (v0.w & 0xffffu) | (v1.w << 16);
        *(unsigned*)(xt + 7 * 144) = (v0.w >> 16) | (v1.w & 0xffff0000u);
      }
    }
    if (c + 1 < SEQ / 64) {
      const bf16_t* base = xc + (size_t)(rowc + 64) * CONVD;
#pragma unroll
      for (int i = 0; i < 4; ++i) pc[i] = *(const u32x4*)(base + (size_t)(i * 16 + crow) * CONVD + 3072 + gi * 128 + cch * 8);
#pragma unroll
      for (int i = 0; i < 2; ++i) {
        pb[i * 2] = *(const u32x4*)(base + (size_t)((i * 16 + crow) * 2) * CONVD + 2048 + gi * 128 + cch * 8);
        pb[i * 2 + 1] = *(const u32x4*)(base + (size_t)((i * 16 + crow) * 2 + 1) * CONVD + 2048 + gi * 128 + cch * 8);
      }
      px[0] = *(const u32x4*)(base + (size_t)((tid >> 3) * 2) * CONVD + h * 64 + (tid & 7) * 8);
      px[1] = *(const u32x4*)(base + (size_t)((tid >> 3) * 2 + 1) * CONVD + h * 64 + (tid & 7) * 8);
      pdt = dtvb[(size_t)(rowc + 64 + lane) * 32 + h];
    }
    __syncthreads();
    u32x2 zwv[4];
#pragma unroll
    for (int tt = 0; tt < 4; ++tt) zwv[tt] = *(const u32x2*)(proj + (size_t)(rowc + tt * 16 + fr) * NPROJ + 8192 + h * 64 + pw + fq * 4);
    {
      bf16x8 cf[4];
#pragma unroll
      for (int ks = 0; ks < 4; ++ks) cf[ks] = *(const bf16x8*)(lds + L_CN + (wave * 16 + fr) * 272 + ks * 64 + fq * 16);
      const int tcol = wave * 16 + fr; const float cst = CSs[tcol];
#pragma unroll
      for (int st = 0; st < 4; ++st) {
        f32x4 g = {0.f, 0.f, 0.f, 0.f};
#pragma unroll
        for (int ks = 0; ks < 4; ++ks) {
          const bf16x8 bf = *(const bf16x8*)(lds + L_BN + (st * 16 + fr) * 272 + ks * 64 + fq * 16);
          g = MFMA16(bf, cf[ks], g);
        }
        float m[4];
#pragma unroll
        for (int r = 0; r < 4; ++r) {
          const int s_ = st * 16 + fq * 4 + r;
          m[r] = s_ <= tcol ? g[r] * __expf(cst - CSs[s_]) * DTs[s_] : 0.f;
        }
        u32x2 o; o.x = pk2(m[0], m[1]); o.y = pk2(m[2], m[3]);
        *(u32x2*)(lds + L_MM + tcol * 144 + (st * 16 + fq * 4) * 2) = o;
      }
    }
    __syncthreads();
    {
      bf16x8 sf[4];
#pragma unroll
      for (int ks = 0; ks < 4; ++ks) {
        u32x4 v; v.x = pk2(S[2 * ks].x, S[2 * ks].y); v.y = pk2(S[2 * ks].z, S[2 * ks].w); v.z = pk2(S[2 * ks + 1].x, S[2 * ks + 1].y); v.w = pk2(S[2 * ks + 1].z, S[2 * ks + 1].w);
        sf[ks] = __builtin_bit_cast(bf16x8, v);
      }
      bf16x8 xf[2];
#pragma unroll
      for (int k2 = 0; k2 < 2; ++k2) xf[k2] = *(const bf16x8*)(lds + L_XT + (pw + fr) * 144 + k2 * 64 + fq * 16);
#pragma unroll
      for (int tt = 0; tt < 4; ++tt) {
        const int t = tt * 16 + fr;
        f32x4 y = {0.f, 0.f, 0.f, 0.f};
#pragma unroll
        for (int ks = 0; ks < 4; ++ks) {
          const u32x2 c0 = *(const u32x2*)(lds + L_CN + t * 272 + ((2 * ks) * 16 + fq * 4) * 2);
          const u32x2 c1 = *(const u32x2*)(lds + L_CN + t * 272 + ((2 * ks + 1) * 16 + fq * 4) * 2);
          u32x4 cv; cv.x = c0.x; cv.y = c0.y; cv.z = c1.x; cv.w = c1.y;
          y = MFMA16(sf[ks], __builtin_bit_cast(bf16x8, cv), y);
        }
        y *= __expf(CSs[t]);
#pragma unroll
        for (int k2 = 0; k2 < 2; ++k2) {
          const bf16x8 mf = *(const bf16x8*)(lds + L_MM + t * 144 + k2 * 64 + fq * 16);
          y = MFMA16(xf[k2], mf, y);
        }
        const int row = rowc + t, pc_ = pw + fq * 4;
        const u32x2 zw = zwv[tt];
        const float x0 = bf1(*(const bf16_t*)(lds + L_XT + (pc_ + 0) * 144 + t * 2)), x1 = bf1(*(const bf16_t*)(lds + L_XT + (pc_ + 1) * 144 + t * 2));
        const float x2 = bf1(*(const bf16_t*)(lds + L_XT + (pc_ + 2) * 144 + t * 2)), x3 = bf1(*(const bf16_t*)(lds + L_XT + (pc_ + 3) * 144 + t * 2));
        const float v0 = (y.x + dsk * x0) * siluf_(bflo(zw.x)), v1 = (y.y + dsk * x1) * siluf_(bfhi(zw.x));
        const float v2 = (y.z + dsk * x2) * siluf_(bflo(zw.y)), v3 = (y.w + dsk * x3) * siluf_(bfhi(zw.y));
        u32x2 o; o.x = pk2(v0, v1); o.y = pk2(v2, v3);
        *(u32x2*)(act + (size_t)row * 4096 + 2048 + h * 64 + pc_) = o;
        float ss = v0 * v0 + v1 * v1 + v2 * v2 + v3 * v3;
        ss += __shfl_xor(ss, 16); ss += __shfl_xor(ss, 32);
        if (fq == 0) atomicAdd(sss + row, ss);
      }
      const float dec = __expf(cs_end);
#pragma unroll
      for (int nt = 0; nt < 8; ++nt) {
        S[nt] *= dec;
#pragma unroll
        for (int k2 = 0; k2 < 2; ++k2) {
          const bf16x8 bt = *(const bf16x8*)(lds + L_BT + (nt * 16 + fr) * 144 + k2 * 64 + fq * 16);
          S[nt] = MFMA16(bt, xf[k2], S[nt]);
        }
      }
    }
  }
  float* so = P.out + O_SSDP + ((size_t)(l * NB + b) * NH + h) * HD * SN;
#pragma unroll
  for (int nt = 0; nt < 8; ++nt) *(f32x4*)(so + (size_t)(pw + fr) * SN + nt * 16 + fq * 4) = S[nt];
}

struct SampLd { f32x4 st[8]; u32x4 xcv; float dtv; float zt[4]; };
__device__ __forceinline__ void ssd_sample_load(const Params& P, int l, int task, int tid, SampLd& L) {
  const int b = task >> 5, h = task & 31, gi = h >> 2, row0 = MP + b * 4;
  const float* sin_ = P.st_ssd + ((size_t)(l * DB + b) * NH + h) * HD * SN;
#pragma unroll
  for (int j = 0; j < 8; ++j) L.st[j] = *(const f32x4*)(sin_ + (j * 256 + tid) * 4);
  L.xcv = (u32x4){0u, 0u, 0u, 0u}; L.dtv = 0.f;
  if (tid < 160) {
    const int t = tid / 40, q = tid % 40;
    const int ch = q < 8 ? h * 64 + q * 8 : q < 24 ? 2048 + gi * 128 + (q - 8) * 8 : 3072 + gi * 128 + (q - 24) * 8;
    L.xcv = *(const u32x4*)((const bf16_t*)(P.ws + WS_XC) + (size_t)(row0 + t) * CONVD + ch);
  }
  if (tid >= 192 && tid < 196) L.dtv = ((const float*)(P.ws + WS_DTV))[(size_t)(row0 + tid - 192) * 32 + h];
  const int p = tid >> 2;
#pragma unroll
  for (int t = 0; t < 4; ++t) L.zt[t] = bf1(((const bf16_t*)(P.ws + WS_PROJ))[(size_t)(row0 + t) * NPROJ + 8192 + h * 64 + p]);
}

__device__ __forceinline__ void ssd_sample_batch(const Params& P, int l, int batch, unsigned char* lds, int dummy) {
  const int tid = opaque_tid(), lane = tid & 63;
  bf16_t* act = (bf16_t*)(P.ws + WS_ACT);
  float* sss = (float*)(P.ws + WS_SS) + (dummy ? 8 : 5 + l) * MT;
  float* xs = (float*)(lds + 64);
  float* Bs = xs + 256;
  float* Cs = Bs + 512;
  float* dts = Cs + 512;
  float* St0 = dts + 16;
  const int p = tid >> 2, nq = tid & 3, n0 = nq * 32;
  SampLd L;
  ssd_sample_load(P, l, batch * 8, tid, L);
#pragma unroll 1
  for (int i = 0; i < 8; ++i) {
    const int task = batch * 8 + i, b = task >> 5, h = task & 31, row0 = MP + b * 4;
    float* St = St0 + (i & 1) * (64 * 132);
    const float a_h = -expf(P.a_log[l * NH + h]), dsk = P.ssd_d[l * NH + h];
#pragma unroll
    for (int j = 0; j < 8; ++j) { const int f = (j * 256 + tid) * 4; *(f32x4*)(St + (f >> 7) * 132 + (f & 127)) = L.st[j]; }
    if (tid < 160) {
      const int t = tid / 40, q = tid % 40;
      float* dst = q < 8 ? xs + t * 64 + q * 8 : q < 24 ? Bs + t * 128 + (q - 8) * 8 : Cs + t * 128 + (q - 24) * 8;
      const u32x4 v = L.xcv;
      *(f32x4*)dst = (f32x4){bflo(v.x), bfhi(v.x), bflo(v.y), bfhi(v.y)};
      *(f32x4*)(dst + 4) = (f32x4){bflo(v.z), bfhi(v.z), bflo(v.w), bfhi(v.w)};
    }
    if (tid >= 192 && tid < 196) dts[tid - 192] = L.dtv;
    float zt[4];
#pragma unroll
    for (int t = 0; t < 4; ++t) zt[t] = L.zt[t];
    __syncthreads();
    if (i + 1 < 8) ssd_sample_load(P, l, task + 1, tid, L);
    f32x4 hs[8];
#pragma unroll
    for (int j = 0; j < 8; ++j) hs[j] = *(const f32x4*)(St + p * 132 + n0 + j * 4);
#pragma unroll
    for (int t = 0; t < 4; ++t) {
      const float dtv = dts[t], dA = __expf(dtv * a_h), xv = xs[t * 64 + p], xdt = xv * dtv;
      float yp = 0.f;
#pragma unroll
      for (int j = 0; j < 8; ++j) {
        const f32x4 bv = *(const f32x4*)(Bs + t * 128 + n0 + j * 4);
        const f32x4 cv = *(const f32x4*)(Cs + t * 128 + n0 + j * 4);
        hs[j] = hs[j] * dA + bv * xdt;
        yp += hs[j].x * cv.x + hs[j].y * cv.y + hs[j].z * cv.z + hs[j].w * cv.w;
      }
      yp += __shfl_xor(yp, 1); yp += __shfl_xor(yp, 2);
      const int row = row0 + t;
      float v = 0.f;
      if (nq == 0) {
        v = (yp + dsk * xv) * siluf_(zt[t]);
        act[(size_t)row * 4096 + 2048 + h * 64 + p] = (bf16_t)(pk2(v, 0.f) & 0xffff);
      }
      const float ss = wave_sum(v * v);
      if (lane == 0) atomicAdd(sss + row, ss);
    }
#pragma unroll
    for (int j = 0; j < 8; ++j) *(f32x4*)(St + p * 132 + n0 + j * 4) = hs[j];
    __syncthreads();
    float* so = P.out + O_SSDS + ((size_t)(l * DB + b) * NH + h) * HD * SN;
#pragma unroll
    for (int j = 0; j < 8; ++j) { const int f = (j * 256 + tid) * 4; *(f32x4*)(so + f) = *(const f32x4*)(St + (f >> 7) * 132 + (f & 127)); }
  }
}

__device__ __forceinline__ void phase_mix(const Params& P, int l, unsigned char* lds, int dummy = 0) {
  int* counter = (int*)(P.ws + WS_CNT) + l + (dummy ? 8 : 0);
  int* slot = (int*)lds;
  constexpr int T0 = 128, T1 = T0 + 512, T2 = T1 + DB * NH / 8, T3 = T2 + NG;
  for (;;) {
    const int t = next_task(counter, slot);
    if (t >= T3) break;
    const int mask = dummy ? (P.probe >> 4) : 15;
    if (t < T0) { if (mask & 1) ssd_prompt_task(P, l, t >> 5, t & 31, lds, dummy); }
    else if (t < T1) { const int q = t - T0; if (mask & 2) s5_block_task<false>(P, l, q & 127, q >> 7, lds); }
    else if (t < T2) { if (mask & 4) ssd_sample_batch(P, l, t - T1, lds, dummy); }
    else { if (mask & 8) s5_block_task<true>(P, l, t - T2, 0, lds); }
  }
}

__device__ __forceinline__ void phase_final(const Params& P) {
  const int tid = opaque_tid(), lane = tid & 63, wave = tid >> 6;
  const float* xres = (const float*)(P.ws + WS_XRES);
  const float* ssx = (const float*)(P.ws + WS_SS) + 2 * MT;
  for (int r4 = blockIdx.x; r4 < MT / 4; r4 += gridDim.x) {
    const int row = r4 * 4 + wave;
    const float rs = rsqrtf(ssx[row] * (1.f / 2048.f) + EPS);
    float* dst = P.out + (size_t)row * DM;
#pragma unroll
    for (int j = 0; j < 8; ++j) {
      const f32x4 v = *(const f32x4*)(xres + (size_t)row * DM + (j * 64 + lane) * 4);
      const f32x4 w = *(const f32x4*)(P.final_w + (j * 64 + lane) * 4);
      *(f32x4*)(dst + (j * 64 + lane) * 4) = v * rs * w;
    }
  }
}

__global__ void __launch_bounds__(256, 2) hymba_fwd(Params P) {
  extern __shared__ __attribute__((aligned(16))) unsigned char lds[];
  cg::grid_group grid = cg::this_grid();
  for (int ph = P.ph_lo; ph < P.ph_hi; ++ph) {
    if (ph > P.ph_lo) grid.sync();
#ifndef TEST_PH
#define TEST_PH -1
#endif
    if (ph == 0) phase_prep(P, lds);
    else if (ph == 1) phase_gemm<G_IN>(P, 0, lds);
    else if (ph == 2 || ph == 5) phase_conv(P, ph == 2 ? 0 : 1);
    else if (ph == 3 || ph == 6) phase_mix(P, ph == 3 ? 0 : 1, lds);
    else if (ph == 4) phase_chain<0>(P, lds);
    else if (ph == 7) phase_chain<1>(P, lds);
    else phase_final(P);
  }
}

extern "C" void kernel_launch(void* const* d_in, const int* in_sizes, int n_in, void* d_out, int out_size, void* d_ws, size_t ws_size, hipStream_t stream) {
  static int grid_blocks = 0;
  if (!grid_blocks) {
    int dev = 0, cus = 0, per_cu = 0;
    hipGetDevice(&dev);
    hipDeviceGetAttribute(&cus, hipDeviceAttributeMultiprocessorCount, dev);
    hipFuncSetAttribute((const void*)hymba_fwd, hipFuncAttributeMaxDynamicSharedMemorySize, LDS_BYTES);
    hipOccupancyMaxActiveBlocksPerMultiprocessor(&per_cu, (const void*)hymba_fwd, 256, LDS_BYTES);
    if (per_cu > 2) per_cu = 2;
    if (per_cu < 1) per_cu = 1;
    grid_blocks = cus * per_cu;
    if (ws_size < WS_END) fprintf(stderr, "workspace too small: %zu < %zu\n", ws_size, (size_t)WS_END);
  }
  Params p{};
  const float** ip = (const float**)&p;
  for (int i = 0; i < 27; ++i) ip[i] = (const float*)d_in[i];
  p.out = (float*)d_out; p.ws = (unsigned char*)d_ws; p.ph_lo = 0; p.ph_hi = 9; p.probe = PROBE_BITS;
  void* args[] = {&p};
  hipError_t e = hipLaunchCooperativeKernel((const void*)hymba_fwd, dim3(grid_blocks), dim3(256), args, LDS_BYTES, stream);
  if (e != hipSuccess) fprintf(stderr, "cooperative launch failed: %s (grid %d)\n", hipGetErrorString(e), grid_blocks);
}
```

```cpp
#include <hip/hip_runtime.h>
#include <hip/hip_cooperative_groups.h>
#include <cstdio>
#include <cstdint>
namespace cg = cooperative_groups;

typedef unsigned short bf16_t;
typedef short bf16x8 __attribute__((ext_vector_type(8)));
typedef float f32x4 __attribute__((ext_vector_type(4)));
typedef float f32x2 __attribute__((ext_vector_type(2)));
typedef unsigned u32x4 __attribute__((ext_vector_type(4)));
typedef unsigned u32x2 __attribute__((ext_vector_type(2)));

constexpr int DM = 2048, MP = 8192, MS = 512, MT = MP + MS;
constexpr int SEQ = 2048, NB = 4, DB = 128, DSEQ = 4;
constexpr int INC = 10272, NPROJ = 10240, NPAD = 10368;
constexpr int WA = 2048, NG = 128, NP = 64, NCH = 16;
constexpr int NH = 32, HD = 64, SN = 128, CONVD = 4096;
constexpr float EPS = 1e-5f;

constexpr size_t al256(size_t x) { return (x + 255) & ~(size_t)255; }
constexpr size_t WS_WIN = 0;
constexpr size_t WS_WGLU = WS_WIN + al256((size_t)2 * NPAD * DM * 2);
constexpr size_t WS_WOUT = WS_WGLU + al256((size_t)2 * 2048 * 2048 * 2);
constexpr size_t WS_PROJ = WS_WOUT + al256((size_t)2 * 2048 * 4096 * 2);
constexpr size_t WS_DT = WS_PROJ + al256((size_t)MT * NPROJ * 2);
constexpr size_t WS_G = WS_DT + al256((size_t)MT * 32 * 4);
constexpr size_t WS_ACT = WS_G + al256((size_t)MT * 2048 * 2);
constexpr size_t WS_XRES = WS_ACT + al256((size_t)MT * 4096 * 2);
constexpr size_t WS_XB = WS_XRES + al256((size_t)MT * 2048 * 4);
constexpr size_t WS_SS = WS_XB + al256((size_t)MT * 2048 * 2);
constexpr size_t WS_AB = WS_SS + al256((size_t)9 * MT * 4);
constexpr size_t WS_BBF = WS_AB + al256((size_t)2 * 2 * NG * NP * 4);
constexpr size_t WS_CCF = WS_BBF + al256((size_t)2 * NG * 8 * 64 * 8 * 2);
constexpr size_t WS_CNT = WS_CCF + al256((size_t)2 * NG * 4 * 64 * 8 * 2);
constexpr size_t WS_FLG = WS_CNT + 256;
constexpr size_t WS_XC = WS_FLG + al256((size_t)2 * 2 * 34 * 64);
constexpr size_t WS_DTV = WS_XC + al256((size_t)MT * CONVD * 2);
constexpr size_t WS_END = WS_DTV + al256((size_t)MT * 32 * 4);

constexpr int LDS_BYTES = 73728;
#ifndef PROBE_BITS
#define PROBE_BITS 0
#endif

struct Params {
  const float *x_prompt, *x_sample, *st_s5_re, *st_s5_im, *st_ssd, *cache_conv;
  const float *norm_w, *w_in, *lam_re, *lam_im, *log_step, *b_re, *b_im, *c_re, *c_im, *s5_d;
  const float *glu_w, *glu_b, *s5_norm_w, *conv_w, *conv_b, *dt_bias, *a_log, *ssd_d, *ssd_norm_w, *w_out, *final_w;
  float* out; unsigned char* ws; int ph_lo, ph_hi, probe, pad_;
};

constexpr size_t O_YP = 0;
constexpr size_t O_YS = O_YP + (size_t)MP * DM;
constexpr size_t O_S5RP = O_YS + (size_t)MS * DM;
constexpr size_t O_S5IP = O_S5RP + (size_t)2 * NB * NG * NP;
constexpr size_t O_SSDP = O_S5IP + (size_t)2 * NB * NG * NP;
constexpr size_t O_CONVP = O_SSDP + (size_t)2 * NB * NH * HD * SN;
constexpr size_t O_S5RS = O_CONVP + (size_t)2 * NB * 3 * CONVD;
constexpr size_t O_S5IS = O_S5RS + (size_t)2 * DB * NG * NP;
constexpr size_t O_SSDS = O_S5IS + (size_t)2 * DB * NG * NP;
constexpr size_t O_CONVS = O_SSDS + (size_t)2 * DB * NH * HD * SN;

typedef __bf16 bf16n2 __attribute__((ext_vector_type(2)));
__device__ __forceinline__ unsigned pk2(float lo, float hi) { const f32x2 v = {lo, hi}; return __builtin_bit_cast(unsigned, __builtin_convertvector(v, bf16n2)); }
__device__ __forceinline__ float bflo(unsigned w) { return __uint_as_float(w << 16); }
__device__ __forceinline__ float bfhi(unsigned w) { return __uint_as_float(w & 0xffff0000u); }
__device__ __forceinline__ float bf1(bf16_t h) { return __uint_as_float((unsigned)h << 16); }
__device__ __forceinline__ float sigmoidf_(float x) { return __builtin_amdgcn_rcpf(1.f + __expf(-x)); }
__device__ __forceinline__ float siluf_(float x) { return x * __builtin_amdgcn_rcpf(1.f + __expf(-x)); }
__device__ __forceinline__ float gelu_tanh(float y) { const float z = 0.7978845608028654f * (y + 0.044715f * y * y * y); return y * __builtin_amdgcn_rcpf(1.f + __expf(-2.f * z)); }
__device__ __forceinline__ float wave_sum(float v) {
#pragma unroll
  for (int o = 1; o < 64; o <<= 1) v += __shfl_xor(v, o);
  return v;
}
__device__ __forceinline__ int opaque_tid() { int t = threadIdx.x; asm volatile("" : "+v"(t)); return t; }
__device__ __forceinline__ void st_wt8(void* p, u32x2 v) {
  __hip_atomic_store((unsigned long long*)p, ((unsigned long long)v.y << 32) | v.x, __ATOMIC_RELAXED, __HIP_MEMORY_SCOPE_AGENT);
}
#define LDS_FENCE() asm volatile("s_waitcnt lgkmcnt(0)" ::: "memory")
#define MFMA16(a, b, c) __builtin_amdgcn_mfma_f32_16x16x32_bf16((a), (b), (c), 0, 0, 0)

__device__ __forceinline__ int next_task(int* counter, int* slot) {
  __syncthreads();
  if (threadIdx.x == 0) *slot = atomicAdd(counter, 1);
  __syncthreads();
  return *slot;
}

__device__ __forceinline__ void transpose_tile(const float* W, int K, int N, bf16_t* WT, const float* sc0, const float* sc1, int tile, float* tl) {
  const int tid = opaque_tid();
  const int nkb = K / 64, kb = tile % nkb, nb = tile / nkb, k0 = kb * 64, n0 = nb * 64;
#pragma unroll
  for (int i = 0; i < 4; ++i) {
    const int idx = tid + i * 256, kk = idx >> 4, n4 = (idx & 15) * 4, k = k0 + kk, n = n0 + n4;
    f32x4 v = {0.f, 0.f, 0.f, 0.f};
    if (n < N) { v = *(const f32x4*)(W + (size_t)k * N + n); if (sc0) v *= (k < 2048 ? sc0[k] : sc1[k - 2048]); }
    tl[(n4 + 0) * 65 + kk] = v.x; tl[(n4 + 1) * 65 + kk] = v.y; tl[(n4 + 2) * 65 + kk] = v.z; tl[(n4 + 3) * 65 + kk] = v.w;
  }
  __syncthreads();
  {
    const int n = tid >> 2, kc = (tid & 3) * 16;
    const float* s = tl + n * 65 + kc;
    u32x4 o0, o1;
    o0.x = pk2(s[0], s[1]); o0.y = pk2(s[2], s[3]); o0.z = pk2(s[4], s[5]); o0.w = pk2(s[6], s[7]);
    o1.x = pk2(s[8], s[9]); o1.y = pk2(s[10], s[11]); o1.z = pk2(s[12], s[13]); o1.w = pk2(s[14], s[15]);
    u32x4* dst = (u32x4*)(WT + (size_t)(n0 + n) * K + k0 + kc);
    dst[0] = o0; dst[1] = o1;
  }
  __syncthreads();
}

__device__ __forceinline__ void sincos_own(float ang, float& s, float& c) {
  const float k = rintf(ang * 0.15915494309189535f);
  float r = fmaf(-k, 6.28125f, ang); r = fmaf(-k, 1.9353071795864769e-3f, r);
  const float r2 = r * r;
  float ps = -1.f / 121645100408832000.f;
  ps = fmaf(ps, r2, 1.f / 355687428096000.f);
  ps = fmaf(ps, r2, -1.f / 1307674368000.f);
  ps = fmaf(ps, r2, 1.f / 6227020800.f);
  ps = fmaf(ps, r2, -1.f / 39916800.f);
  ps = fmaf(ps, r2, 1.f / 362880.f);
  ps = fmaf(ps, r2, -1.f / 5040.f);
  ps = fmaf(ps, r2, 1.f / 120.f);
  ps = fmaf(ps, r2, -1.f / 6.f);
  s = fmaf(ps * r2, r, r);
  float pc = 1.f / 2432902008176640000.f;
  pc = fmaf(pc, r2, -1.f / 6402373705728000.f);
  pc = fmaf(pc, r2, 1.f / 20922789888000.f);
  pc = fmaf(pc, r2, -1.f / 87178291200.f);
  pc = fmaf(pc, r2, 1.f / 479001600.f);
  pc = fmaf(pc, r2, -1.f / 3628800.f);
  pc = fmaf(pc, r2, 1.f / 40320.f);
  pc = fmaf(pc, r2, -1.f / 720.f);
  pc = fmaf(pc, r2, 1.f / 24.f);
  pc = fmaf(pc, r2, -0.5f);
  c = fmaf(pc, r2, 1.f);
}

__device__ __forceinline__ void s5_precompute(const Params& P, int l, int g, float* tl) {
  const int tid = opaque_tid();
  float* gre = tl; float* gim = tl + 64;
  if (tid < 64) {
    const int idx = (l * NG + g) * NP + tid;
    const float lr = fminf(P.lam_re[idx], -1e-4f), li = P.lam_im[idx];
    const float step = expf(P.log_step[l * NG + g]);
    const float mag = expf(lr * step);
    float sn, cs; sincos_own(li * step, sn, cs);
    const float abr = mag * cs, abi = mag * sn;
    const float den = lr * lr + li * li, nr = abr - 1.f;
    gre[tid] = (nr * lr + abi * li) / den;
    gim[tid] = (abi * lr - nr * li) / den;
    float* ab = (float*)(P.ws + WS_AB);
    ab[idx] = abr; ab[2 * NG * NP + idx] = abi;
  }
  __syncthreads();
  bf16_t* bbf = (bf16_t*)(P.ws + WS_BBF) + (size_t)(l * NG + g) * 8 * 64 * 8;
  const float* br = P.b_re + (size_t)(l * NG + g) * NP * NCH;
  const float* bi = P.b_im + (size_t)(l * NG + g) * NP * NCH;
  for (int j = 0; j < 16; ++j) {
    const int idx = tid * 16 + j, tile = idx >> 9, lane = (idx >> 3) & 63, e = idx & 7;
    const int pt = tile >> 1, part = tile & 1, p = pt * 16 + (lane & 15), q = lane >> 4, c = q * 8 + e;
    float v = 0.f;
    if (q < 2) { const float a = br[p * NCH + c], b = bi[p * NCH + c]; v = part == 0 ? gre[p] * a - gim[p] * b : gre[p] * b + gim[p] * a; }
    bbf[idx] = (bf16_t)(pk2(v, 0.f) & 0xffff);
  }
  bf16_t* ccf = (bf16_t*)(P.ws + WS_CCF) + (size_t)(l * NG + g) * 4 * 64 * 8;
  const float* cr = P.c_re + (size_t)(l * NG + g) * NCH * NP;
  const float* ci = P.c_im + (size_t)(l * NG + g) * NCH * NP;
  for (int j = 0; j < 8; ++j) {
    const int idx = tid * 8 + j, ks = idx >> 9, lane = (idx >> 3) & 63, e = idx & 7;
    const int c = lane & 15, q = lane >> 4, k = ks * 32 + q * 8 + e, p = k >> 1, part = k & 1;
    const float v = part == 0 ? cr[c * NP + p] : -ci[c * NP + p];
    ccf[idx] = (bf16_t)(pk2(v, 0.f) & 0xffff);
  }
  __syncthreads();
}

constexpr int TW_WIN = 2 * 32 * (NPAD / 64), TW_GLU = 2 * 32 * 32, TW_OUT = 2 * 64 * 32, TW_ALL = TW_WIN + TW_GLU + TW_OUT;
__device__ __forceinline__ void weight_tile_task(const Params& P, int r, float* tl) {
  if (r < TW_WIN) { const int per = 32 * (NPAD / 64), l = r / per; transpose_tile(P.w_in + (size_t)l * DM * INC, DM, INC, (bf16_t*)(P.ws + WS_WIN) + (size_t)l * NPAD * DM, P.norm_w + l * DM, P.norm_w + l * DM, r % per, tl); return; }
  r -= TW_WIN;
  if (r < TW_GLU) { const int per = 32 * 32, l = r / per; transpose_tile(P.glu_w + (size_t)l * 2048 * 2048, 2048, 2048, (bf16_t*)(P.ws + WS_WGLU) + (size_t)l * 2048 * 2048, nullptr, nullptr, r % per, tl); return; }
  r -= TW_GLU;
  { const int per = 64 * 32, l = r / per; transpose_tile(P.w_out + (size_t)l * 4096 * 2048, 4096, 2048, (bf16_t*)(P.ws + WS_WOUT) + (size_t)l * 2048 * 4096, P.s5_norm_w + l * 2048, P.ssd_norm_w + l * 2048, r % per, tl); }
}
__device__ __forceinline__ void deferred_weights(const Params& P, unsigned char* lds) {
  float* tl = (float*)(lds + 64);
  const int grid = gridDim.x, slots = grid >> 3, q = (blockIdx.x & 7) * slots + (blockIdx.x >> 3);
  const int leftover = (34 * 81) % grid;
  int rank = q, n = grid;
  if (leftover != 0) { if (q < leftover) return; rank = q - leftover; n = grid - leftover; }
  __syncthreads();
  for (int r = 32 * (NPAD / 64) + rank; r < TW_ALL; r += n) weight_tile_task(P, r, tl);
}

__device__ __forceinline__ void phase_prep(const Params& P, unsigned char* lds) {
  float* tl = (float*)(lds + 64);
  const int tid = opaque_tid(), lane = tid & 63, wave = tid >> 6;
  {
    float* ss = (float*)(P.ws + WS_SS);
    for (int i = blockIdx.x * 256 + tid; i < 8 * MT; i += gridDim.x * 256) ss[MT + i] = 0.f;
    if (blockIdx.x == 0 && tid < 64) ((int*)(P.ws + WS_CNT))[tid] = 0;
    if (blockIdx.x == 1) for (int i = tid; i < 2 * 2 * 34 * 16; i += 256) ((int*)(P.ws + WS_FLG))[i] = 0;
  }
  constexpr int T_W0 = 32 * (NPAD / 64), T_X = MT / 4, T_S5 = 2 * NG;
  constexpr int T_ALL = T_W0 + T_X + T_S5;
  for (int t = blockIdx.x; t < T_ALL; t += gridDim.x) {
    int r = t;
    if (r < T_W0) { weight_tile_task(P, r, tl); continue; }
    r -= T_W0;
    if (r < T_X) {
      const int row = r * 4 + wave;
      const float* src = row < MP ? P.x_prompt + (size_t)row * DM : P.x_sample + (size_t)(row - MP) * DM;
      bf16_t* dst = (bf16_t*)(P.ws + WS_XB) + (size_t)row * DM;
      float s = 0.f;
#pragma unroll
      for (int j = 0; j < 8; ++j) {
        const f32x4 v = *(const f32x4*)(src + (j * 64 + lane) * 4);
        s += v.x * v.x + v.y * v.y + v.z * v.z + v.w * v.w;
        u32x2 o; o.x = pk2(v.x, v.y); o.y = pk2(v.z, v.w);
        *(u32x2*)(dst + (j * 64 + lane) * 4) = o;
      }
      s = wave_sum(s);
      if (lane == 0) ((float*)(P.ws + WS_SS))[row] = s;
      continue;
    }
    r -= T_X;
    s5_precompute(P, r / NG, r % NG, tl);
  }
}

constexpr int G_IN = 0, G_GLU = 1, G_OUT = 2;

__device__ __forceinline__ bool gemm_unit_of(int v, int NT, int& pm, int& pn) {
  const int total = 34 * NT;
  if (v >= total) return false;
  const int ng = NT >> 3, rem = NT & 7;
  if (v < ng * 272) { const int pg = v / 272, w = v % 272; pm = w >> 3; pn = pg * 8 + (w & 7); }
  else { const int w = v - ng * 272; pm = w / rem; pn = ng * 8 + w % rem; }
  return true;
}

template <int MODE>
__device__ __forceinline__ void gemm_unit(const Params& P, int l, int pm, int pn, unsigned char* lds, int dummy) {
  constexpr int K = MODE == G_OUT ? 4096 : 2048;
  constexpr int NK = K / 32;
  const bf16_t* A = MODE == G_IN ? (const bf16_t*)(P.ws + WS_XB) : MODE == G_GLU ? (const bf16_t*)(P.ws + WS_G) : (const bf16_t*)(P.ws + WS_ACT);
  const bf16_t* Bt = MODE == G_IN ? (const bf16_t*)(P.ws + WS_WIN) + (size_t)l * NPAD * DM
                   : MODE == G_GLU ? (const bf16_t*)(P.ws + WS_WGLU) + (size_t)l * 2048 * 2048
                                   : (const bf16_t*)(P.ws + WS_WOUT) + (size_t)l * 2048 * 4096;
  const int tid = opaque_tid(), lane = tid & 63, wave = tid >> 6, wr = wave >> 1, wc = wave & 1, fr = lane & 15, fq = lane >> 4;
  unsigned char* base = lds + 64;
  const int grow = tid >> 2, gch = (tid & 3) ^ ((((tid >> 2) >> 3) & 1) << 1);
  const bf16_t* Ag = A + (size_t)(pm * 256 + grow) * K + gch * 8;
  const bf16_t* Bg = Bt + (size_t)(pn * 128 + grow) * K + gch * 8;
  const int swz = (fq ^ ((fr >> 3) << 1)) << 4;
  const int a_rd = (wr * 128 + fr) * 64 + swz;
  const int b_rd = 16384 + (wc * 64 + fr) * 64 + swz;

  f32x4 acc[8][4];
#pragma unroll
  for (int mi = 0; mi < 8; ++mi)
#pragma unroll
    for (int ni = 0; ni < 4; ++ni) acc[mi][ni] = (f32x4){0.f, 0.f, 0.f, 0.f};

  auto stage_tile = [&](int kt, unsigned char* st) __attribute__((always_inline)) {
#pragma unroll
    for (int i = 0; i < 4; ++i) __builtin_amdgcn_global_load_lds((const unsigned*)(Ag + (size_t)i * 64 * K + kt * 32), (unsigned*)(st + (tid + i * 256) * 16), 16, 0, 0);
#pragma unroll
    for (int i = 0; i < 2; ++i) __builtin_amdgcn_global_load_lds((const unsigned*)(Bg + (size_t)i * 64 * K + kt * 32), (unsigned*)(st + 16384 + (tid + i * 256) * 16), 16, 0, 0);
  };
  stage_tile(0, base);
  __syncthreads();

  for (int kt = 0; kt < NK; ++kt) {
    unsigned char* cur = base + (kt & 1) * 24576;
    unsigned char* nxt = base + ((kt & 1) ^ 1) * 24576;
    if (kt + 1 < NK) stage_tile(kt + 1, nxt);
    __builtin_amdgcn_sched_barrier(0);
    if (MODE == G_OUT && kt == NK / 2) {
      const float* ssa = (const float*)(P.ws + WS_SS) + (3 + l) * MT;
      const float* sss = (const float*)(P.ws + WS_SS) + (5 + l) * MT;
#pragma unroll
      for (int mi = 0; mi < 8; ++mi) {
        const int row = pm * 256 + wr * 128 + mi * 16 + fr;
        const float ra = rsqrtf(ssa[row] * (1.f / 2048.f) + EPS), rs = rsqrtf(sss[row] * (1.f / 2048.f) + EPS);
        const float ratio = ra / rs;
#pragma unroll
        for (int ni = 0; ni < 4; ++ni) acc[mi][ni] *= ratio;
      }
    }
    bf16x8 af[8], bfr[4];
#pragma unroll
    for (int mi = 0; mi < 8; ++mi) af[mi] = *(const bf16x8*)(cur + a_rd + mi * 1024);
#pragma unroll
    for (int ni = 0; ni < 4; ++ni) bfr[ni] = *(const bf16x8*)(cur + b_rd + ni * 1024);
    __builtin_amdgcn_s_setprio(1);
#pragma unroll
    for (int mi = 0; mi < 8; ++mi)
#pragma unroll
      for (int ni = 0; ni < 4; ++ni) acc[mi][ni] = MFMA16(bfr[ni], af[mi], acc[mi][ni]);
    __builtin_amdgcn_s_setprio(0);
    __syncthreads();
  }

  const int row0 = pm * 256 + wr * 128 + fr, col0 = pn * 128 + wc * 64 + fq * 4;
  if (MODE == G_IN) {
    const float* ssx = (const float*)(P.ws + WS_SS) + l * MT;
    bf16_t* proj = (bf16_t*)(P.ws + WS_PROJ);
    float* dtb = (float*)(P.ws + WS_DT);
#pragma unroll
    for (int mi = 0; mi < 8; ++mi) {
      const int row = row0 + mi * 16;
      const float rs = rsqrtf(ssx[row] * (1.f / 2048.f) + EPS);
#pragma unroll
      for (int ni = 0; ni < 4; ++ni) {
        const f32x4 v = acc[mi][ni] * rs;
        const int col = col0 + ni * 16;
        if (pn < 80) { u32x2 o; o.x = pk2(v.x, v.y); o.y = pk2(v.z, v.w); *(u32x2*)(proj + (size_t)row * NPROJ + col) = o; }
        else if (col < NPROJ + 32) { *(f32x4*)(dtb + (size_t)row * 32 + (col - NPROJ)) = v; }
      }
    }
  } else if (MODE == G_GLU) {
    const bf16_t* gbuf = (const bf16_t*)(P.ws + WS_G);
    const bf16_t* proj = (const bf16_t*)(P.ws + WS_PROJ);
    bf16_t* act = (bf16_t*)(P.ws + WS_ACT);
    float* ssa = (float*)(P.ws + WS_SS) + (dummy ? 7 : 3 + l) * MT;
    const float* gb_ = P.glu_b + l * 2048;
#pragma unroll
    for (int mi = 0; mi < 8; ++mi) {
      const int row = row0 + mi * 16;
      float ss = 0.f;
#pragma unroll
      for (int ni = 0; ni < 4; ++ni) {
        const int col = col0 + ni * 16;
        const f32x4 bv = *(const f32x4*)(gb_ + col);
        const u32x2 gw = *(const u32x2*)(gbuf + (size_t)row * 2048 + col);
        const u32x2 zw = *(const u32x2*)(proj + (size_t)row * NPROJ + 2048 + col);
        const f32x4 a = acc[mi][ni] + bv;
        const float v0 = bflo(gw.x) * sigmoidf_(a.x) * siluf_(bflo(zw.x));
        const float v1 = bfhi(gw.x) * sigmoidf_(a.y) * siluf_(bfhi(zw.x));
        const float v2 = bflo(gw.y) * sigmoidf_(a.z) * siluf_(bflo(zw.y));
        const float v3 = bfhi(gw.y) * sigmoidf_(a.w) * siluf_(bfhi(zw.y));
        ss += v0 * v0 + v1 * v1 + v2 * v2 + v3 * v3;
        u32x2 o; o.x = pk2(v0, v1); o.y = pk2(v2, v3);
        st_wt8(act + (size_t)row * 4096 + col, o);
      }
      ss += __shfl_xor(ss, 16); ss += __shfl_xor(ss, 32);
      if (fq == 0) atomicAdd(ssa + row, ss);
    }
  } else {
    const float* sss = (const float*)(P.ws + WS_SS) + (5 + l) * MT;
    float* ssx = (float*)(P.ws + WS_SS) + (l + 1) * MT;
    float* xres = (float*)(P.ws + WS_XRES);
    bf16_t* xb = (bf16_t*)(P.ws + WS_XB);
#pragma unroll
    for (int mi = 0; mi < 8; ++mi) {
      const int row = row0 + mi * 16;
      const float rs = rsqrtf(sss[row] * (1.f / 2048.f) + EPS);
      const float* xold = l == 0 ? (row < MP ? P.x_prompt + (size_t)row * DM : P.x_sample + (size_t)(row - MP) * DM) : xres + (size_t)row * DM;
      float ss = 0.f;
#pragma unroll
      for (int ni = 0; ni < 4; ++ni) {
        const int col = col0 + ni * 16;
        const f32x4 xo = *(const f32x4*)(xold + col);
        const f32x4 v = xo + acc[mi][ni] * rs;
        ss += v.x * v.x + v.y * v.y + v.z * v.z + v.w * v.w;
        st_wt8(xres + (size_t)row * DM + col, (u32x2){__float_as_uint(v.x), __float_as_uint(v.y)});
        st_wt8(xres + (size_t)row * DM + col + 2, (u32x2){__float_as_uint(v.z), __float_as_uint(v.w)});
        u32x2 o; o.x = pk2(v.x, v.y); o.y = pk2(v.z, v.w);
        st_wt8(xb + (size_t)row * DM + col, o);
      }
      ss += __shfl_xor(ss, 16); ss += __shfl_xor(ss, 32);
      if (fq == 0) atomicAdd(ssx + row, ss);
    }
  }
}

template <int MODE>
__device__ __forceinline__ void phase_gemm(const Params& P, int l, unsigned char* lds, int dummy = 0) {
  constexpr int NT = MODE == G_IN ? 81 : 16;
  const int slots = gridDim.x >> 3, xcd = blockIdx.x & 7, slot = blockIdx.x >> 3;
  for (int i = 0;; ++i) {
    const int v = (i * 8 + xcd) * slots + slot;
    int pm, pn;
    if (!gemm_unit_of(v, NT, pm, pn)) break;
    gemm_unit<MODE>(P, l, pm, pn, lds, dummy);
  }
}


__device__ __forceinline__ int* panel_flag(const Params& P, int l, int kind, int pm) { return (int*)(P.ws + WS_FLG) + ((l * 2 + kind) * 34 + pm) * 16; }
__device__ __forceinline__ void panel_wait(int* flag, int need) {
  if (threadIdx.x == 0) { while (__hip_atomic_load(flag, __ATOMIC_RELAXED, __HIP_MEMORY_SCOPE_AGENT) < need) __builtin_amdgcn_s_sleep(4); }
  __syncthreads();
  asm volatile("" ::: "memory");
}
__device__ __forceinline__ void panel_signal(int* flag) {
  asm volatile("s_waitcnt vmcnt(0)" ::: "memory");
  __syncthreads();
  if (threadIdx.x == 0) __hip_atomic_fetch_add(flag, 1, __ATOMIC_RELAXED, __HIP_MEMORY_SCOPE_AGENT);
}
__device__ __forceinline__ void phase_chain(const Params& P, int l, unsigned char* lds) {
  const int nGLU = 34 * 16, nOUT = 34 * 16, nIN = l == 0 ? 34 * 81 : 0, total = nGLU + nOUT + nIN;
  const int slots = gridDim.x >> 3, xcd = blockIdx.x & 7, slot = blockIdx.x >> 3;
  for (int i = 0;; ++i) {
    const int v = (i * 8 + xcd) * slots + slot;
    if (v >= total) break;
    int pm, pn;
    if (v < nGLU) {
      gemm_unit_of(v, 16, pm, pn);
      gemm_unit<G_GLU>(P, l, pm, pn, lds, 0);
      panel_signal(panel_flag(P, l, 0, pm));
    } else if (v < nGLU + nOUT) {
      gemm_unit_of(v - nGLU, 16, pm, pn);
      panel_wait(panel_flag(P, l, 0, pm), 16);
      gemm_unit<G_OUT>(P, l, pm, pn, lds, 0);
      panel_signal(panel_flag(P, l, 1, pm));
    } else {
      gemm_unit_of(v - nGLU - nOUT, 81, pm, pn);
      panel_wait(panel_flag(P, l, 1, pm), 16);
      gemm_unit<G_IN>(P, l + 1, pm, pn, lds, 0);
    }
  }
}

__device__ __forceinline__ void conv8(const u32x4* r, int i, const f32x4* w, const f32x4* bias, float* o) {
#pragma unroll
  for (int hf = 0; hf < 2; ++hf) {
    f32x4 a = bias[hf];
#pragma unroll
    for (int k = 0; k < 4; ++k) {
      const u32x4 rv = r[i + k];
      const unsigned w0 = hf == 0 ? rv.x : rv.z, w1 = hf == 0 ? rv.y : rv.w;
      const f32x4 wk = w[k * 2 + hf];
      a.x = fmaf(wk.x, bflo(w0), a.x); a.y = fmaf(wk.y, bfhi(w0), a.y);
      a.z = fmaf(wk.z, bflo(w1), a.z); a.w = fmaf(wk.w, bfhi(w1), a.w);
    }
    o[hf * 4 + 0] = siluf_(a.x); o[hf * 4 + 1] = siluf_(a.y); o[hf * 4 + 2] = siluf_(a.z); o[hf * 4 + 3] = siluf_(a.w);
  }
}
__device__ __forceinline__ void store8f(float* dst, u32x4 v) {
  *(f32x4*)dst = (f32x4){bflo(v.x), bfhi(v.x), bflo(v.y), bfhi(v.y)};
  *(f32x4*)(dst + 4) = (f32x4){bflo(v.z), bfhi(v.z), bflo(v.w), bfhi(v.w)};
}

__device__ __forceinline__ void phase_conv(const Params& P, int l) {
  const int tid = opaque_tid();
  const int gsz = gridDim.x * 256, gid = blockIdx.x * 256 + tid;
  const bf16_t* proj = (const bf16_t*)(P.ws + WS_PROJ);
  bf16_t* xc = (bf16_t*)(P.ws + WS_XC);
  const float* cw = P.conv_w + (size_t)l * 4 * CONVD;
  const float* cb = P.conv_b + (size_t)l * CONVD;
#pragma unroll 1
  for (int it = gid; it < (MP / 8) * 512; it += gsz) {
    const int ch0 = (it & 511) * 8, row0 = (it >> 9) * 8, t0 = row0 & (SEQ - 1);
    u32x4 r[11];
#pragma unroll
    for (int j = 0; j < 11; ++j) {
      r[j] = (u32x4){0u, 0u, 0u, 0u};
      if (t0 - 3 + j >= 0) r[j] = *(const u32x4*)(proj + (size_t)(row0 - 3 + j) * NPROJ + 4096 + ch0);
    }
    f32x4 w[8], bias[2];
#pragma unroll
    for (int k = 0; k < 4; ++k) { w[k * 2] = *(const f32x4*)(cw + k * CONVD + ch0); w[k * 2 + 1] = *(const f32x4*)(cw + k * CONVD + ch0 + 4); }
    bias[0] = *(const f32x4*)(cb + ch0); bias[1] = *(const f32x4*)(cb + ch0 + 4);
#pragma unroll
    for (int i = 0; i < 8; ++i) {
      float o[8]; conv8(r, i, w, bias, o);
      u32x4 q; q.x = pk2(o[0], o[1]); q.y = pk2(o[2], o[3]); q.z = pk2(o[4], o[5]); q.w = pk2(o[6], o[7]);
      *(u32x4*)(xc + (size_t)(row0 + i) * CONVD + ch0) = q;
    }
    if (t0 == SEQ - 8) {
      const int bb = row0 >> 11;
#pragma unroll
      for (int j = 0; j < 3; ++j) store8f(P.out + O_CONVP + ((size_t)(l * NB + bb) * 3 + j) * CONVD + ch0, r[8 + j]);
    }
  }
#pragma unroll 1
  for (int it = gid; it < DB * 512; it += gsz) {
    const int ch0 = (it & 511) * 8, bb = it >> 9, row0 = MP + bb * 4;
    u32x4 r[7];
#pragma unroll
    for (int j = 0; j < 3; ++j) {
      const float* cp = P.cache_conv + ((size_t)(l * DB + bb) * 3 + j) * CONVD + ch0;
      const f32x4 c0 = *(const f32x4*)cp, c1 = *(const f32x4*)(cp + 4);
      r[j].x = pk2(c0.x, c0.y); r[j].y = pk2(c0.z, c0.w); r[j].z = pk2(c1.x, c1.y); r[j].w = pk2(c1.z, c1.w);
    }
#pragma unroll
    for (int j = 0; j < 4; ++j) r[3 + j] = *(const u32x4*)(proj + (size_t)(row0 + j) * NPROJ + 4096 + ch0);
    f32x4 w[8], bias[2];
#pragma unroll
    for (int k = 0; k < 4; ++k) { w[k * 2] = *(const f32x4*)(cw + k * CONVD + ch0); w[k * 2 + 1] = *(const f32x4*)(cw + k * CONVD + ch0 + 4); }
    bias[0] = *(const f32x4*)(cb + ch0); bias[1] = *(const f32x4*)(cb + ch0 + 4);
#pragma unroll
    for (int i = 0; i < 4; ++i) {
      float o[8]; conv8(r, i, w, bias, o);
      u32x4 q; q.x = pk2(o[0], o[1]); q.y = pk2(o[2], o[3]); q.z = pk2(o[4], o[5]); q.w = pk2(o[6], o[7]);
      *(u32x4*)(xc + (size_t)(row0 + i) * CONVD + ch0) = q;
    }
#pragma unroll
    for (int j = 0; j < 3; ++j) store8f(P.out + O_CONVS + ((size_t)(l * DB + bb) * 3 + j) * CONVD + ch0, r[4 + j]);
  }
  {
    const float* dtb = (const float*)(P.ws + WS_DT);
    float* dtv = (float*)(P.ws + WS_DTV);
    for (int i = gid; i < MT * 32; i += gsz) {
      const float x = dtb[i] + P.dt_bias[l * NH + (i & 31)];
      dtv[i] = fmaxf(x, 0.f) + log1pf(__expf(-fabsf(x)));
    }
  }
}

template <int MODE>
__device__ __forceinline__ void s5_wave(const Params& P, int l, int g, int rowbase, int nchunks, unsigned char* wl, float& hr, float& hi,
                                        const bf16x8 (&bbf)[8], const bf16x8 (&ccf)[4], float ar, float ai) {
  const int lane = opaque_tid() & 63, fr = lane & 15, fq = lane >> 4;
  unsigned char* bu = wl; unsigned char* Hb = wl + 8192;
  const bf16_t* proj = (const bf16_t*)(P.ws + WS_PROJ);
  bf16_t* gbuf = (bf16_t*)(P.ws + WS_G);
  f32x4 dv = {0.f, 0.f, 0.f, 0.f};
  if (MODE != 0) dv = *(const f32x4*)(P.s5_d + l * WA + g * NCH + fq * 4);
  const bf16x8 zero8 = {0, 0, 0, 0, 0, 0, 0, 0};
  bf16x8 uf = zero8;
  if (fq < 2) uf = *(const bf16x8*)(proj + (size_t)(rowbase + fr) * NPROJ + g * NCH + fq * 8);
#pragma unroll 1
  for (int c = 0; c < nchunks; ++c) {
    const int row0 = rowbase + c * 16;
    f32x4 t[8];
#pragma unroll
    for (int i = 0; i < 8; ++i) t[i] = MFMA16(uf, bbf[i], ((f32x4){0.f, 0.f, 0.f, 0.f}));
    u32x2 uw = {0u, 0u};
    if (MODE != 0) uw = *(const u32x2*)(proj + (size_t)(row0 + fr) * NPROJ + g * NCH + fq * 4);
    if (c + 1 < nchunks) { if (fq < 2) uf = *(const bf16x8*)(proj + (size_t)(row0 + 16 + fr) * NPROJ + g * NCH + fq * 8); }
#pragma unroll
    for (int pt = 0; pt < 4; ++pt)
#pragma unroll
      for (int r = 0; r < 4; ++r) {
        f32x2 v; v.x = t[2 * pt][r]; v.y = t[2 * pt + 1][r];
        *(f32x2*)(bu + (fq * 4 + r) * 512 + (pt * 16 + fr) * 8) = v;
      }
    LDS_FENCE();
#pragma unroll
    for (int tt = 0; tt < 16; ++tt) {
      if (MODE == 2 && (tt & 3) == 0) {
        const int b = ((row0 - MP) >> 2) + (tt >> 2);
        hr = P.st_s5_re[((size_t)(l * DB + b) * NG + g) * NP + lane];
        hi = P.st_s5_im[((size_t)(l * DB + b) * NG + g) * NP + lane];
      }
      const f32x2 bv = *(const f32x2*)(bu + tt * 512 + lane * 8);
      const float nr = fmaf(ar, hr, fmaf(-ai, hi, bv.x));
      const float ni = fmaf(ar, hi, fmaf(ai, hr, bv.y));
      hr = nr; hi = ni;
      if (MODE != 0) *(unsigned*)(Hb + tt * 272 + lane * 4) = pk2(hr, hi);
      if (MODE == 2 && (tt & 3) == 3) {
        const int b = ((row0 - MP) >> 2) + (tt >> 2);
        P.out[O_S5RS + ((size_t)(l * DB + b) * NG + g) * NP + lane] = hr;
        P.out[O_S5IS + ((size_t)(l * DB + b) * NG + g) * NP + lane] = hi;
      }
    }
    LDS_FENCE();
    if (MODE != 0) {
      f32x4 y = {0.f, 0.f, 0.f, 0.f};
#pragma unroll
      for (int ks = 0; ks < 4; ++ks) {
        const bf16x8 hf = *(const bf16x8*)(Hb + fr * 272 + ks * 64 + fq * 16);
        y = MFMA16(ccf[ks], hf, y);
      }
      LDS_FENCE();
      const float y0 = gelu_tanh(y.x + dv.x * bflo(uw.x)), y1 = gelu_tanh(y.y + dv.y * bfhi(uw.x));
      const float y2 = gelu_tanh(y.z + dv.z * bflo(uw.y)), y3 = gelu_tanh(y.w + dv.w * bfhi(uw.y));
      u32x2 o; o.x = pk2(y0, y1); o.y = pk2(y2, y3);
      *(u32x2*)(gbuf + (size_t)(row0 + fr) * 2048 + g * NCH + fq * 4) = o;
    }
  }
}

constexpr int L_S5X = 64 + 4 * 12544;
template <bool SAMPLE>
__device__ __forceinline__ void s5_block_task(const Params& P, int l, int g, int b, unsigned char* lds) {
  const int tid = opaque_tid(), lane = tid & 63, wave = tid >> 6;
  const bf16x8* bbp = (const bf16x8*)((const bf16_t*)(P.ws + WS_BBF) + (size_t)(l * NG + g) * 8 * 64 * 8);
  const bf16x8* ccp = (const bf16x8*)((const bf16_t*)(P.ws + WS_CCF) + (size_t)(l * NG + g) * 4 * 64 * 8);
  bf16x8 bbf[8], ccf[4];
#pragma unroll
  for (int i = 0; i < 8; ++i) bbf[i] = bbp[i * 64 + lane];
#pragma unroll
  for (int i = 0; i < 4; ++i) ccf[i] = ccp[i * 64 + lane];
  const float* ab = (const float*)(P.ws + WS_AB);
  const float ar = ab[(l * NG + g) * NP + lane], ai = ab[2 * NG * NP + (l * NG + g) * NP + lane];
  unsigned char* wl = lds + 64 + wave * 12544;
  float hr = 0.f, hi = 0.f;
  if (SAMPLE) {
    s5_wave<2>(P, l, g, MP + wave * 128, 8, wl, hr, hi, bbf, ccf, ar, ai);
  } else {
    const int rowbase = b * SEQ + (wave < 3 ? wave * 448 : 1344), nch = wave < 3 ? 28 : 44;
    if (wave < 3) s5_wave<0>(P, l, g, rowbase, 28, wl, hr, hi, bbf, ccf, ar, ai);
    f32x2* xch = (f32x2*)(lds + L_S5X);
    xch[wave * 64 + lane] = (f32x2){hr, hi};
    float pr = ar, pi = ai;
#pragma unroll
    for (int i = 0; i < 6; ++i) { const float nr = pr * pr - pi * pi, ni = 2.f * pr * pi; pr = nr; pi = ni; }
    const float q64r = pr, q64i = pi;
    { const float nr = pr * pr - pi * pi, ni = 2.f * pr * pi; pr = nr; pi = ni; }
    const float q128r = pr, q128i = pi;
    { const float nr = pr * pr - pi * pi, ni = 2.f * pr * pi; pr = nr; pi = ni; }
    { const float tr = pr * q128r - pi * q128i, ti = pr * q128i + pi * q128r; pr = tr * q64r - ti * q64i; pi = tr * q64i + ti * q64r; }
    __syncthreads();
    hr = 0.f; hi = 0.f;
    for (int j = 0; j < wave; ++j) {
      const f32x2 e = xch[j * 64 + lane];
      const float nr = fmaf(pr, hr, fmaf(-pi, hi, e.x)), ni = fmaf(pr, hi, fmaf(pi, hr, e.y));
      hr = nr; hi = ni;
    }
    s5_wave<1>(P, l, g, rowbase, nch, wl, hr, hi, bbf, ccf, ar, ai);
    if (wave == 3) {
      P.out[O_S5RP + ((size_t)(l * NB + b) * NG + g) * NP + lane] = hr;
      P.out[O_S5IP + ((size_t)(l * NB + b) * NG + g) * NP + lane] = hi;
    }
  }
}

constexpr int L_CN = 64, L_BN = L_CN + 17408, L_BT = L_BN + 17408, L_XT = L_BT + 18432, L_MM = L_XT + 9216, L_DT = L_MM + 9216, L_CS = L_DT + 256;

__device__ __forceinline__ void ssd_prompt_task(const Params& P, int l, int b, int h, unsigned char* lds, int dummy) {
  const int tid = opaque_tid(), lane = tid & 63, wave = tid >> 6, fr = lane & 15, fq = lane >> 4;
  const int gi = h >> 2, pw = wave * 16;
  const bf16_t* proj = (const bf16_t*)(P.ws + WS_PROJ);
  const bf16_t* xc = (const bf16_t*)(P.ws + WS_XC);
  const float* dtvb = (const float*)(P.ws + WS_DTV);
  bf16_t* act = (bf16_t*)(P.ws + WS_ACT);
  float* sss = (float*)(P.ws + WS_SS) + (dummy ? 8 : 5 + l) * MT;
  const float a_h = -expf(P.a_log[l * NH + h]), dsk = P.ssd_d[l * NH + h];
  f32x4 S[8];
#pragma unroll
  for (int i = 0; i < 8; ++i) S[i] = (f32x4){0.f, 0.f, 0.f, 0.f};
  const int crow = tid >> 4, cch = tid & 15;
  u32x4 pc[4], pb[4], px[2]; float pdt;
  {
    const bf16_t* base = xc + (size_t)(b * SEQ) * CONVD;
#pragma unroll
    for (int i = 0; i < 4; ++i) pc[i] = *(const u32x4*)(base + (size_t)(i * 16 + crow) * CONVD + 3072 + gi * 128 + cch * 8);
#pragma unroll
    for (int i = 0; i < 2; ++i) {
      pb[i * 2] = *(const u32x4*)(base + (size_t)((i * 16 + crow) * 2) * CONVD + 2048 + gi * 128 + cch * 8);
      pb[i * 2 + 1] = *(const u32x4*)(base + (size_t)((i * 16 + crow) * 2 + 1) * CONVD + 2048 + gi * 128 + cch * 8);
    }
    px[0] = *(const u32x4*)(base + (size_t)((tid >> 3) * 2) * CONVD + h * 64 + (tid & 7) * 8);
    px[1] = *(const u32x4*)(base + (size_t)((tid >> 3) * 2 + 1) * CONVD + h * 64 + (tid & 7) * 8);
    pdt = dtvb[(size_t)(b * SEQ + lane) * 32 + h];
  }
#pragma unroll 1
  for (int c = 0; c < SEQ / 64; ++c) {
    const int rowc = b * SEQ + c * 64;
    float* DTs = (float*)(lds + L_DT + (c & 1) * 512); float* CSs = DTs + 64;
    {
      float cs = pdt * a_h;
#pragma unroll
      for (int o = 1; o < 64; o <<= 1) { const float v = __shfl_up(cs, o); if (lane >= o) cs += v; }
      if (wave == 0) { DTs[lane] = pdt; CSs[lane] = cs; }
    }
    __syncthreads();
    const float cs_end = CSs[63];
    {
#pragma unroll
      for (int i = 0; i < 4; ++i) *(u32x4*)(lds + L_CN + (i * 16 + crow) * 272 + cch * 16) = pc[i];
#pragma unroll
      for (int i = 0; i < 2; ++i) {
        const int t0 = (i * 16 + crow) * 2;
        const u32x4 v0 = pb[i * 2], v1 = pb[i * 2 + 1];
        *(u32x4*)(lds + L_BN + t0 * 272 + cch * 16) = v0;
        *(u32x4*)(lds + L_BN + (t0 + 1) * 272 + cch * 16) = v1;
        const float d0 = __expf(cs_end - CSs[t0]) * DTs[t0], d1 = __expf(cs_end - CSs[t0 + 1]) * DTs[t0 + 1];
        unsigned char* bt = lds + L_BT + (cch * 8) * 144 + t0 * 2;
        *(unsigned*)(bt + 0 * 144) = pk2(bflo(v0.x) * d0, bflo(v1.x) * d1);
        *(unsigned*)(bt + 1 * 144) = pk2(bfhi(v0.x) * d0, bfhi(v1.x) * d1);
        *(unsigned*)(bt + 2 * 144) = pk2(bflo(v0.y) * d0, bflo(v1.y) * d1);
        *(unsigned*)(bt + 3 * 144) = pk2(bfhi(v0.y) * d0, bfhi(v1.y) * d1);
        *(unsigned*)(bt + 4 * 144) = pk2(bflo(v0.z) * d0, bflo(v1.z) * d1);
        *(unsigned*)(bt + 5 * 144) = pk2(bfhi(v0.z) * d0, bfhi(v1.z) * d1);
        *(unsigned*)(bt + 6 * 144) = pk2(bflo(v0.w) * d0, bflo(v1.w) * d1);
        *(unsigned*)(bt + 7 * 144) = pk2(bfhi(v0.w) * d0, bfhi(v1.w) * d1);
      }
      {
        const u32x4 v0 = px[0], v1 = px[1];
        unsigned char* xt = lds + L_XT + ((tid & 7) * 8) * 144 + (tid >> 3) * 4;
        *(unsigned*)(xt + 0 * 144) = (v0.x & 0xffffu) | (v1.x << 16);
        *(unsigned*)(xt + 1 * 144) = (v0.x >> 16) | (v1.x & 0xffff0000u);
        *(unsigned*)(xt + 2 * 144) = (v0.y & 0xffffu) | (v1.y << 16);
        *(unsigned*)(xt + 3 * 144) = (v0.y >> 16) | (v1.y & 0xffff0000u);
        *(unsigned*)(xt + 4 * 144) = (v0.z & 0xffffu) | (v1.z << 16);
        *(unsigned*)(xt + 5 * 144) = (v0.z >> 16) | (v1.z & 0xffff0000u);
        *(unsigned*)(xt + 6 * 144) = (v0.w & 0xffffu) | (v1.w << 16);
        *(unsigned*)(xt + 7 * 144) = (v0.w >> 16) | (v1.w & 0xffff0000u);
      }
    }
    if (c + 1 < SEQ / 64) {
      const bf16_t* base = xc + (size_t)(rowc + 64) * CONVD;
#pragma unroll
      for (int i = 0; i < 4; ++i) pc[i] = *(const u32x4*)(base + (size_t)(i * 16 + crow) * CONVD + 3072 + gi * 128 + cch * 8);
#pragma unroll
      for (int i = 0; i < 2; ++i) {
        pb[i * 2] = *(const u32x4*)(base + (size_t)((i * 16 + crow) * 2) * CONVD + 2048 + gi * 128 + cch * 8);
        pb[i * 2 + 1] = *(const u32x4*)(base + (size_t)((i * 16 + crow) * 2 + 1) * CONVD + 2048 + gi * 128 + cch * 8);
      }
      px[0] = *(const u32x4*)(base + (size_t)((tid >> 3) * 2) * CONVD + h * 64 + (tid & 7) * 8);
      px[1] = *(const u32x4*)(base + (size_t)((tid >> 3) * 2 + 1) * CONVD + h * 64 + (tid & 7) * 8);
      pdt = dtvb[(size_t)(rowc + 64 + lane) * 32 + h];
    }
    __syncthreads();
    u32x2 zwv[4];
#pragma unroll
    for (int tt = 0; tt < 4; ++tt) zwv[tt] = *(const u32x2*)(proj + (size_t)(rowc + tt * 16 + fr) * NPROJ + 8192 + h * 64 + pw + fq * 4);
    {
      bf16x8 cf[4];
#pragma unroll
      for (int ks = 0; ks < 4; ++ks) cf[ks] = *(const bf16x8*)(lds + L_CN + (wave * 16 + fr) * 272 + ks * 64 + fq * 16);
      const int tcol = wave * 16 + fr; const float cst = CSs[tcol];
#pragma unroll
      for (int st = 0; st < 4; ++st) {
        f32x4 g = {0.f, 0.f, 0.f, 0.f};
#pragma unroll
        for (int ks = 0; ks < 4; ++ks) {
          const bf16x8 bf = *(const bf16x8*)(lds + L_BN + (st * 16 + fr) * 272 + ks * 64 + fq * 16);
          g = MFMA16(bf, cf[ks], g);
        }
        float m[4];
#pragma unroll
        for (int r = 0; r < 4; ++r) {
          const int s_ = st * 16 + fq * 4 + r;
          m[r] = s_ <= tcol ? g[r] * __expf(cst - CSs[s_]) * DTs[s_] : 0.f;
        }
        u32x2 o; o.x = pk2(m[0], m[1]); o.y = pk2(m[2], m[3]);
        *(u32x2*)(lds + L_MM + tcol * 144 + (st * 16 + fq * 4) * 2) = o;
      }
    }
    __syncthreads();
    {
      bf16x8 sf[4];
#pragma unroll
      for (int ks = 0; ks < 4; ++ks) {
        u32x4 v; v.x = pk2(S[2 * ks].x, S[2 * ks].y); v.y = pk2(S[2 * ks].z, S[2 * ks].w); v.z = pk2(S[2 * ks + 1].x, S[2 * ks + 1].y); v.w = pk2(S[2 * ks + 1].z, S[2 * ks + 1].w);
        sf[ks] = __builtin_bit_cast(bf16x8, v);
      }
      bf16x8 xf[2];
#pragma unroll
      for (int k2 = 0; k2 < 2; ++k2) xf[k2] = *(const bf16x8*)(lds + L_XT + (pw + fr) * 144 + k2 * 64 + fq * 16);
#pragma unroll
      for (int tt = 0; tt < 4; ++tt) {
        const int t = tt * 16 + fr;
        f32x4 y = {0.f, 0.f, 0.f, 0.f};
#pragma unroll
        for (int ks = 0; ks < 4; ++ks) {
          const u32x2 c0 = *(const u32x2*)(lds + L_CN + t * 272 + ((2 * ks) * 16 + fq * 4) * 2);
          const u32x2 c1 = *(const u32x2*)(lds + L_CN + t * 272 + ((2 * ks + 1) * 16 + fq * 4) * 2);
          u32x4 cv; cv.x = c0.x; cv.y = c0.y; cv.z = c1.x; cv.w = c1.y;
          y = MFMA16(sf[ks], __builtin_bit_cast(bf16x8, cv), y);
        }
        y *= __expf(CSs[t]);
#pragma unroll
        for (int k2 = 0; k2 < 2; ++k2) {
          const bf16x8 mf = *(const bf16x8*)(lds + L_MM + t * 144 + k2 * 64 + fq * 16);
          y = MFMA16(xf[k2], mf, y);
        }
        const int row = rowc + t, pc_ = pw + fq * 4;
        const u32x2 zw = zwv[tt];
        const float x0 = bf1(*(const bf16_t*)(lds + L_XT + (pc_ + 0) * 144 + t * 2)), x1 = bf1(*(const bf16_t*)(lds + L_XT + (pc_ + 1) * 144 + t * 2));
        const float x2 = bf1(*(const bf16_t*)(lds + L_XT + (pc_ + 2) * 144 + t * 2)), x3 = bf1(*(const bf16_t*)(lds + L_XT + (pc_ + 3) * 144 + t * 2));
        const float v0 = (y.x + dsk * x0) * siluf_(bflo(zw.x)), v1 = (y.y + dsk * x1) * siluf_(bfhi(zw.x));
        const float v2 = (y.z + dsk * x2) * siluf_(bflo(zw.y)), v3 = (y.w + dsk * x3) * siluf_(bfhi(zw.y));
        u32x2 o; o.x = pk2(v0, v1); o.y = pk2(v2, v3);
        *(u32x2*)(act + (size_t)row * 4096 + 2048 + h * 64 + pc_) = o;
        float ss = v0 * v0 + v1 * v1 + v2 * v2 + v3 * v3;
        ss += __shfl_xor(ss, 16); ss += __shfl_xor(ss, 32);
        if (fq == 0) atomicAdd(sss + row, ss);
      }
      const float dec = __expf(cs_end);
#pragma unroll
      for (int nt = 0; nt < 8; ++nt) {
        S[nt] *= dec;
#pragma unroll
        for (int k2 = 0; k2 < 2; ++k2) {
          const bf16x8 bt = *(const bf16x8*)(lds + L_BT + (nt * 16 + fr) * 144 + k2 * 64 + fq * 16);
          S[nt] = MFMA16(bt, xf[k2], S[nt]);
        }
      }
    }
  }
  float* so = P.out + O_SSDP + ((size_t)(l * NB + b) * NH + h) * HD * SN;
#pragma unroll
  for (int nt = 0; nt < 8; ++nt) *(f32x4*)(so + (size_t)(pw + fr) * SN + nt * 16 + fq * 4) = S[nt];
}

struct SampLd { f32x4 st[8]; u32x4 xcv; float dtv; float zt[4]; };
__device__ __forceinline__ void ssd_sample_load(const Params& P, int l, int task, int tid, SampLd& L) {
  const int b = task >> 5, h = task & 31, gi = h >> 2, row0 = MP + b * 4;
  const float* sin_ = P.st_ssd + ((size_t)(l * DB + b) * NH + h) * HD * SN;
#pragma unroll
  for (int j = 0; j < 8; ++j) L.st[j] = *(const f32x4*)(sin_ + (j * 256 + tid) * 4);
  L.xcv = (u32x4){0u, 0u, 0u, 0u}; L.dtv = 0.f;
  if (tid < 160) {
    const int t = tid / 40, q = tid % 40;
    const int ch = q < 8 ? h * 64 + q * 8 : q < 24 ? 2048 + gi * 128 + (q - 8) * 8 : 3072 + gi * 128 + (q - 24) * 8;
    L.xcv = *(const u32x4*)((const bf16_t*)(P.ws + WS_XC) + (size_t)(row0 + t) * CONVD + ch);
  }
  if (tid >= 192 && tid < 196) L.dtv = ((const float*)(P.ws + WS_DTV))[(size_t)(row0 + tid - 192) * 32 + h];
  const int p = tid >> 2;
#pragma unroll
  for (int t = 0; t < 4; ++t) L.zt[t] = bf1(((const bf16_t*)(P.ws + WS_PROJ))[(size_t)(row0 + t) * NPROJ + 8192 + h * 64 + p]);
}

__device__ __forceinline__ void ssd_sample_batch(const Params& P, int l, int batch, unsigned char* lds, int dummy) {
  const int tid = opaque_tid(), lane = tid & 63;
  bf16_t* act = (bf16_t*)(P.ws + WS_ACT);
  float* sss = (float*)(P.ws + WS_SS) + (dummy ? 8 : 5 + l) * MT;
  float* xs = (float*)(lds + 64);
  float* Bs = xs + 256;
  float* Cs = Bs + 512;
  float* dts = Cs + 512;
  float* St0 = dts + 16;
  const int p = tid >> 2, nq = tid & 3, n0 = nq * 32;
  SampLd L;
  ssd_sample_load(P, l, batch * 8, tid, L);
#pragma unroll 1
  for (int i = 0; i < 8; ++i) {
    const int task = batch * 8 + i, b = task >> 5, h = task & 31, row0 = MP + b * 4;
    float* St = St0 + (i & 1) * (64 * 132);
    const float a_h = -expf(P.a_log[l * NH + h]), dsk = P.ssd_d[l * NH + h];
#pragma unroll
    for (int j = 0; j < 8; ++j) { const int f = (j * 256 + tid) * 4; *(f32x4*)(St + (f >> 7) * 132 + (f & 127)) = L.st[j]; }
    if (tid < 160) {
      const int t = tid / 40, q = tid % 40;
      float* dst = q < 8 ? xs + t * 64 + q * 8 : q < 24 ? Bs + t * 128 + (q - 8) * 8 : Cs + t * 128 + (q - 24) * 8;
      const u32x4 v = L.xcv;
      *(f32x4*)dst = (f32x4){bflo(v.x), bfhi(v.x), bflo(v.y), bfhi(v.y)};
      *(f32x4*)(dst + 4) = (f32x4){bflo(v.z), bfhi(v.z), bflo(v.w), bfhi(v.w)};
    }
    if (tid >= 192 && tid < 196) dts[tid - 192] = L.dtv;
    float zt[4];
#pragma unroll
    for (int t = 0; t < 4; ++t) zt[t] = L.zt[t];
    __syncthreads();
    if (i + 1 < 8) ssd_sample_load(P, l, task + 1, tid, L);
    f32x4 hs[8];
#pragma unroll
    for (int j = 0; j < 8; ++j) hs[j] = *(const f32x4*)(St + p * 132 + n0 + j * 4);
#pragma unroll
    for (int t = 0; t < 4; ++t) {
      const float dtv = dts[t], dA = __expf(dtv * a_h), xv = xs[t * 64 + p], xdt = xv * dtv;
      float yp = 0.f;
#pragma unroll
      for (int j = 0; j < 8; ++j) {
        const f32x4 bv = *(const f32x4*)(Bs + t * 128 + n0 + j * 4);
        const f32x4 cv = *(const f32x4*)(Cs + t * 128 + n0 + j * 4);
        hs[j] = hs[j] * dA + bv * xdt;
        yp += hs[j].x * cv.x + hs[j].y * cv.y + hs[j].z * cv.z + hs[j].w * cv.w;
      }
      yp += __shfl_xor(yp, 1); yp += __shfl_xor(yp, 2);
      const int row = row0 + t;
      float v = 0.f;
      if (nq == 0) {
        v = (yp + dsk * xv) * siluf_(zt[t]);
        act[(size_t)row * 4096 + 2048 + h * 64 + p] = (bf16_t)(pk2(v, 0.f) & 0xffff);
      }
      const float ss = wave_sum(v * v);
      if (lane == 0) atomicAdd(sss + row, ss);
    }
#pragma unroll
    for (int j = 0; j < 8; ++j) *(f32x4*)(St + p * 132 + n0 + j * 4) = hs[j];
    __syncthreads();
    float* so = P.out + O_SSDS + ((size_t)(l * DB + b) * NH + h) * HD * SN;
#pragma unroll
    for (int j = 0; j < 8; ++j) { const int f = (j * 256 + tid) * 4; *(f32x4*)(so + f) = *(const f32x4*)(St + (f >> 7) * 132 + (f & 127)); }
  }
}

__device__ __forceinline__ void phase_mix(const Params& P, int l, unsigned char* lds, int dummy = 0) {
  int* counter = (int*)(P.ws + WS_CNT) + l + (dummy ? 8 : 0);
  int* slot = (int*)lds;
  constexpr int T0 = 128, T1 = T0 + 512, T2 = T1 + DB * NH / 8, T3 = T2 + NG;
  for (;;) {
    const int t = next_task(counter, slot);
    if (t >= T3) break;
    const int mask = dummy ? (P.probe >> 4) : 15;
    if (t < T0) { if (mask & 1) ssd_prompt_task(P, l, t >> 5, t & 31, lds, dummy); }
    else if (t < T1) { const int q = t - T0; if (mask & 2) s5_block_task<false>(P, l, q & 127, q >> 7, lds); }
    else if (t < T2) { if (mask & 4) ssd_sample_batch(P, l, t - T1, lds, dummy); }
    else { if (mask & 8) s5_block_task<true>(P, l, t - T2, 0, lds); }
  }
}

__device__ __forceinline__ void phase_final(const Params& P) {
  const int tid = opaque_tid(), lane = tid & 63, wave = tid >> 6;
  const float* xres = (const float*)(P.ws + WS_XRES);
  const float* ssx = (const float*)(P.ws + WS_SS) + 2 * MT;
  for (int r4 = blockIdx.x; r4 < MT / 4; r4 += gridDim.x) {
    const int row = r4 * 4 + wave;
    const float rs = rsqrtf(ssx[row] * (1.f / 2048.f) + EPS);
    float* dst = P.out + (size_t)row * DM;
#pragma unroll
    for (int j = 0; j < 8; ++j) {
      const f32x4 v = *(const f32x4*)(xres + (size_t)row * DM + (j * 64 + lane) * 4);
      const f32x4 w = *(const f32x4*)(P.final_w + (j * 64 + lane) * 4);
      *(f32x4*)(dst + (j * 64 + lane) * 4) = v * rs * w;
    }
  }
}

__global__ void __launch_bounds__(256, 2) hymba_fwd(Params P) {
  extern __shared__ __attribute__((aligned(16))) unsigned char lds[];
  cg::grid_group grid = cg::this_grid();
  for (int ph = P.ph_lo; ph < P.ph_hi; ++ph) {
    if (ph > P.ph_lo) grid.sync();
#ifndef TEST_PH
#define TEST_PH -1
#endif
    if (ph == 0) phase_prep(P, lds);
    else if (ph == 1) { phase_gemm<G_IN>(P, 0, lds); deferred_weights(P, lds); }
    else if (ph == 2 || ph == 5) phase_conv(P, ph == 2 ? 0 : 1);
    else if (ph == 3 || ph == 6) phase_mix(P, ph == 3 ? 0 : 1, lds);
    else if (ph == 4 || ph == 7) phase_chain(P, ph == 4 ? 0 : 1, lds);
    else phase_final(P);
  }
}

extern "C" void kernel_launch(void* const* d_in, const int* in_sizes, int n_in, void* d_out, int out_size, void* d_ws, size_t ws_size, hipStream_t stream) {
  static int grid_blocks = 0;
  if (!grid_blocks) {
    int dev = 0, cus = 0, per_cu = 0;
    hipGetDevice(&dev);
    hipDeviceGetAttribute(&cus, hipDeviceAttributeMultiprocessorCount, dev);
    hipFuncSetAttribute((const void*)hymba_fwd, hipFuncAttributeMaxDynamicSharedMemorySize, LDS_BYTES);
    hipOccupancyMaxActiveBlocksPerMultiprocessor(&per_cu, (const void*)hymba_fwd, 256, LDS_BYTES);
    if (per_cu > 2) per_cu = 2;
    if (per_cu < 1) per_cu = 1;
    grid_blocks = cus * per_cu;
    if (ws_size < WS_END) fprintf(stderr, "workspace too small: %zu < %zu\n", ws_size, (size_t)WS_END);
  }
  Params p{};
  const float** ip = (const float**)&p;
  for (int i = 0; i < 27; ++i) ip[i] = (const float*)d_in[i];
  p.out = (float*)d_out; p.ws = (unsigned char*)d_ws; p.ph_lo = 0; p.ph_hi = 9; p.probe = PROBE_BITS;
  void* args[] = {&p};
  hipError_t e = hipLaunchCooperativeKernel((const void*)hymba_fwd, dim3(grid_blocks), dim3(256), args, LDS_BYTES, stream);
  if (e != hipSuccess) fprintf(stderr, "cooperative launch failed: %s (grid %d)\n", hipGetErrorString(e), grid_blocks);
}
```

```cpp
#include <hip/hip_runtime.h>
#include <hip/hip_cooperative_groups.h>
#include <cstdio>
#include <cstdint>
namespace cg = cooperative_groups;

typedef unsigned short bf16_t;
typedef short bf16x8 __attribute__((ext_vector_type(8)));
typedef float f32x4 __attribute__((ext_vector_type(4)));
typedef float f32x2 __attribute__((ext_vector_type(2)));
typedef unsigned u32x4 __attribute__((ext_vector_type(4)));
typedef unsigned u32x2 __attribute__((ext_vector_type(2)));

constexpr int DM = 2048, MP = 8192, MS = 512, MT = MP + MS;
constexpr int SEQ = 2048, NB = 4, DB = 128, DSEQ = 4;
constexpr int INC = 10272, NPROJ = 10240, NPAD = 10368;
constexpr int WA = 2048, NG = 128, NP = 64, NCH = 16;
constexpr int NH = 32, HD = 64, SN = 128, CONVD = 4096;
constexpr float EPS = 1e-5f;

constexpr size_t al256(size_t x) { return (x + 255) & ~(size_t)255; }
constexpr size_t WS_WIN = 0;
constexpr size_t WS_WGLU = WS_WIN + al256((size_t)2 * NPAD * DM * 2);
constexpr size_t WS_WOUT = WS_WGLU + al256((size_t)2 * 2048 * 2048 * 2);
constexpr size_t WS_PROJ = WS_WOUT + al256((size_t)2 * 2048 * 4096 * 2);
constexpr size_t WS_DT = WS_PROJ + al256((size_t)MT * NPROJ * 2);
constexpr size_t WS_G = WS_DT + al256((size_t)MT * 32 * 4);
constexpr size_t WS_ACT = WS_G + al256((size_t)MT * 2048 * 2);
constexpr size_t WS_XRES = WS_ACT + al256((size_t)MT * 4096 * 2);
constexpr size_t WS_XB = WS_XRES + al256((size_t)MT * 2048 * 4);
constexpr size_t WS_SS = WS_XB + al256((size_t)MT * 2048 * 2);
constexpr size_t WS_AB = WS_SS + al256((size_t)9 * MT * 4);
constexpr size_t WS_BBF = WS_AB + al256((size_t)2 * 2 * NG * NP * 4);
constexpr size_t WS_CCF = WS_BBF + al256((size_t)2 * NG * 8 * 64 * 8 * 2);
constexpr size_t WS_CNT = WS_CCF + al256((size_t)2 * NG * 4 * 64 * 8 * 2);
constexpr size_t WS_FLG = WS_CNT + 256;
constexpr size_t WS_XC = WS_FLG + al256((size_t)2 * 2 * 34 * 64);
constexpr size_t WS_DTV = WS_XC + al256((size_t)MT * CONVD * 2);
constexpr size_t WS_END = WS_DTV + al256((size_t)MT * 32 * 4);

constexpr int LDS_BYTES = 73728;
#ifndef PROBE_BITS
#define PROBE_BITS 0
#endif

struct Params {
  const float *x_prompt, *x_sample, *st_s5_re, *st_s5_im, *st_ssd, *cache_conv;
  const float *norm_w, *w_in, *lam_re, *lam_im, *log_step, *b_re, *b_im, *c_re, *c_im, *s5_d;
  const float *glu_w, *glu_b, *s5_norm_w, *conv_w, *conv_b, *dt_bias, *a_log, *ssd_d, *ssd_norm_w, *w_out, *final_w;
  float* out; unsigned char* ws; int ph_lo, ph_hi, probe, pad_;
};

constexpr size_t O_YP = 0;
constexpr size_t O_YS = O_YP + (size_t)MP * DM;
constexpr size_t O_S5RP = O_YS + (size_t)MS * DM;
constexpr size_t O_S5IP = O_S5RP + (size_t)2 * NB * NG * NP;
constexpr size_t O_SSDP = O_S5IP + (size_t)2 * NB * NG * NP;
constexpr size_t O_CONVP = O_SSDP + (size_t)2 * NB * NH * HD * SN;
constexpr size_t O_S5RS = O_CONVP + (size_t)2 * NB * 3 * CONVD;
constexpr size_t O_S5IS = O_S5RS + (size_t)2 * DB * NG * NP;
constexpr size_t O_SSDS = O_S5IS + (size_t)2 * DB * NG * NP;
constexpr size_t O_CONVS = O_SSDS + (size_t)2 * DB * NH * HD * SN;

typedef __bf16 bf16n2 __attribute__((ext_vector_type(2)));
__device__ __forceinline__ unsigned pk2(float lo, float hi) { const f32x2 v = {lo, hi}; return __builtin_bit_cast(unsigned, __builtin_convertvector(v, bf16n2)); }
__device__ __forceinline__ float bflo(unsigned w) { return __uint_as_float(w << 16); }
__device__ __forceinline__ float bfhi(unsigned w) { return __uint_as_float(w & 0xffff0000u); }
__device__ __forceinline__ float bf1(bf16_t h) { return __uint_as_float((unsigned)h << 16); }
__device__ __forceinline__ float sigmoidf_(float x) { return __builtin_amdgcn_rcpf(1.f + __expf(-x)); }
__device__ __forceinline__ float siluf_(float x) { return x * __builtin_amdgcn_rcpf(1.f + __expf(-x)); }
__device__ __forceinline__ float gelu_tanh(float y) { const float z = 0.7978845608028654f * (y + 0.044715f * y * y * y); return y * __builtin_amdgcn_rcpf(1.f + __expf(-2.f * z)); }
__device__ __forceinline__ float wave_sum(float v) {
#pragma unroll
  for (int o = 1; o < 64; o <<= 1) v += __shfl_xor(v, o);
  return v;
}
__device__ __forceinline__ int opaque_tid() { int t = threadIdx.x; asm volatile("" : "+v"(t)); return t; }
__device__ __forceinline__ void st_wt8(void* p, u32x2 v) {
  __hip_atomic_store((unsigned long long*)p, ((unsigned long long)v.y << 32) | v.x, __ATOMIC_RELAXED, __HIP_MEMORY_SCOPE_AGENT);
}
#define LDS_FENCE() asm volatile("s_waitcnt lgkmcnt(0)" ::: "memory")
#define MFMA16(a, b, c) __builtin_amdgcn_mfma_f32_16x16x32_bf16((a), (b), (c), 0, 0, 0)

__device__ __forceinline__ int next_task(int* counter, int* slot) {
  __syncthreads();
  if (threadIdx.x == 0) *slot = atomicAdd(counter, 1);
  __syncthreads();
  return *slot;
}

__device__ __forceinline__ void transpose_tile(const float* W, int K, int N, bf16_t* WT, const float* sc0, const float* sc1, int tile, float* tl) {
  const int tid = opaque_tid();
  const int nkb = K / 64, kb = tile % nkb, nb = tile / nkb, k0 = kb * 64, n0 = nb * 64;
#pragma unroll
  for (int i = 0; i < 4; ++i) {
    const int idx = tid + i * 256, kk = idx >> 4, n4 = (idx & 15) * 4, k = k0 + kk, n = n0 + n4;
    f32x4 v = {0.f, 0.f, 0.f, 0.f};
    if (n < N) { v = *(const f32x4*)(W + (size_t)k * N + n); if (sc0) v *= (k < 2048 ? sc0[k] : sc1[k - 2048]); }
    tl[(n4 + 0) * 65 + kk] = v.x; tl[(n4 + 1) * 65 + kk] = v.y; tl[(n4 + 2) * 65 + kk] = v.z; tl[(n4 + 3) * 65 + kk] = v.w;
  }
  __syncthreads();
  {
    const int n = tid >> 2, kc = (tid & 3) * 16;
    const float* s = tl + n * 65 + kc;
    u32x4 o0, o1;
    o0.x = pk2(s[0], s[1]); o0.y = pk2(s[2], s[3]); o0.z = pk2(s[4], s[5]); o0.w = pk2(s[6], s[7]);
    o1.x = pk2(s[8], s[9]); o1.y = pk2(s[10], s[11]); o1.z = pk2(s[12], s[13]); o1.w = pk2(s[14], s[15]);
    u32x4* dst = (u32x4*)(WT + (size_t)(n0 + n) * K + k0 + kc);
    dst[0] = o0; dst[1] = o1;
  }
  __syncthreads();
}

__device__ __forceinline__ void sincos_own(float ang, float& s, float& c) {
  const float k = rintf(ang * 0.15915494309189535f);
  float r = fmaf(-k, 6.28125f, ang); r = fmaf(-k, 1.9353071795864769e-3f, r);
  const float r2 = r * r;
  float ps = -1.f / 121645100408832000.f;
  ps = fmaf(ps, r2, 1.f / 355687428096000.f);
  ps = fmaf(ps, r2, -1.f / 1307674368000.f);
  ps = fmaf(ps, r2, 1.f / 6227020800.f);
  ps = fmaf(ps, r2, -1.f / 39916800.f);
  ps = fmaf(ps, r2, 1.f / 362880.f);
  ps = fmaf(ps, r2, -1.f / 5040.f);
  ps = fmaf(ps, r2, 1.f / 120.f);
  ps = fmaf(ps, r2, -1.f / 6.f);
  s = fmaf(ps * r2, r, r);
  float pc = 1.f / 2432902008176640000.f;
  pc = fmaf(pc, r2, -1.f / 6402373705728000.f);
  pc = fmaf(pc, r2, 1.f / 20922789888000.f);
  pc = fmaf(pc, r2, -1.f / 87178291200.f);
  pc = fmaf(pc, r2, 1.f / 479001600.f);
  pc = fmaf(pc, r2, -1.f / 3628800.f);
  pc = fmaf(pc, r2, 1.f / 40320.f);
  pc = fmaf(pc, r2, -1.f / 720.f);
  pc = fmaf(pc, r2, 1.f / 24.f);
  pc = fmaf(pc, r2, -0.5f);
  c = fmaf(pc, r2, 1.f);
}

__device__ __forceinline__ void s5_precompute(const Params& P, int l, int g, float* tl) {
  const int tid = opaque_tid();
  float* gre = tl; float* gim = tl + 64;
  if (tid < 64) {
    const int idx = (l * NG + g) * NP + tid;
    const float lr = fminf(P.lam_re[idx], -1e-4f), li = P.lam_im[idx];
    const float step = expf(P.log_step[l * NG + g]);
    const float mag = expf(lr * step);
    float sn, cs; sincos_own(li * step, sn, cs);
    const float abr = mag * cs, abi = mag * sn;
    const float den = lr * lr + li * li, nr = abr - 1.f;
    gre[tid] = (nr * lr + abi * li) / den;
    gim[tid] = (abi * lr - nr * li) / den;
    float* ab = (float*)(P.ws + WS_AB);
    ab[idx] = abr; ab[2 * NG * NP + idx] = abi;
  }
  __syncthreads();
  bf16_t* bbf = (bf16_t*)(P.ws + WS_BBF) + (size_t)(l * NG + g) * 8 * 64 * 8;
  const float* br = P.b_re + (size_t)(l * NG + g) * NP * NCH;
  const float* bi = P.b_im + (size_t)(l * NG + g) * NP * NCH;
  for (int j = 0; j < 16; ++j) {
    const int idx = tid * 16 + j, tile = idx >> 9, lane = (idx >> 3) & 63, e = idx & 7;
    const int pt = tile >> 1, part = tile & 1, p = pt * 16 + (lane & 15), q = lane >> 4, c = q * 8 + e;
    float v = 0.f;
    if (q < 2) { const float a = br[p * NCH + c], b = bi[p * NCH + c]; v = part == 0 ? gre[p] * a - gim[p] * b : gre[p] * b + gim[p] * a; }
    bbf[idx] = (bf16_t)(pk2(v, 0.f) & 0xffff);
  }
  bf16_t* ccf = (bf16_t*)(P.ws + WS_CCF) + (size_t)(l * NG + g) * 4 * 64 * 8;
  const float* cr = P.c_re + (size_t)(l * NG + g) * NCH * NP;
  const float* ci = P.c_im + (size_t)(l * NG + g) * NCH * NP;
  for (int j = 0; j < 8; ++j) {
    const int idx = tid * 8 + j, ks = idx >> 9, lane = (idx >> 3) & 63, e = idx & 7;
    const int c = lane & 15, q = lane >> 4, k = ks * 32 + q * 8 + e, p = k >> 1, part = k & 1;
    const float v = part == 0 ? cr[c * NP + p] : -ci[c * NP + p];
    ccf[idx] = (bf16_t)(pk2(v, 0.f) & 0xffff);
  }
  __syncthreads();
}

constexpr int TW_WIN = 2 * 32 * (NPAD / 64), TW_GLU = 2 * 32 * 32, TW_OUT = 2 * 64 * 32, TW_ALL = TW_WIN + TW_GLU + TW_OUT;
__device__ __forceinline__ void weight_tile_task(const Params& P, int r, float* tl) {
  if (r < TW_WIN) { const int per = 32 * (NPAD / 64), l = r / per; transpose_tile(P.w_in + (size_t)l * DM * INC, DM, INC, (bf16_t*)(P.ws + WS_WIN) + (size_t)l * NPAD * DM, P.norm_w + l * DM, P.norm_w + l * DM, r % per, tl); return; }
  r -= TW_WIN;
  if (r < TW_GLU) { const int per = 32 * 32, l = r / per; transpose_tile(P.glu_w + (size_t)l * 2048 * 2048, 2048, 2048, (bf16_t*)(P.ws + WS_WGLU) + (size_t)l * 2048 * 2048, nullptr, nullptr, r % per, tl); return; }
  r -= TW_GLU;
  { const int per = 64 * 32, l = r / per; transpose_tile(P.w_out + (size_t)l * 4096 * 2048, 4096, 2048, (bf16_t*)(P.ws + WS_WOUT) + (size_t)l * 2048 * 4096, P.s5_norm_w + l * 2048, P.ssd_norm_w + l * 2048, r % per, tl); }
}
__device__ __forceinline__ void deferred_weights(const Params& P, unsigned char* lds) {
  float* tl = (float*)(lds + 64);
  const int grid = gridDim.x, slots = grid >> 3, q = (blockIdx.x & 7) * slots + (blockIdx.x >> 3);
  const int leftover = (34 * 81) % grid;
  int rank = q, n = grid;
  if (leftover != 0) { if (q < leftover) return; rank = q - leftover; n = grid - leftover; }
  __syncthreads();
  for (int r = 32 * (NPAD / 64) + rank; r < TW_ALL; r += n) weight_tile_task(P, r, tl);
}

__device__ __forceinline__ void phase_prep(const Params& P, unsigned char* lds) {
  float* tl = (float*)(lds + 64);
  const int tid = opaque_tid(), lane = tid & 63, wave = tid >> 6;
  {
    float* ss = (float*)(P.ws + WS_SS);
    for (int i = blockIdx.x * 256 + tid; i < 8 * MT; i += gridDim.x * 256) ss[MT + i] = 0.f;
    if (blockIdx.x == 0 && tid < 64) ((int*)(P.ws + WS_CNT))[tid] = 0;
    if (blockIdx.x == 1) for (int i = tid; i < 2 * 2 * 34 * 16; i += 256) ((int*)(P.ws + WS_FLG))[i] = 0;
  }
  constexpr int T_W0 = 32 * (NPAD / 64), T_X = MT / 4, T_S5 = 2 * NG;
  constexpr int T_ALL = T_W0 + T_X + T_S5;
  for (int t = blockIdx.x; t < T_ALL; t += gridDim.x) {
    int r = t;
    if (r < T_W0) { weight_tile_task(P, r, tl); continue; }
    r -= T_W0;
    if (r < T_X) {
      const int row = r * 4 + wave;
      const float* src = row < MP ? P.x_prompt + (size_t)row * DM : P.x_sample + (size_t)(row - MP) * DM;
      bf16_t* dst = (bf16_t*)(P.ws + WS_XB) + (size_t)row * DM;
      float s = 0.f;
#pragma unroll
      for (int j = 0; j < 8; ++j) {
        const f32x4 v = *(const f32x4*)(src + (j * 64 + lane) * 4);
        s += v.x * v.x + v.y * v.y + v.z * v.z + v.w * v.w;
        u32x2 o; o.x = pk2(v.x, v.y); o.y = pk2(v.z, v.w);
        *(u32x2*)(dst + (j * 64 + lane) * 4) = o;
      }
      s = wave_sum(s);
      if (lane == 0) ((float*)(P.ws + WS_SS))[row] = s;
      continue;
    }
    r -= T_X;
    s5_precompute(P, r / NG, r % NG, tl);
  }
}

constexpr int G_IN = 0, G_GLU = 1, G_OUT = 2;

__device__ __forceinline__ bool gemm_unit_of(int v, int NT, int& pm, int& pn) {
  const int total = 34 * NT;
  if (v >= total) return false;
  const int ng = NT >> 3, rem = NT & 7;
  if (v < ng * 272) { const int pg = v / 272, w = v % 272; pm = w >> 3; pn = pg * 8 + (w & 7); }
  else { const int w = v - ng * 272; pm = w / rem; pn = ng * 8 + w % rem; }
  return true;
}

template <int MODE>
__device__ __forceinline__ void gemm_unit(const Params& P, int l, int pm, int pn, unsigned char* lds, int dummy) {
  constexpr int K = MODE == G_OUT ? 4096 : 2048;
  constexpr int NK = K / 32;
  const bf16_t* A = MODE == G_IN ? (const bf16_t*)(P.ws + WS_XB) : MODE == G_GLU ? (const bf16_t*)(P.ws + WS_G) : (const bf16_t*)(P.ws + WS_ACT);
  const bf16_t* Bt = MODE == G_IN ? (const bf16_t*)(P.ws + WS_WIN) + (size_t)l * NPAD * DM
                   : MODE == G_GLU ? (const bf16_t*)(P.ws + WS_WGLU) + (size_t)l * 2048 * 2048
                                   : (const bf16_t*)(P.ws + WS_WOUT) + (size_t)l * 2048 * 4096;
  const int tid = opaque_tid(), lane = tid & 63, wave = tid >> 6, wr = wave >> 1, wc = wave & 1, fr = lane & 15, fq = lane >> 4;
  unsigned char* base = lds + 64;
  const int grow = tid >> 2, gch = (tid & 3) ^ ((((tid >> 2) >> 3) & 1) << 1);
  const bf16_t* Ag = A + (size_t)(pm * 256 + grow) * K + gch * 8;
  const bf16_t* Bg = Bt + (size_t)(pn * 128 + grow) * K + gch * 8;
  const int swz = (fq ^ ((fr >> 3) << 1)) << 4;
  const int a_rd = (wr * 128 + fr) * 64 + swz;
  const int b_rd = 16384 + (wc * 64 + fr) * 64 + swz;

  f32x4 acc[8][4];
#pragma unroll
  for (int mi = 0; mi < 8; ++mi)
#pragma unroll
    for (int ni = 0; ni < 4; ++ni) acc[mi][ni] = (f32x4){0.f, 0.f, 0.f, 0.f};

  auto stage_tile = [&](int kt, unsigned char* st) __attribute__((always_inline)) {
#pragma unroll
    for (int i = 0; i < 4; ++i) __builtin_amdgcn_global_load_lds((const unsigned*)(Ag + (size_t)i * 64 * K + kt * 32), (unsigned*)(st + (tid + i * 256) * 16), 16, 0, 0);
#pragma unroll
    for (int i = 0; i < 2; ++i) __builtin_amdgcn_global_load_lds((const unsigned*)(Bg + (size_t)i * 64 * K + kt * 32), (unsigned*)(st + 16384 + (tid + i * 256) * 16), 16, 0, 0);
  };
  stage_tile(0, base);
  __syncthreads();

  for (int kt = 0; kt < NK; ++kt) {
    unsigned char* cur = base + (kt & 1) * 24576;
    unsigned char* nxt = base + ((kt & 1) ^ 1) * 24576;
    if (kt + 1 < NK) stage_tile(kt + 1, nxt);
    __builtin_amdgcn_sched_barrier(0);
    if (MODE == G_OUT && kt == NK / 2) {
      const float* ssa = (const float*)(P.ws + WS_SS) + (3 + l) * MT;
      const float* sss = (const float*)(P.ws + WS_SS) + (5 + l) * MT;
#pragma unroll
      for (int mi = 0; mi < 8; ++mi) {
        const int row = pm * 256 + wr * 128 + mi * 16 + fr;
        const float ra = rsqrtf(ssa[row] * (1.f / 2048.f) + EPS), rs = rsqrtf(sss[row] * (1.f / 2048.f) + EPS);
        const float ratio = ra / rs;
#pragma unroll
        for (int ni = 0; ni < 4; ++ni) acc[mi][ni] *= ratio;
      }
    }
    bf16x8 af[8], bfr[4];
#pragma unroll
    for (int mi = 0; mi < 8; ++mi) af[mi] = *(const bf16x8*)(cur + a_rd + mi * 1024);
#pragma unroll
    for (int ni = 0; ni < 4; ++ni) bfr[ni] = *(const bf16x8*)(cur + b_rd + ni * 1024);
    __builtin_amdgcn_s_setprio(1);
#pragma unroll
    for (int mi = 0; mi < 8; ++mi)
#pragma unroll
      for (int ni = 0; ni < 4; ++ni) acc[mi][ni] = MFMA16(bfr[ni], af[mi], acc[mi][ni]);
    __builtin_amdgcn_s_setprio(0);
    __syncthreads();
  }

  const int row0 = pm * 256 + wr * 128 + fr, col0 = pn * 128 + wc * 64 + fq * 4;
  if (MODE == G_IN) {
    const float* ssx = (const float*)(P.ws + WS_SS) + l * MT;
    bf16_t* proj = (bf16_t*)(P.ws + WS_PROJ);
    float* dtb = (float*)(P.ws + WS_DT);
#pragma unroll
    for (int mi = 0; mi < 8; ++mi) {
      const int row = row0 + mi * 16;
      const float rs = rsqrtf(ssx[row] * (1.f / 2048.f) + EPS);
#pragma unroll
      for (int ni = 0; ni < 4; ++ni) {
        const f32x4 v = acc[mi][ni] * rs;
        const int col = col0 + ni * 16;
        if (pn < 80) { u32x2 o; o.x = pk2(v.x, v.y); o.y = pk2(v.z, v.w); *(u32x2*)(proj + (size_t)row * NPROJ + col) = o; }
        else if (col < NPROJ + 32) { *(f32x4*)(dtb + (size_t)row * 32 + (col - NPROJ)) = v; }
      }
    }
  } else if (MODE == G_GLU) {
    const bf16_t* gbuf = (const bf16_t*)(P.ws + WS_G);
    const bf16_t* proj = (const bf16_t*)(P.ws + WS_PROJ);
    bf16_t* act = (bf16_t*)(P.ws + WS_ACT);
    float* ssa = (float*)(P.ws + WS_SS) + (dummy ? 7 : 3 + l) * MT;
    const float* gb_ = P.glu_b + l * 2048;
#pragma unroll
    for (int mi = 0; mi < 8; ++mi) {
      const int row = row0 + mi * 16;
      float ss = 0.f;
#pragma unroll
      for (int ni = 0; ni < 4; ++ni) {
        const int col = col0 + ni * 16;
        const f32x4 bv = *(const f32x4*)(gb_ + col);
        const u32x2 gw = *(const u32x2*)(gbuf + (size_t)row * 2048 + col);
        const u32x2 zw = *(const u32x2*)(proj + (size_t)row * NPROJ + 2048 + col);
        const f32x4 a = acc[mi][ni] + bv;
        const float v0 = bflo(gw.x) * sigmoidf_(a.x) * siluf_(bflo(zw.x));
        const float v1 = bfhi(gw.x) * sigmoidf_(a.y) * siluf_(bfhi(zw.x));
        const float v2 = bflo(gw.y) * sigmoidf_(a.z) * siluf_(bflo(zw.y));
        const float v3 = bfhi(gw.y) * sigmoidf_(a.w) * siluf_(bfhi(zw.y));
        ss += v0 * v0 + v1 * v1 + v2 * v2 + v3 * v3;
        u32x2 o; o.x = pk2(v0, v1); o.y = pk2(v2, v3);
        st_wt8(act + (size_t)row * 4096 + col, o);
      }
      ss += __shfl_xor(ss, 16); ss += __shfl_xor(ss, 32);
      if (fq == 0) atomicAdd(ssa + row, ss);
    }
  } else {
    const float* sss = (const float*)(P.ws + WS_SS) + (5 + l) * MT;
    float* ssx = (float*)(P.ws + WS_SS) + (l + 1) * MT;
    float* xres = (float*)(P.ws + WS_XRES);
    bf16_t* xb = (bf16_t*)(P.ws + WS_XB);
#pragma unroll
    for (int mi = 0; mi < 8; ++mi) {
      const int row = row0 + mi * 16;
      const float rs = rsqrtf(sss[row] * (1.f / 2048.f) + EPS);
      const float* xold = l == 0 ? (row < MP ? P.x_prompt + (size_t)row * DM : P.x_sample + (size_t)(row - MP) * DM) : xres + (size_t)row * DM;
      float ss = 0.f;
#pragma unroll
      for (int ni = 0; ni < 4; ++ni) {
        const int col = col0 + ni * 16;
        const f32x4 xo = *(const f32x4*)(xold + col);
        const f32x4 v = xo + acc[mi][ni] * rs;
        ss += v.x * v.x + v.y * v.y + v.z * v.z + v.w * v.w;
        st_wt8(xres + (size_t)row * DM + col, (u32x2){__float_as_uint(v.x), __float_as_uint(v.y)});
        st_wt8(xres + (size_t)row * DM + col + 2, (u32x2){__float_as_uint(v.z), __float_as_uint(v.w)});
        u32x2 o; o.x = pk2(v.x, v.y); o.y = pk2(v.z, v.w);
        st_wt8(xb + (size_t)row * DM + col, o);
      }
      ss += __shfl_xor(ss, 16); ss += __shfl_xor(ss, 32);
      if (fq == 0) atomicAdd(ssx + row, ss);
    }
  }
}

template <int MODE>
__device__ __forceinline__ void phase_gemm(const Params& P, int l, unsigned char* lds, int dummy = 0) {
  constexpr int NT = MODE == G_IN ? 81 : 16;
  const int slots = gridDim.x >> 3, xcd = blockIdx.x & 7, slot = blockIdx.x >> 3;
  for (int i = 0;; ++i) {
    const int v = (i * 8 + xcd) * slots + slot;
    int pm, pn;
    if (!gemm_unit_of(v, NT, pm, pn)) break;
    gemm_unit<MODE>(P, l, pm, pn, lds, dummy);
  }
}


__device__ __forceinline__ int* panel_flag(const Params& P, int l, int kind, int pm) { return (int*)(P.ws + WS_FLG) + ((l * 2 + kind) * 34 + pm) * 16; }
__device__ __forceinline__ void panel_wait(int* flag, int need) {
  if (threadIdx.x == 0) { while (__hip_atomic_load(flag, __ATOMIC_RELAXED, __HIP_MEMORY_SCOPE_AGENT) < need) __builtin_amdgcn_s_sleep(4); }
  __syncthreads();
  asm volatile("" ::: "memory");
}
__device__ __forceinline__ void panel_signal(int* flag) {
  asm volatile("s_waitcnt vmcnt(0)" ::: "memory");
  __syncthreads();
  if (threadIdx.x == 0) __hip_atomic_fetch_add(flag, 1, __ATOMIC_RELAXED, __HIP_MEMORY_SCOPE_AGENT);
}
__device__ __forceinline__ void phase_chain(const Params& P, int l, unsigned char* lds) {
  const int nGLU = 34 * 16, nOUT = 34 * 16, nIN = l == 0 ? 34 * 81 : 0, total = nGLU + nOUT + nIN;
  const int slots = gridDim.x >> 3, xcd = blockIdx.x & 7, slot = blockIdx.x >> 3;
  for (int i = 0;; ++i) {
    const int v = (i * 8 + xcd) * slots + slot;
    if (v >= total) break;
    int pm, pn;
    if (v < nGLU) {
      gemm_unit_of(v, 16, pm, pn);
      gemm_unit<G_GLU>(P, l, pm, pn, lds, 0);
      panel_signal(panel_flag(P, l, 0, pm));
    } else if (v < nGLU + nOUT) {
      gemm_unit_of(v - nGLU, 16, pm, pn);
      panel_wait(panel_flag(P, l, 0, pm), 16);
      gemm_unit<G_OUT>(P, l, pm, pn, lds, 0);
      panel_signal(panel_flag(P, l, 1, pm));
    } else {
      gemm_unit_of(v - nGLU - nOUT, 81, pm, pn);
      panel_wait(panel_flag(P, l, 1, pm), 16);
      gemm_unit<G_IN>(P, l + 1, pm, pn, lds, 0);
    }
  }
}

__device__ __forceinline__ void conv8(const u32x4* r, int i, const f32x4* w, const f32x4* bias, float* o) {
#pragma unroll
  for (int hf = 0; hf < 2; ++hf) {
    f32x4 a = bias[hf];
#pragma unroll
    for (int k = 0; k < 4; ++k) {
      const u32x4 rv = r[i + k];
      const unsigned w0 = hf == 0 ? rv.x : rv.z, w1 = hf == 0 ? rv.y : rv.w;
      const f32x4 wk = w[k * 2 + hf];
      a.x = fmaf(wk.x, bflo(w0), a.x); a.y = fmaf(wk.y, bfhi(w0), a.y);
      a.z = fmaf(wk.z, bflo(w1), a.z); a.w = fmaf(wk.w, bfhi(w1), a.w);
    }
    o[hf * 4 + 0] = siluf_(a.x); o[hf * 4 + 1] = siluf_(a.y); o[hf * 4 + 2] = siluf_(a.z); o[hf * 4 + 3] = siluf_(a.w);
  }
}
__device__ __forceinline__ void store8f(float* dst, u32x4 v) {
  *(f32x4*)dst = (f32x4){bflo(v.x), bfhi(v.x), bflo(v.y), bfhi(v.y)};
  *(f32x4*)(dst + 4) = (f32x4){bflo(v.z), bfhi(v.z), bflo(v.w), bfhi(v.w)};
}

__device__ __forceinline__ void phase_conv(const Params& P, int l) {
  const int tid = opaque_tid();
  const int gsz = gridDim.x * 256, gid = blockIdx.x * 256 + tid;
  const bf16_t* proj = (const bf16_t*)(P.ws + WS_PROJ);
  bf16_t* xc = (bf16_t*)(P.ws + WS_XC);
  const float* cw = P.conv_w + (size_t)l * 4 * CONVD;
  const float* cb = P.conv_b + (size_t)l * CONVD;
#pragma unroll 1
  for (int it = gid; it < (MP / 8) * 512; it += gsz) {
    const int ch0 = (it & 511) * 8, row0 = (it >> 9) * 8, t0 = row0 & (SEQ - 1);
    u32x4 r[11];
#pragma unroll
    for (int j = 0; j < 11; ++j) {
      r[j] = (u32x4){0u, 0u, 0u, 0u};
      if (t0 - 3 + j >= 0) r[j] = *(const u32x4*)(proj + (size_t)(row0 - 3 + j) * NPROJ + 4096 + ch0);
    }
    f32x4 w[8], bias[2];
#pragma unroll
    for (int k = 0; k < 4; ++k) { w[k * 2] = *(const f32x4*)(cw + k * CONVD + ch0); w[k * 2 + 1] = *(const f32x4*)(cw + k * CONVD + ch0 + 4); }
    bias[0] = *(const f32x4*)(cb + ch0); bias[1] = *(const f32x4*)(cb + ch0 + 4);
#pragma unroll
    for (int i = 0; i < 8; ++i) {
      float o[8]; conv8(r, i, w, bias, o);
      u32x4 q; q.x = pk2(o[0], o[1]); q.y = pk2(o[2], o[3]); q.z = pk2(o[4], o[5]); q.w = pk2(o[6], o[7]);
      *(u32x4*)(xc + (size_t)(row0 + i) * CONVD + ch0) = q;
    }
    if (t0 == SEQ - 8) {
      const int bb = row0 >> 11;
#pragma unroll
      for (int j = 0; j < 3; ++j) store8f(P.out + O_CONVP + ((size_t)(l * NB + bb) * 3 + j) * CONVD + ch0, r[8 + j]);
    }
  }
#pragma unroll 1
  for (int it = gid; it < DB * 512; it += gsz) {
    const int ch0 = (it & 511) * 8, bb = it >> 9, row0 = MP + bb * 4;
    u32x4 r[7];
#pragma unroll
    for (int j = 0; j < 3; ++j) {
      const float* cp = P.cache_conv + ((size_t)(l * DB + bb) * 3 + j) * CONVD + ch0;
      const f32x4 c0 = *(const f32x4*)cp, c1 = *(const f32x4*)(cp + 4);
      r[j].x = pk2(c0.x, c0.y); r[j].y = pk2(c0.z, c0.w); r[j].z = pk2(c1.x, c1.y); r[j].w = pk2(c1.z, c1.w);
    }
#pragma unroll
    for (int j = 0; j < 4; ++j) r[3 + j] = *(const u32x4*)(proj + (size_t)(row0 + j) * NPROJ + 4096 + ch0);
    f32x4 w[8], bias[2];
#pragma unroll
    for (int k = 0; k < 4; ++k) { w[k * 2] = *(const f32x4*)(cw + k * CONVD + ch0); w[k * 2 + 1] = *(const f32x4*)(cw + k * CONVD + ch0 + 4); }
    bias[0] = *(const f32x4*)(cb + ch0); bias[1] = *(const f32x4*)(cb + ch0 + 4);
#pragma unroll
    for (int i = 0; i < 4; ++i) {
      float o[8]; conv8(r, i, w, bias, o);
      u32x4 q; q.x = pk2(o[0], o[1]); q.y = pk2(o[2], o[3]); q.z = pk2(o[4], o[5]); q.w = pk2(o[6], o[7]);
      *(u32x4*)(xc + (size_t)(row0 + i) * CONVD + ch0) = q;
    }
#pragma unroll
    for (int j = 0; j < 3; ++j) store8f(P.out + O_CONVS + ((size_t)(l * DB + bb) * 3 + j) * CONVD + ch0, r[4 + j]);
  }
  {
    const float* dtb = (const float*)(P.ws + WS_DT);
    float* dtv = (float*)(P.ws + WS_DTV);
    for (int i = gid; i < MT * 32; i += gsz) {
      const float x = dtb[i] + P.dt_bias[l * NH + (i & 31)];
      dtv[i] = fmaxf(x, 0.f) + log1pf(__expf(-fabsf(x)));
    }
  }
}

template <int MODE>
__device__ __forceinline__ void s5_wave(const Params& P, int l, int g, int rowbase, int nchunks, unsigned char* wl, float& hr, float& hi,
                                        const bf16x8 (&bbf)[8], const bf16x8 (&ccf)[4], float ar, float ai) {
  const int lane = opaque_tid() & 63, fr = lane & 15, fq = lane >> 4;
  unsigned char* bu = wl; unsigned char* Hb = wl + 8192;
  const bf16_t* proj = (const bf16_t*)(P.ws + WS_PROJ);
  bf16_t* gbuf = (bf16_t*)(P.ws + WS_G);
  f32x4 dv = {0.f, 0.f, 0.f, 0.f};
  if (MODE != 0) dv = *(const f32x4*)(P.s5_d + l * WA + g * NCH + fq * 4);
  const bf16x8 zero8 = {0, 0, 0, 0, 0, 0, 0, 0};
  bf16x8 uf = zero8;
  if (fq < 2) uf = *(const bf16x8*)(proj + (size_t)(rowbase + fr) * NPROJ + g * NCH + fq * 8);
#pragma unroll 1
  for (int c = 0; c < nchunks; ++c) {
    const int row0 = rowbase + c * 16;
    f32x4 t[8];
#pragma unroll
    for (int i = 0; i < 8; ++i) t[i] = MFMA16(uf, bbf[i], ((f32x4){0.f, 0.f, 0.f, 0.f}));
    u32x2 uw = {0u, 0u};
    if (MODE != 0) uw = *(const u32x2*)(proj + (size_t)(row0 + fr) * NPROJ + g * NCH + fq * 4);
    if (c + 1 < nchunks) { if (fq < 2) uf = *(const bf16x8*)(proj + (size_t)(row0 + 16 + fr) * NPROJ + g * NCH + fq * 8); }
#pragma unroll
    for (int pt = 0; pt < 4; ++pt)
#pragma unroll
      for (int r = 0; r < 4; ++r) {
        f32x2 v; v.x = t[2 * pt][r]; v.y = t[2 * pt + 1][r];
        *(f32x2*)(bu + (fq * 4 + r) * 512 + (pt * 16 + fr) * 8) = v;
      }
    LDS_FENCE();
#pragma unroll
    for (int tt = 0; tt < 16; ++tt) {
      if (MODE == 2 && (tt & 3) == 0) {
        const int b = ((row0 - MP) >> 2) + (tt >> 2);
        hr = P.st_s5_re[((size_t)(l * DB + b) * NG + g) * NP + lane];
        hi = P.st_s5_im[((size_t)(l * DB + b) * NG + g) * NP + lane];
      }
      const f32x2 bv = *(const f32x2*)(bu + tt * 512 + lane * 8);
      const float nr = fmaf(ar, hr, fmaf(-ai, hi, bv.x));
      const float ni = fmaf(ar, hi, fmaf(ai, hr, bv.y));
      hr = nr; hi = ni;
      if (MODE != 0) *(unsigned*)(Hb + tt * 272 + lane * 4) = pk2(hr, hi);
      if (MODE == 2 && (tt & 3) == 3) {
        const int b = ((row0 - MP) >> 2) + (tt >> 2);
        P.out[O_S5RS + ((size_t)(l * DB + b) * NG + g) * NP + lane] = hr;
        P.out[O_S5IS + ((size_t)(l * DB + b) * NG + g) * NP + lane] = hi;
      }
    }
    LDS_FENCE();
    if (MODE != 0) {
      f32x4 y = {0.f, 0.f, 0.f, 0.f};
#pragma unroll
      for (int ks = 0; ks < 4; ++ks) {
        const bf16x8 hf = *(const bf16x8*)(Hb + fr * 272 + ks * 64 + fq * 16);
        y = MFMA16(ccf[ks], hf, y);
      }
      LDS_FENCE();
      const float y0 = gelu_tanh(y.x + dv.x * bflo(uw.x)), y1 = gelu_tanh(y.y + dv.y * bfhi(uw.x));
      const float y2 = gelu_tanh(y.z + dv.z * bflo(uw.y)), y3 = gelu_tanh(y.w + dv.w * bfhi(uw.y));
      u32x2 o; o.x = pk2(y0, y1); o.y = pk2(y2, y3);
      *(u32x2*)(gbuf + (size_t)(row0 + fr) * 2048 + g * NCH + fq * 4) = o;
    }
  }
}

constexpr int L_S5X = 64 + 4 * 12544;
template <bool SAMPLE>
__device__ __forceinline__ void s5_block_task(const Params& P, int l, int g, int b, unsigned char* lds) {
  const int tid = opaque_tid(), lane = tid & 63, wave = tid >> 6;
  const bf16x8* bbp = (const bf16x8*)((const bf16_t*)(P.ws + WS_BBF) + (size_t)(l * NG + g) * 8 * 64 * 8);
  const bf16x8* ccp = (const bf16x8*)((const bf16_t*)(P.ws + WS_CCF) + (size_t)(l * NG + g) * 4 * 64 * 8);
  bf16x8 bbf[8], ccf[4];
#pragma unroll
  for (int i = 0; i < 8; ++i) bbf[i] = bbp[i * 64 + lane];
#pragma unroll
  for (int i = 0; i < 4; ++i) ccf[i] = ccp[i * 64 + lane];
  const float* ab = (const float*)(P.ws + WS_AB);
  const float ar = ab[(l * NG + g) * NP + lane], ai = ab[2 * NG * NP + (l * NG + g) * NP + lane];
  unsigned char* wl = lds + 64 + wave * 12544;
  float hr = 0.f, hi = 0.f;
  if (SAMPLE) {
    s5_wave<2>(P, l, g, MP + wave * 128, 8, wl, hr, hi, bbf, ccf, ar, ai);
  } else {
    const int rowbase = b * SEQ + (wave < 3 ? wave * 448 : 1344), nch = wave < 3 ? 28 : 44;
    if (wave < 3) s5_wave<0>(P, l, g, rowbase, 28, wl, hr, hi, bbf, ccf, ar, ai);
    f32x2* xch = (f32x2*)(lds + L_S5X);
    xch[wave * 64 + lane] = (f32x2){hr, hi};
    float pr = ar, pi = ai;
#pragma unroll
    for (int i = 0; i < 6; ++i) { const float nr = pr * pr - pi * pi, ni = 2.f * pr * pi; pr = nr; pi = ni; }
    const float q64r = pr, q64i = pi;
    { const float nr = pr * pr - pi * pi, ni = 2.f * pr * pi; pr = nr; pi = ni; }
    const float q128r = pr, q128i = pi;
    { const float nr = pr * pr - pi * pi, ni = 2.f * pr * pi; pr = nr; pi = ni; }
    { const float tr = pr * q128r - pi * q128i, ti = pr * q128i + pi * q128r; pr = tr * q64r - ti * q64i; pi = tr * q64i + ti * q64r; }
    __syncthreads();
    hr = 0.f; hi = 0.f;
    for (int j = 0; j < wave; ++j) {
      const f32x2 e = xch[j * 64 + lane];
      const float nr = fmaf(pr, hr, fmaf(-pi, hi, e.x)), ni = fmaf(pr, hi, fmaf(pi, hr, e.y));
      hr = nr; hi = ni;
    }
    s5_wave<1>(P, l, g, rowbase, nch, wl, hr, hi, bbf, ccf, ar, ai);
    if (wave == 3) {
      P.out[O_S5RP + ((size_t)(l * NB + b) * NG + g) * NP + lane] = hr;
      P.out[O_S5IP + ((size_t)(l * NB + b) * NG + g) * NP + lane] = hi;
    }
  }
}

constexpr int L_CN = 64, L_BN = L_CN + 17408, L_BT = L_BN + 17408, L_XT = L_BT + 18432, L_MM = L_XT + 9216, L_DT = L_MM + 9216, L_CS = L_DT + 256;

__device__ __forceinline__ void ssd_prompt_task(const Params& P, int l, int b, int h, unsigned char* lds, int dummy, int c1, int cfull) {
  const int tid = opaque_tid(), lane = tid & 63, wave = tid >> 6, fr = lane & 15, fq = lane >> 4;
  const int gi = h >> 2, pw = wave * 16;
  const bf16_t* proj = (const bf16_t*)(P.ws + WS_PROJ);
  const bf16_t* xc = (const bf16_t*)(P.ws + WS_XC);
  const float* dtvb = (const float*)(P.ws + WS_DTV);
  bf16_t* act = (bf16_t*)(P.ws + WS_ACT);
  float* sss = (float*)(P.ws + WS_SS) + (dummy ? 8 : 5 + l) * MT;
  const float a_h = -expf(P.a_log[l * NH + h]), dsk = P.ssd_d[l * NH + h];
  f32x4 S[8];
#pragma unroll
  for (int i = 0; i < 8; ++i) S[i] = (f32x4){0.f, 0.f, 0.f, 0.f};
  const int crow = tid >> 4, cch = tid & 15;
  u32x4 pc[4], pb[4], px[2]; float pdt;
  {
    const bf16_t* base = xc + (size_t)(b * SEQ) * CONVD;
#pragma unroll
    for (int i = 0; i < 4; ++i) { pc[i] = (u32x4){0u, 0u, 0u, 0u}; if (cfull == 0) pc[i] = *(const u32x4*)(base + (size_t)(i * 16 + crow) * CONVD + 3072 + gi * 128 + cch * 8); }
#pragma unroll
    for (int i = 0; i < 2; ++i) {
      pb[i * 2] = *(const u32x4*)(base + (size_t)((i * 16 + crow) * 2) * CONVD + 2048 + gi * 128 + cch * 8);
      pb[i * 2 + 1] = *(const u32x4*)(base + (size_t)((i * 16 + crow) * 2 + 1) * CONVD + 2048 + gi * 128 + cch * 8);
    }
    px[0] = *(const u32x4*)(base + (size_t)((tid >> 3) * 2) * CONVD + h * 64 + (tid & 7) * 8);
    px[1] = *(const u32x4*)(base + (size_t)((tid >> 3) * 2 + 1) * CONVD + h * 64 + (tid & 7) * 8);
    pdt = dtvb[(size_t)(b * SEQ + lane) * 32 + h];
  }
#pragma unroll 1
  for (int c = 0; c < c1; ++c) {
    const int rowc = b * SEQ + c * 64;
    const bool full = c >= cfull;
    float* DTs = (float*)(lds + L_DT + (c & 1) * 512); float* CSs = DTs + 64;
    {
      float cs = pdt * a_h;
#pragma unroll
      for (int o = 1; o < 64; o <<= 1) { const float v = __shfl_up(cs, o); if (lane >= o) cs += v; }
      if (wave == 0) { DTs[lane] = pdt; CSs[lane] = cs; }
    }
    __syncthreads();
    const float cs_end = CSs[63];
    {
      if (full) {
#pragma unroll
        for (int i = 0; i < 4; ++i) *(u32x4*)(lds + L_CN + (i * 16 + crow) * 272 + cch * 16) = pc[i];
      }
#pragma unroll
      for (int i = 0; i < 2; ++i) {
        const int t0 = (i * 16 + crow) * 2;
        const u32x4 v0 = pb[i * 2], v1 = pb[i * 2 + 1];
        if (full) {
          *(u32x4*)(lds + L_BN + t0 * 272 + cch * 16) = v0;
          *(u32x4*)(lds + L_BN + (t0 + 1) * 272 + cch * 16) = v1;
        }
        const float d0 = __expf(cs_end - CSs[t0]) * DTs[t0], d1 = __expf(cs_end - CSs[t0 + 1]) * DTs[t0 + 1];
        unsigned char* bt = lds + L_BT + (cch * 8) * 144 + t0 * 2;
        *(unsigned*)(bt + 0 * 144) = pk2(bflo(v0.x) * d0, bflo(v1.x) * d1);
        *(unsigned*)(bt + 1 * 144) = pk2(bfhi(v0.x) * d0, bfhi(v1.x) * d1);
        *(unsigned*)(bt + 2 * 144) = pk2(bflo(v0.y) * d0, bflo(v1.y) * d1);
        *(unsigned*)(bt + 3 * 144) = pk2(bfhi(v0.y) * d0, bfhi(v1.y) * d1);
        *(unsigned*)(bt + 4 * 144) = pk2(bflo(v0.z) * d0, bflo(v1.z) * d1);
        *(unsigned*)(bt + 5 * 144) = pk2(bfhi(v0.z) * d0, bfhi(v1.z) * d1);
        *(unsigned*)(bt + 6 * 144) = pk2(bflo(v0.w) * d0, bflo(v1.w) * d1);
        *(unsigned*)(bt + 7 * 144) = pk2(bfhi(v0.w) * d0, bfhi(v1.w) * d1);
      }
      {
        const u32x4 v0 = px[0], v1 = px[1];
        unsigned char* xt = lds + L_XT + ((tid & 7) * 8) * 144 + (tid >> 3) * 4;
        *(unsigned*)(xt + 0 * 144) = (v0.x & 0xffffu) | (v1.x << 16);
        *(unsigned*)(xt + 1 * 144) = (v0.x >> 16) | (v1.x & 0xffff0000u);
        *(unsigned*)(xt + 2 * 144) = (v0.y & 0xffffu) | (v1.y << 16);
        *(unsigned*)(xt + 3 * 144) = (v0.y >> 16) | (v1.y & 0xffff0000u);
        *(unsigned*)(xt + 4 * 144) = (v0.z & 0xffffu) | (v1.z << 16);
        *(unsigned*)(xt + 5 * 144) = (v0.z >> 16) | (v1.z & 0xffff0000u);
        *(unsigned*)(xt + 6 * 144) = (v0.w & 0xffffu) | (v1.w << 16);
        *(unsigned*)(xt + 7 * 144) = (v0.w >> 16) | (v1.w & 0xffff0000u);
      }
    }
    if (c + 1 < c1) {
      const bf16_t* base = xc + (size_t)(rowc + 64) * CONVD;
      if (c + 1 >= cfull) {
#pragma unroll
        for (int i = 0; i < 4; ++i) pc[i] = *(const u32x4*)(base + (size_t)(i * 16 + crow) * CONVD + 3072 + gi * 128 + cch * 8);
      }
#pragma unroll
      for (int i = 0; i < 2; ++i) {
        pb[i * 2] = *(const u32x4*)(base + (size_t)((i * 16 + crow) * 2) * CONVD + 2048 + gi * 128 + cch * 8);
        pb[i * 2 + 1] = *(const u32x4*)(base + (size_t)((i * 16 + crow) * 2 + 1) * CONVD + 2048 + gi * 128 + cch * 8);
      }
      px[0] = *(const u32x4*)(base + (size_t)((tid >> 3) * 2) * CONVD + h * 64 + (tid & 7) * 8);
      px[1] = *(const u32x4*)(base + (size_t)((tid >> 3) * 2 + 1) * CONVD + h * 64 + (tid & 7) * 8);
      pdt = dtvb[(size_t)(rowc + 64 + lane) * 32 + h];
    }
    __syncthreads();
    u32x2 zwv[4];
#pragma unroll
    for (int tt = 0; tt < 4; ++tt) { zwv[tt] = (u32x2){0u, 0u}; if (full) zwv[tt] = *(const u32x2*)(proj + (size_t)(rowc + tt * 16 + fr) * NPROJ + 8192 + h * 64 + pw + fq * 4); }
    if (full) {
      bf16x8 cf[4];
#pragma unroll
      for (int ks = 0; ks < 4; ++ks) cf[ks] = *(const bf16x8*)(lds + L_CN + (wave * 16 + fr) * 272 + ks * 64 + fq * 16);
      const int tcol = wave * 16 + fr; const float cst = CSs[tcol];
#pragma unroll
      for (int st = 0; st < 4; ++st) {
        f32x4 g = {0.f, 0.f, 0.f, 0.f};
#pragma unroll
        for (int ks = 0; ks < 4; ++ks) {
          const bf16x8 bf = *(const bf16x8*)(lds + L_BN + (st * 16 + fr) * 272 + ks * 64 + fq * 16);
          g = MFMA16(bf, cf[ks], g);
        }
        float m[4];
#pragma unroll
        for (int r = 0; r < 4; ++r) {
          const int s_ = st * 16 + fq * 4 + r;
          m[r] = s_ <= tcol ? g[r] * __expf(cst - CSs[s_]) * DTs[s_] : 0.f;
        }
        u32x2 o; o.x = pk2(m[0], m[1]); o.y = pk2(m[2], m[3]);
        *(u32x2*)(lds + L_MM + tcol * 144 + (st * 16 + fq * 4) * 2) = o;
      }
    }
    __syncthreads();
    {
      bf16x8 sf[4];
#pragma unroll
      for (int ks = 0; ks < 4; ++ks) {
        u32x4 v; v.x = pk2(S[2 * ks].x, S[2 * ks].y); v.y = pk2(S[2 * ks].z, S[2 * ks].w); v.z = pk2(S[2 * ks + 1].x, S[2 * ks + 1].y); v.w = pk2(S[2 * ks + 1].z, S[2 * ks + 1].w);
        sf[ks] = __builtin_bit_cast(bf16x8, v);
      }
      bf16x8 xf[2];
#pragma unroll
      for (int k2 = 0; k2 < 2; ++k2) xf[k2] = *(const bf16x8*)(lds + L_XT + (pw + fr) * 144 + k2 * 64 + fq * 16);
      if (full) {
#pragma unroll
      for (int tt = 0; tt < 4; ++tt) {
        const int t = tt * 16 + fr;
        f32x4 y = {0.f, 0.f, 0.f, 0.f};
#pragma unroll
        for (int ks = 0; ks < 4; ++ks) {
          const u32x2 c0 = *(const u32x2*)(lds + L_CN + t * 272 + ((2 * ks) * 16 + fq * 4) * 2);
          const u32x2 c1 = *(const u32x2*)(lds + L_CN + t * 272 + ((2 * ks + 1) * 16 + fq * 4) * 2);
          u32x4 cv; cv.x = c0.x; cv.y = c0.y; cv.z = c1.x; cv.w = c1.y;
          y = MFMA16(sf[ks], __builtin_bit_cast(bf16x8, cv), y);
        }
        y *= __expf(CSs[t]);
#pragma unroll
        for (int k2 = 0; k2 < 2; ++k2) {
          const bf16x8 mf = *(const bf16x8*)(lds + L_MM + t * 144 + k2 * 64 + fq * 16);
          y = MFMA16(xf[k2], mf, y);
        }
        const int row = rowc + t, pc_ = pw + fq * 4;
        const u32x2 zw = zwv[tt];
        const float x0 = bf1(*(const bf16_t*)(lds + L_XT + (pc_ + 0) * 144 + t * 2)), x1 = bf1(*(const bf16_t*)(lds + L_XT + (pc_ + 1) * 144 + t * 2));
        const float x2 = bf1(*(const bf16_t*)(lds + L_XT + (pc_ + 2) * 144 + t * 2)), x3 = bf1(*(const bf16_t*)(lds + L_XT + (pc_ + 3) * 144 + t * 2));
        const float v0 = (y.x + dsk * x0) * siluf_(bflo(zw.x)), v1 = (y.y + dsk * x1) * siluf_(bfhi(zw.x));
        const float v2 = (y.z + dsk * x2) * siluf_(bflo(zw.y)), v3 = (y.w + dsk * x3) * siluf_(bfhi(zw.y));
        u32x2 o; o.x = pk2(v0, v1); o.y = pk2(v2, v3);
        *(u32x2*)(act + (size_t)row * 4096 + 2048 + h * 64 + pc_) = o;
        float ss = v0 * v0 + v1 * v1 + v2 * v2 + v3 * v3;
        ss += __shfl_xor(ss, 16); ss += __shfl_xor(ss, 32);
        if (fq == 0) atomicAdd(sss + row, ss);
      }
      }
      const float dec = __expf(cs_end);
#pragma unroll
      for (int nt = 0; nt < 8; ++nt) {
        S[nt] *= dec;
#pragma unroll
        for (int k2 = 0; k2 < 2; ++k2) {
          const bf16x8 bt = *(const bf16x8*)(lds + L_BT + (nt * 16 + fr) * 144 + k2 * 64 + fq * 16);
          S[nt] = MFMA16(bt, xf[k2], S[nt]);
        }
      }
    }
  }
  if (c1 == SEQ / 64) {
    float* so = P.out + O_SSDP + ((size_t)(l * NB + b) * NH + h) * HD * SN;
#pragma unroll
    for (int nt = 0; nt < 8; ++nt) *(f32x4*)(so + (size_t)(pw + fr) * SN + nt * 16 + fq * 4) = S[nt];
  }
}

struct SampLd { f32x4 st[8]; u32x4 xcv; float dtv; float zt[4]; };
__device__ __forceinline__ void ssd_sample_load(const Params& P, int l, int task, int tid, SampLd& L) {
  const int b = task >> 5, h = task & 31, gi = h >> 2, row0 = MP + b * 4;
  const float* sin_ = P.st_ssd + ((size_t)(l * DB + b) * NH + h) * HD * SN;
#pragma unroll
  for (int j = 0; j < 8; ++j) L.st[j] = *(const f32x4*)(sin_ + (j * 256 + tid) * 4);
  L.xcv = (u32x4){0u, 0u, 0u, 0u}; L.dtv = 0.f;
  if (tid < 160) {
    const int t = tid / 40, q = tid % 40;
    const int ch = q < 8 ? h * 64 + q * 8 : q < 24 ? 2048 + gi * 128 + (q - 8) * 8 : 3072 + gi * 128 + (q - 24) * 8;
    L.xcv = *(const u32x4*)((const bf16_t*)(P.ws + WS_XC) + (size_t)(row0 + t) * CONVD + ch);
  }
  if (tid >= 192 && tid < 196) L.dtv = ((const float*)(P.ws + WS_DTV))[(size_t)(row0 + tid - 192) * 32 + h];
  const int p = tid >> 2;
#pragma unroll
  for (int t = 0; t < 4; ++t) L.zt[t] = bf1(((const bf16_t*)(P.ws + WS_PROJ))[(size_t)(row0 + t) * NPROJ + 8192 + h * 64 + p]);
}

__device__ __forceinline__ void ssd_sample_batch(const Params& P, int l, int batch, unsigned char* lds, int dummy) {
  const int tid = opaque_tid(), lane = tid & 63;
  bf16_t* act = (bf16_t*)(P.ws + WS_ACT);
  float* sss = (float*)(P.ws + WS_SS) + (dummy ? 8 : 5 + l) * MT;
  float* xs = (float*)(lds + 64);
  float* Bs = xs + 256;
  float* Cs = Bs + 512;
  float* dts = Cs + 512;
  float* St0 = dts + 16;
  const int p = tid >> 2, nq = tid & 3, n0 = nq * 32;
  SampLd L;
  ssd_sample_load(P, l, batch * 8, tid, L);
#pragma unroll 1
  for (int i = 0; i < 8; ++i) {
    const int task = batch * 8 + i, b = task >> 5, h = task & 31, row0 = MP + b * 4;
    float* St = St0 + (i & 1) * (64 * 132);
    const float a_h = -expf(P.a_log[l * NH + h]), dsk = P.ssd_d[l * NH + h];
#pragma unroll
    for (int j = 0; j < 8; ++j) { const int f = (j * 256 + tid) * 4; *(f32x4*)(St + (f >> 7) * 132 + (f & 127)) = L.st[j]; }
    if (tid < 160) {
      const int t = tid / 40, q = tid % 40;
      float* dst = q < 8 ? xs + t * 64 + q * 8 : q < 24 ? Bs + t * 128 + (q - 8) * 8 : Cs + t * 128 + (q - 24) * 8;
      const u32x4 v = L.xcv;
      *(f32x4*)dst = (f32x4){bflo(v.x), bfhi(v.x), bflo(v.y), bfhi(v.y)};
      *(f32x4*)(dst + 4) = (f32x4){bflo(v.z), bfhi(v.z), bflo(v.w), bfhi(v.w)};
    }
    if (tid >= 192 && tid < 196) dts[tid - 192] = L.dtv;
    float zt[4];
#pragma unroll
    for (int t = 0; t < 4; ++t) zt[t] = L.zt[t];
    __syncthreads();
    if (i + 1 < 8) ssd_sample_load(P, l, task + 1, tid, L);
    f32x4 hs[8];
#pragma unroll
    for (int j = 0; j < 8; ++j) hs[j] = *(const f32x4*)(St + p * 132 + n0 + j * 4);
#pragma unroll
    for (int t = 0; t < 4; ++t) {
      const float dtv = dts[t], dA = __expf(dtv * a_h), xv = xs[t * 64 + p], xdt = xv * dtv;
      float yp = 0.f;
#pragma unroll
      for (int j = 0; j < 8; ++j) {
        const f32x4 bv = *(const f32x4*)(Bs + t * 128 + n0 + j * 4);
        const f32x4 cv = *(const f32x4*)(Cs + t * 128 + n0 + j * 4);
        hs[j] = hs[j] * dA + bv * xdt;
        yp += hs[j].x * cv.x + hs[j].y * cv.y + hs[j].z * cv.z + hs[j].w * cv.w;
      }
      yp += __shfl_xor(yp, 1); yp += __shfl_xor(yp, 2);
      const int row = row0 + t;
      float v = 0.f;
      if (nq == 0) {
        v = (yp + dsk * xv) * siluf_(zt[t]);
        act[(size_t)row * 4096 + 2048 + h * 64 + p] = (bf16_t)(pk2(v, 0.f) & 0xffff);
      }
      const float ss = wave_sum(v * v);
      if (lane == 0) atomicAdd(sss + row, ss);
    }
#pragma unroll
    for (int j = 0; j < 8; ++j) *(f32x4*)(St + p * 132 + n0 + j * 4) = hs[j];
    __syncthreads();
    float* so = P.out + O_SSDS + ((size_t)(l * DB + b) * NH + h) * HD * SN;
#pragma unroll
    for (int j = 0; j < 8; ++j) { const int f = (j * 256 + tid) * 4; *(f32x4*)(so + f) = *(const f32x4*)(St + (f >> 7) * 132 + (f & 127)); }
  }
}

__device__ __forceinline__ void phase_mix(const Params& P, int l, unsigned char* lds, int dummy = 0) {
  int* counter = (int*)(P.ws + WS_CNT) + l + (dummy ? 8 : 0);
  int* slot = (int*)lds;
  constexpr int T0 = 256, T1 = T0 + 512, T2 = T1 + DB * NH / 8, T3 = T2 + NG;
  for (;;) {
    const int t = next_task(counter, slot);
    if (t >= T3) break;
    const int mask = dummy ? (P.probe >> 4) : 15;
    if (t < T0) { if (mask & 1) { const int q = t & 127; if (t < 128) ssd_prompt_task(P, l, q >> 5, q & 31, lds, dummy, 32, 16); else ssd_prompt_task(P, l, q >> 5, q & 31, lds, dummy, 16, 0); } }
    else if (t < T1) { const int q = t - T0; if (mask & 2) s5_block_task<false>(P, l, q & 127, q >> 7, lds); }
    else if (t < T2) { if (mask & 4) ssd_sample_batch(P, l, t - T1, lds, dummy); }
    else { if (mask & 8) s5_block_task<true>(P, l, t - T2, 0, lds); }
  }
}

__device__ __forceinline__ void phase_final(const Params& P) {
  const int tid = opaque_tid(), lane = tid & 63, wave = tid >> 6;
  const float* xres = (const float*)(P.ws + WS_XRES);
  const float* ssx = (const float*)(P.ws + WS_SS) + 2 * MT;
  for (int r4 = blockIdx.x; r4 < MT / 4; r4 += gridDim.x) {
    const int row = r4 * 4 + wave;
    const float rs = rsqrtf(ssx[row] * (1.f / 2048.f) + EPS);
    float* dst = P.out + (size_t)row * DM;
#pragma unroll
    for (int j = 0; j < 8; ++j) {
      const f32x4 v = *(const f32x4*)(xres + (size_t)row * DM + (j * 64 + lane) * 4);
      const f32x4 w = *(const f32x4*)(P.final_w + (j * 64 + lane) * 4);
      *(f32x4*)(dst + (j * 64 + lane) * 4) = v * rs * w;
    }
  }
}

__global__ void __launch_bounds__(256, 2) hymba_fwd(Params P) {
  extern __shared__ __attribute__((aligned(16))) unsigned char lds[];
  cg::grid_group grid = cg::this_grid();
  for (int ph = P.ph_lo; ph < P.ph_hi; ++ph) {
    if (ph > P.ph_lo) grid.sync();
#ifndef TEST_PH
#define TEST_PH -1
#endif
    if (ph == 0) phase_prep(P, lds);
    else if (ph == 1) { phase_gemm<G_IN>(P, 0, lds); deferred_weights(P, lds); }
    else if (ph == 2 || ph == 5) phase_conv(P, ph == 2 ? 0 : 1);
    else if (ph == 3 || ph == 6) phase_mix(P, ph == 3 ? 0 : 1, lds);
    else if (ph == 4 || ph == 7) phase_chain(P, ph == 4 ? 0 : 1, lds);
    else phase_final(P);
  }
}

extern "C" void kernel_launch(void* const* d_in, const int* in_sizes, int n_in, void* d_out, int out_size, void* d_ws, size_t ws_size, hipStream_t stream) {
  static int grid_blocks = 0;
  if (!grid_blocks) {
    int dev = 0, cus = 0, per_cu = 0;
    hipGetDevice(&dev);
    hipDeviceGetAttribute(&cus, hipDeviceAttributeMultiprocessorCount, dev);
    hipFuncSetAttribute((const void*)hymba_fwd, hipFuncAttributeMaxDynamicSharedMemorySize, LDS_BYTES);
    hipOccupancyMaxActiveBlocksPerMultiprocessor(&per_cu, (const void*)hymba_fwd, 256, LDS_BYTES);
    if (per_cu > 2) per_cu = 2;
    if (per_cu < 1) per_cu = 1;
    grid_blocks = cus * per_cu;
    if (ws_size < WS_END) fprintf(stderr, "workspace too small: %zu < %zu\n", ws_size, (size_t)WS_END);
  }
  Params p{};
  const float** ip = (const float**)&p;
  for (int i = 0; i < 27; ++i) ip[i] = (const float*)d_in[i];
  p.out = (float*)d_out; p.ws = (unsigned char*)d_ws; p.ph_lo = 0; p.ph_hi = 9; p.probe = PROBE_BITS;
  void* args[] = {&p};
  hipError_t e = hipLaunchCooperativeKernel((const void*)hymba_fwd, dim3(grid_blocks), dim3(256), args, LDS_BYTES, stream);
  if (e != hipSuccess) fprintf(stderr, "cooperative launch failed: %s (grid %d)\n", hipGetErrorString(e), grid_blocks);
}
```

```cpp
#include <hip/hip_runtime.h>
#include <hip/hip_cooperative_groups.h>
#include <cstdio>
#include <cstdint>
namespace cg = cooperative_groups;

typedef unsigned short bf16_t;
typedef short bf16x8 __attribute__((ext_vector_type(8)));
typedef float f32x4 __attribute__((ext_vector_type(4)));
typedef float f32x2 __attribute__((ext_vector_type(2)));
typedef unsigned u32x4 __attribute__((ext_vector_type(4)));
typedef unsigned u32x2 __attribute__((ext_vector_type(2)));

constexpr int DM = 2048, MP = 8192, MS = 512, MT = MP + MS;
constexpr int SEQ = 2048, NB = 4, DB = 128, DSEQ = 4;
constexpr int INC = 10272, NPROJ = 10240, NPAD = 10368;
constexpr int WA = 2048, NG = 128, NP = 64, NCH = 16;
constexpr int NH = 32, HD = 64, SN = 128, CONVD = 4096;
constexpr float EPS = 1e-5f;

constexpr size_t al256(size_t x) { return (x + 255) & ~(size_t)255; }
constexpr size_t WS_WIN = 0;
constexpr size_t WS_WGLU = WS_WIN + al256((size_t)2 * NPAD * DM * 2);
constexpr size_t WS_WOUT = WS_WGLU + al256((size_t)2 * 2048 * 2048 * 2);
constexpr size_t WS_PROJ = WS_WOUT + al256((size_t)2 * 2048 * 4096 * 2);
constexpr size_t WS_DT = WS_PROJ + al256((size_t)MT * NPROJ * 2);
constexpr size_t WS_G = WS_DT + al256((size_t)MT * 32 * 4);
constexpr size_t WS_ACT = WS_G + al256((size_t)MT * 2048 * 2);
constexpr size_t WS_XRES = WS_ACT + al256((size_t)MT * 4096 * 2);
constexpr size_t WS_XB = WS_XRES + al256((size_t)MT * 2048 * 4);
constexpr size_t WS_SS = WS_XB + al256((size_t)MT * 2048 * 2);
constexpr size_t WS_AB = WS_SS + al256((size_t)9 * MT * 4);
constexpr size_t WS_BBF = WS_AB + al256((size_t)2 * 2 * NG * NP * 4);
constexpr size_t WS_CCF = WS_BBF + al256((size_t)2 * NG * 8 * 64 * 8 * 2);
constexpr size_t WS_CNT = WS_CCF + al256((size_t)2 * NG * 4 * 64 * 8 * 2);
constexpr size_t WS_FLG = WS_CNT + 256;
constexpr size_t WS_XC = WS_FLG + al256((size_t)2 * 2 * 34 * 64);
constexpr size_t WS_DTV = WS_XC + al256((size_t)MT * CONVD * 2);
constexpr size_t WS_END = WS_DTV + al256((size_t)MT * 32 * 4);

constexpr int LDS_BYTES = 73728;
#ifndef PROBE_BITS
#define PROBE_BITS 0
#endif

struct Params {
  const float *x_prompt, *x_sample, *st_s5_re, *st_s5_im, *st_ssd, *cache_conv;
  const float *norm_w, *w_in, *lam_re, *lam_im, *log_step, *b_re, *b_im, *c_re, *c_im, *s5_d;
  const float *glu_w, *glu_b, *s5_norm_w, *conv_w, *conv_b, *dt_bias, *a_log, *ssd_d, *ssd_norm_w, *w_out, *final_w;
  float* out; unsigned char* ws; int ph_lo, ph_hi, probe, pad_;
};

constexpr size_t O_YP = 0;
constexpr size_t O_YS = O_YP + (size_t)MP * DM;
constexpr size_t O_S5RP = O_YS + (size_t)MS * DM;
constexpr size_t O_S5IP = O_S5RP + (size_t)2 * NB * NG * NP;
constexpr size_t O_SSDP = O_S5IP + (size_t)2 * NB * NG * NP;
constexpr size_t O_CONVP = O_SSDP + (size_t)2 * NB * NH * HD * SN;
constexpr size_t O_S5RS = O_CONVP + (size_t)2 * NB * 3 * CONVD;
constexpr size_t O_S5IS = O_S5RS + (size_t)2 * DB * NG * NP;
constexpr size_t O_SSDS = O_S5IS + (size_t)2 * DB * NG * NP;
constexpr size_t O_CONVS = O_SSDS + (size_t)2 * DB * NH * HD * SN;

typedef __bf16 bf16n2 __attribute__((ext_vector_type(2)));
__device__ __forceinline__ unsigned pk2(float lo, float hi) { const f32x2 v = {lo, hi}; return __builtin_bit_cast(unsigned, __builtin_convertvector(v, bf16n2)); }
__device__ __forceinline__ float bflo(unsigned w) { return __uint_as_float(w << 16); }
__device__ __forceinline__ float bfhi(unsigned w) { return __uint_as_float(w & 0xffff0000u); }
__device__ __forceinline__ float bf1(bf16_t h) { return __uint_as_float((unsigned)h << 16); }
__device__ __forceinline__ float sigmoidf_(float x) { return __builtin_amdgcn_rcpf(1.f + __expf(-x)); }
__device__ __forceinline__ float siluf_(float x) { return x * __builtin_amdgcn_rcpf(1.f + __expf(-x)); }
__device__ __forceinline__ float gelu_tanh(float y) { const float z = 0.7978845608028654f * (y + 0.044715f * y * y * y); return y * __builtin_amdgcn_rcpf(1.f + __expf(-2.f * z)); }
__device__ __forceinline__ float wave_sum(float v) {
#pragma unroll
  for (int o = 1; o < 64; o <<= 1) v += __shfl_xor(v, o);
  return v;
}
__device__ __forceinline__ int opaque_tid() { int t = threadIdx.x; asm volatile("" : "+v"(t)); return t; }
__device__ __forceinline__ void st_wt8(void* p, u32x2 v) {
  __hip_atomic_store((unsigned long long*)p, ((unsigned long long)v.y << 32) | v.x, __ATOMIC_RELAXED, __HIP_MEMORY_SCOPE_AGENT);
}
#define LDS_FENCE() asm volatile("s_waitcnt lgkmcnt(0)" ::: "memory")
#define MFMA16(a, b, c) __builtin_amdgcn_mfma_f32_16x16x32_bf16((a), (b), (c), 0, 0, 0)

__device__ __forceinline__ int next_task(int* counter, int* slot) {
  __syncthreads();
  if (threadIdx.x == 0) *slot = atomicAdd(counter, 1);
  __syncthreads();
  return *slot;
}

__device__ __forceinline__ void transpose_tile(const float* W, int K, int N, bf16_t* WT, const float* sc0, const float* sc1, int tile, float* tl) {
  const int tid = opaque_tid();
  const int nkb = K / 64, kb = tile % nkb, nb = tile / nkb, k0 = kb * 64, n0 = nb * 64;
#pragma unroll
  for (int i = 0; i < 4; ++i) {
    const int idx = tid + i * 256, kk = idx >> 4, n4 = (idx & 15) * 4, k = k0 + kk, n = n0 + n4;
    f32x4 v = {0.f, 0.f, 0.f, 0.f};
    if (n < N) { v = *(const f32x4*)(W + (size_t)k * N + n); if (sc0) v *= (k < 2048 ? sc0[k] : sc1[k - 2048]); }
    tl[(n4 + 0) * 65 + kk] = v.x; tl[(n4 + 1) * 65 + kk] = v.y; tl[(n4 + 2) * 65 + kk] = v.z; tl[(n4 + 3) * 65 + kk] = v.w;
  }
  __syncthreads();
  {
    const int n = tid >> 2, kc = (tid & 3) * 16;
    const float* s = tl + n * 65 + kc;
    u32x4 o0, o1;
    o0.x = pk2(s[0], s[1]); o0.y = pk2(s[2], s[3]); o0.z = pk2(s[4], s[5]); o0.w = pk2(s[6], s[7]);
    o1.x = pk2(s[8], s[9]); o1.y = pk2(s[10], s[11]); o1.z = pk2(s[12], s[13]); o1.w = pk2(s[14], s[15]);
    u32x4* dst = (u32x4*)(WT + (size_t)(n0 + n) * K + k0 + kc);
    dst[0] = o0; dst[1] = o1;
  }
  __syncthreads();
}

__device__ __forceinline__ void sincos_own(float ang, float& s, float& c) {
  const float k = rintf(ang * 0.15915494309189535f);
  float r = fmaf(-k, 6.28125f, ang); r = fmaf(-k, 1.9353071795864769e-3f, r);
  const float r2 = r * r;
  float ps = -1.f / 121645100408832000.f;
  ps = fmaf(ps, r2, 1.f / 355687428096000.f);
  ps = fmaf(ps, r2, -1.f / 1307674368000.f);
  ps = fmaf(ps, r2, 1.f / 6227020800.f);
  ps = fmaf(ps, r2, -1.f / 39916800.f);
  ps = fmaf(ps, r2, 1.f / 362880.f);
  ps = fmaf(ps, r2, -1.f / 5040.f);
  ps = fmaf(ps, r2, 1.f / 120.f);
  ps = fmaf(ps, r2, -1.f / 6.f);
  s = fmaf(ps * r2, r, r);
  float pc = 1.f / 2432902008176640000.f;
  pc = fmaf(pc, r2, -1.f / 6402373705728000.f);
  pc = fmaf(pc, r2, 1.f / 20922789888000.f);
  pc = fmaf(pc, r2, -1.f / 87178291200.f);
  pc = fmaf(pc, r2, 1.f / 479001600.f);
  pc = fmaf(pc, r2, -1.f / 3628800.f);
  pc = fmaf(pc, r2, 1.f / 40320.f);
  pc = fmaf(pc, r2, -1.f / 720.f);
  pc = fmaf(pc, r2, 1.f / 24.f);
  pc = fmaf(pc, r2, -0.5f);
  c = fmaf(pc, r2, 1.f);
}

__device__ __forceinline__ void s5_precompute(const Params& P, int l, int g, float* tl) {
  const int tid = opaque_tid();
  float* gre = tl; float* gim = tl + 64;
  if (tid < 64) {
    const int idx = (l * NG + g) * NP + tid;
    const float lr = fminf(P.lam_re[idx], -1e-4f), li = P.lam_im[idx];
    const float step = expf(P.log_step[l * NG + g]);
    const float mag = expf(lr * step);
    float sn, cs; sincos_own(li * step, sn, cs);
    const float abr = mag * cs, abi = mag * sn;
    const float den = lr * lr + li * li, nr = abr - 1.f;
    gre[tid] = (nr * lr + abi * li) / den;
    gim[tid] = (abi * lr - nr * li) / den;
    float* ab = (float*)(P.ws + WS_AB);
    ab[idx] = abr; ab[2 * NG * NP + idx] = abi;
  }
  __syncthreads();
  bf16_t* bbf = (bf16_t*)(P.ws + WS_BBF) + (size_t)(l * NG + g) * 8 * 64 * 8;
  const float* br = P.b_re + (size_t)(l * NG + g) * NP * NCH;
  const float* bi = P.b_im + (size_t)(l * NG + g) * NP * NCH;
  for (int j = 0; j < 16; ++j) {
    const int idx = tid * 16 + j, tile = idx >> 9, lane = (idx >> 3) & 63, e = idx & 7;
    const int pt = tile >> 1, part = tile & 1, p = pt * 16 + (lane & 15), q = lane >> 4, c = q * 8 + e;
    float v = 0.f;
    if (q < 2) { const float a = br[p * NCH + c], b = bi[p * NCH + c]; v = part == 0 ? gre[p] * a - gim[p] * b : gre[p] * b + gim[p] * a; }
    bbf[idx] = (bf16_t)(pk2(v, 0.f) & 0xffff);
  }
  bf16_t* ccf = (bf16_t*)(P.ws + WS_CCF) + (size_t)(l * NG + g) * 4 * 64 * 8;
  const float* cr = P.c_re + (size_t)(l * NG + g) * NCH * NP;
  const float* ci = P.c_im + (size_t)(l * NG + g) * NCH * NP;
  for (int j = 0; j < 8; ++j) {
    const int idx = tid * 8 + j, ks = idx >> 9, lane = (idx >> 3) & 63, e = idx & 7;
    const int c = lane & 15, q = lane >> 4, k = ks * 32 + q * 8 + e, p = k >> 1, part = k & 1;
    const float v = part == 0 ? cr[c * NP + p] : -ci[c * NP + p];
    ccf[idx] = (bf16_t)(pk2(v, 0.f) & 0xffff);
  }
  __syncthreads();
}

constexpr int TW_WIN = 2 * 32 * (NPAD / 64), TW_GLU = 2 * 32 * 32, TW_OUT = 2 * 64 * 32, TW_ALL = TW_WIN + TW_GLU + TW_OUT;
__device__ __forceinline__ void weight_tile_task(const Params& P, int r, float* tl) {
  if (r < TW_WIN) { const int per = 32 * (NPAD / 64), l = r / per; transpose_tile(P.w_in + (size_t)l * DM * INC, DM, INC, (bf16_t*)(P.ws + WS_WIN) + (size_t)l * NPAD * DM, P.norm_w + l * DM, P.norm_w + l * DM, r % per, tl); return; }
  r -= TW_WIN;
  if (r < TW_GLU) { const int per = 32 * 32, l = r / per; transpose_tile(P.glu_w + (size_t)l * 2048 * 2048, 2048, 2048, (bf16_t*)(P.ws + WS_WGLU) + (size_t)l * 2048 * 2048, nullptr, nullptr, r % per, tl); return; }
  r -= TW_GLU;
  { const int per = 64 * 32, l = r / per; transpose_tile(P.w_out + (size_t)l * 4096 * 2048, 4096, 2048, (bf16_t*)(P.ws + WS_WOUT) + (size_t)l * 2048 * 4096, P.s5_norm_w + l * 2048, P.ssd_norm_w + l * 2048, r % per, tl); }
}
__device__ __forceinline__ void deferred_weights(const Params& P, unsigned char* lds) {
  float* tl = (float*)(lds + 64);
  const int grid = gridDim.x, slots = grid >> 3, q = (blockIdx.x & 7) * slots + (blockIdx.x >> 3);
  const int leftover = (34 * 81) % grid;
  int rank = q, n = grid;
  if (leftover != 0) { if (q < leftover) return; rank = q - leftover; n = grid - leftover; }
  __syncthreads();
  for (int r = 32 * (NPAD / 64) + rank; r < TW_ALL; r += n) weight_tile_task(P, r, tl);
}

__device__ __forceinline__ void phase_prep(const Params& P, unsigned char* lds) {
  float* tl = (float*)(lds + 64);
  const int tid = opaque_tid(), lane = tid & 63, wave = tid >> 6;
  {
    float* ss = (float*)(P.ws + WS_SS);
    for (int i = blockIdx.x * 256 + tid; i < 8 * MT; i += gridDim.x * 256) ss[MT + i] = 0.f;
    if (blockIdx.x == 0 && tid < 64) ((int*)(P.ws + WS_CNT))[tid] = 0;
    if (blockIdx.x == 1) for (int i = tid; i < 2 * 2 * 34 * 16; i += 256) ((int*)(P.ws + WS_FLG))[i] = 0;
  }
  constexpr int T_W0 = 32 * (NPAD / 64), T_X = MT / 4, T_S5 = 2 * NG;
  constexpr int T_ALL = T_W0 + T_X + T_S5;
  for (int t = blockIdx.x; t < T_ALL; t += gridDim.x) {
    int r = t;
    if (r < T_W0) { weight_tile_task(P, r, tl); continue; }
    r -= T_W0;
    if (r < T_X) {
      const int row = r * 4 + wave;
      const float* src = row < MP ? P.x_prompt + (size_t)row * DM : P.x_sample + (size_t)(row - MP) * DM;
      bf16_t* dst = (bf16_t*)(P.ws + WS_XB) + (size_t)row * DM;
      float s = 0.f;
#pragma unroll
      for (int j = 0; j < 8; ++j) {
        const f32x4 v = *(const f32x4*)(src + (j * 64 + lane) * 4);
        s += v.x * v.x + v.y * v.y + v.z * v.z + v.w * v.w;
        u32x2 o; o.x = pk2(v.x, v.y); o.y = pk2(v.z, v.w);
        *(u32x2*)(dst + (j * 64 + lane) * 4) = o;
      }
      s = wave_sum(s);
      if (lane == 0) ((float*)(P.ws + WS_SS))[row] = s;
      continue;
    }
    r -= T_X;
    s5_precompute(P, r / NG, r % NG, tl);
  }
}

constexpr int G_IN = 0, G_GLU = 1, G_OUT = 2;

__device__ __forceinline__ bool gemm_unit_of(int v, int NT, int& pm, int& pn) {
  const int total = 34 * NT;
  if (v >= total) return false;
  const int ng = NT >> 3, rem = NT & 7;
  if (v < ng * 272) { const int pg = v / 272, w = v % 272; pm = w >> 3; pn = pg * 8 + (w & 7); }
  else { const int w = v - ng * 272; pm = w / rem; pn = ng * 8 + w % rem; }
  return true;
}

template <int MODE>
__device__ __forceinline__ void gemm_unit(const Params& P, int l, int pm, int pn, unsigned char* lds, int dummy) {
  constexpr int K = MODE == G_OUT ? 4096 : 2048;
  constexpr int NK = K / 32;
  const bf16_t* A = MODE == G_IN ? (const bf16_t*)(P.ws + WS_XB) : MODE == G_GLU ? (const bf16_t*)(P.ws + WS_G) : (const bf16_t*)(P.ws + WS_ACT);
  const bf16_t* Bt = MODE == G_IN ? (const bf16_t*)(P.ws + WS_WIN) + (size_t)l * NPAD * DM
                   : MODE == G_GLU ? (const bf16_t*)(P.ws + WS_WGLU) + (size_t)l * 2048 * 2048
                                   : (const bf16_t*)(P.ws + WS_WOUT) + (size_t)l * 2048 * 4096;
  const int tid = opaque_tid(), lane = tid & 63, wave = tid >> 6, wr = wave >> 1, wc = wave & 1, fr = lane & 15, fq = lane >> 4;
  unsigned char* base = lds + 64;
  const int grow = tid >> 2, gch = (tid & 3) ^ ((((tid >> 2) >> 3) & 1) << 1);
  const bf16_t* Ag = A + (size_t)(pm * 256 + grow) * K + gch * 8;
  const bf16_t* Bg = Bt + (size_t)(pn * 128 + grow) * K + gch * 8;
  const int swz = (fq ^ ((fr >> 3) << 1)) << 4;
  const int a_rd = (wr * 128 + fr) * 64 + swz;
  const int b_rd = 16384 + (wc * 64 + fr) * 64 + swz;

  f32x4 acc[8][4];
#pragma unroll
  for (int mi = 0; mi < 8; ++mi)
#pragma unroll
    for (int ni = 0; ni < 4; ++ni) acc[mi][ni] = (f32x4){0.f, 0.f, 0.f, 0.f};

  auto stage_tile = [&](int kt, unsigned char* st) __attribute__((always_inline)) {
#pragma unroll
    for (int i = 0; i < 4; ++i) __builtin_amdgcn_global_load_lds((const unsigned*)(Ag + (size_t)i * 64 * K + kt * 32), (unsigned*)(st + (tid + i * 256) * 16), 16, 0, 0);
#pragma unroll
    for (int i = 0; i < 2; ++i) __builtin_amdgcn_global_load_lds((const unsigned*)(Bg + (size_t)i * 64 * K + kt * 32), (unsigned*)(st + 16384 + (tid + i * 256) * 16), 16, 0, 0);
  };
  stage_tile(0, base);
  __syncthreads();

  for (int kt = 0; kt < NK; ++kt) {
    unsigned char* cur = base + (kt & 1) * 24576;
    unsigned char* nxt = base + ((kt & 1) ^ 1) * 24576;
    if (kt + 1 < NK) stage_tile(kt + 1, nxt);
    __builtin_amdgcn_sched_barrier(0);
    if (MODE == G_OUT && kt == NK / 2) {
      const float* ssa = (const float*)(P.ws + WS_SS) + (3 + l) * MT;
      const float* sss = (const float*)(P.ws + WS_SS) + (5 + l) * MT;
#pragma unroll
      for (int mi = 0; mi < 8; ++mi) {
        const int row = pm * 256 + wr * 128 + mi * 16 + fr;
        const float ra = rsqrtf(ssa[row] * (1.f / 2048.f) + EPS), rs = rsqrtf(sss[row] * (1.f / 2048.f) + EPS);
        const float ratio = ra / rs;
#pragma unroll
        for (int ni = 0; ni < 4; ++ni) acc[mi][ni] *= ratio;
      }
    }
    bf16x8 af[8], bfr[4];
#pragma unroll
    for (int mi = 0; mi < 8; ++mi) af[mi] = *(const bf16x8*)(cur + a_rd + mi * 1024);
#pragma unroll
    for (int ni = 0; ni < 4; ++ni) bfr[ni] = *(const bf16x8*)(cur + b_rd + ni * 1024);
    __builtin_amdgcn_s_setprio(1);
#pragma unroll
    for (int mi = 0; mi < 8; ++mi)
#pragma unroll
      for (int ni = 0; ni < 4; ++ni) acc[mi][ni] = MFMA16(bfr[ni], af[mi], acc[mi][ni]);
    __builtin_amdgcn_s_setprio(0);
    __syncthreads();
  }

  const int row0 = pm * 256 + wr * 128 + fr, col0 = pn * 128 + wc * 64 + fq * 4;
  if (MODE == G_IN) {
    const float* ssx = (const float*)(P.ws + WS_SS) + l * MT;
    bf16_t* proj = (bf16_t*)(P.ws + WS_PROJ);
    float* dtb = (float*)(P.ws + WS_DT);
#pragma unroll
    for (int mi = 0; mi < 8; ++mi) {
      const int row = row0 + mi * 16;
      const float rs = rsqrtf(ssx[row] * (1.f / 2048.f) + EPS);
#pragma unroll
      for (int ni = 0; ni < 4; ++ni) {
        const f32x4 v = acc[mi][ni] * rs;
        const int col = col0 + ni * 16;
        if (pn < 80) { u32x2 o; o.x = pk2(v.x, v.y); o.y = pk2(v.z, v.w); *(u32x2*)(proj + (size_t)row * NPROJ + col) = o; }
        else if (col < NPROJ + 32) { *(f32x4*)(dtb + (size_t)row * 32 + (col - NPROJ)) = v; }
      }
    }
  } else if (MODE == G_GLU) {
    const bf16_t* gbuf = (const bf16_t*)(P.ws + WS_G);
    const bf16_t* proj = (const bf16_t*)(P.ws + WS_PROJ);
    bf16_t* act = (bf16_t*)(P.ws + WS_ACT);
    float* ssa = (float*)(P.ws + WS_SS) + (dummy ? 7 : 3 + l) * MT;
    const float* gb_ = P.glu_b + l * 2048;
#pragma unroll
    for (int mi = 0; mi < 8; ++mi) {
      const int row = row0 + mi * 16;
      float ss = 0.f;
#pragma unroll
      for (int ni = 0; ni < 4; ++ni) {
        const int col = col0 + ni * 16;
        const f32x4 bv = *(const f32x4*)(gb_ + col);
        const u32x2 gw = *(const u32x2*)(gbuf + (size_t)row * 2048 + col);
        const u32x2 zw = *(const u32x2*)(proj + (size_t)row * NPROJ + 2048 + col);
        const f32x4 a = acc[mi][ni] + bv;
        const float v0 = bflo(gw.x) * sigmoidf_(a.x) * siluf_(bflo(zw.x));
        const float v1 = bfhi(gw.x) * sigmoidf_(a.y) * siluf_(bfhi(zw.x));
        const float v2 = bflo(gw.y) * sigmoidf_(a.z) * siluf_(bflo(zw.y));
        const float v3 = bfhi(gw.y) * sigmoidf_(a.w) * siluf_(bfhi(zw.y));
        ss += v0 * v0 + v1 * v1 + v2 * v2 + v3 * v3;
        u32x2 o; o.x = pk2(v0, v1); o.y = pk2(v2, v3);
        st_wt8(act + (size_t)row * 4096 + col, o);
      }
      ss += __shfl_xor(ss, 16); ss += __shfl_xor(ss, 32);
      if (fq == 0) atomicAdd(ssa + row, ss);
    }
  } else {
    const float* sss = (const float*)(P.ws + WS_SS) + (5 + l) * MT;
    float* ssx = (float*)(P.ws + WS_SS) + (l + 1) * MT;
    float* xres = (float*)(P.ws + WS_XRES);
    bf16_t* xb = (bf16_t*)(P.ws + WS_XB);
#pragma unroll
    for (int mi = 0; mi < 8; ++mi) {
      const int row = row0 + mi * 16;
      const float rs = rsqrtf(sss[row] * (1.f / 2048.f) + EPS);
      const float* xold = l == 0 ? (row < MP ? P.x_prompt + (size_t)row * DM : P.x_sample + (size_t)(row - MP) * DM) : xres + (size_t)row * DM;
      float ss = 0.f;
#pragma unroll
      for (int ni = 0; ni < 4; ++ni) {
        const int col = col0 + ni * 16;
        const f32x4 xo = *(const f32x4*)(xold + col);
        const f32x4 v = xo + acc[mi][ni] * rs;
        ss += v.x * v.x + v.y * v.y + v.z * v.z + v.w * v.w;
        st_wt8(xres + (size_t)row * DM + col, (u32x2){__float_as_uint(v.x), __float_as_uint(v.y)});
        st_wt8(xres + (size_t)row * DM + col + 2, (u32x2){__float_as_uint(v.z), __float_as_uint(v.w)});
        u32x2 o; o.x = pk2(v.x, v.y); o.y = pk2(v.z, v.w);
        st_wt8(xb + (size_t)row * DM + col, o);
      }
      ss += __shfl_xor(ss, 16); ss += __shfl_xor(ss, 32);
      if (fq == 0) atomicAdd(ssx + row, ss);
    }
  }
}

template <int MODE>
__device__ __forceinline__ void phase_gemm(const Params& P, int l, unsigned char* lds, int dummy = 0) {
  constexpr int NT = MODE == G_IN ? 81 : 16;
  const int slots = gridDim.x >> 3, xcd = blockIdx.x & 7, slot = blockIdx.x >> 3;
  for (int i = 0;; ++i) {
    const int v = (i * 8 + xcd) * slots + slot;
    int pm, pn;
    if (!gemm_unit_of(v, NT, pm, pn)) break;
    gemm_unit<MODE>(P, l, pm, pn, lds, dummy);
  }
}


__device__ __forceinline__ int* panel_flag(const Params& P, int l, int kind, int pm) { return (int*)(P.ws + WS_FLG) + ((l * 2 + kind) * 34 + pm) * 16; }
__device__ __forceinline__ void panel_wait(int* flag, int need) {
  if (threadIdx.x == 0) { while (__hip_atomic_load(flag, __ATOMIC_RELAXED, __HIP_MEMORY_SCOPE_AGENT) < need) __builtin_amdgcn_s_sleep(4); }
  __syncthreads();
  asm volatile("" ::: "memory");
}
__device__ __forceinline__ void panel_signal(int* flag) {
  asm volatile("s_waitcnt vmcnt(0)" ::: "memory");
  __syncthreads();
  if (threadIdx.x == 0) __hip_atomic_fetch_add(flag, 1, __ATOMIC_RELAXED, __HIP_MEMORY_SCOPE_AGENT);
}
__device__ __forceinline__ void phase_chain(const Params& P, int l, unsigned char* lds) {
  const int nGLU = 34 * 16, nOUT = 34 * 16, nIN = l == 0 ? 34 * 81 : 0, total = nGLU + nOUT + nIN;
  const int slots = gridDim.x >> 3, xcd = blockIdx.x & 7, slot = blockIdx.x >> 3;
  for (int i = 0;; ++i) {
    const int v = (i * 8 + xcd) * slots + slot;
    if (v >= total) break;
    int pm, pn;
    if (v < nGLU) {
      gemm_unit_of(v, 16, pm, pn);
      gemm_unit<G_GLU>(P, l, pm, pn, lds, 0);
      panel_signal(panel_flag(P, l, 0, pm));
    } else if (v < nGLU + nOUT) {
      gemm_unit_of(v - nGLU, 16, pm, pn);
      panel_wait(panel_flag(P, l, 0, pm), 16);
      gemm_unit<G_OUT>(P, l, pm, pn, lds, 0);
      panel_signal(panel_flag(P, l, 1, pm));
    } else {
      gemm_unit_of(v - nGLU - nOUT, 81, pm, pn);
      panel_wait(panel_flag(P, l, 1, pm), 16);
      gemm_unit<G_IN>(P, l + 1, pm, pn, lds, 0);
    }
  }
}

__device__ __forceinline__ void conv8(const u32x4* r, int i, const f32x4* w, const f32x4* bias, float* o) {
#pragma unroll
  for (int hf = 0; hf < 2; ++hf) {
    f32x4 a = bias[hf];
#pragma unroll
    for (int k = 0; k < 4; ++k) {
      const u32x4 rv = r[i + k];
      const unsigned w0 = hf == 0 ? rv.x : rv.z, w1 = hf == 0 ? rv.y : rv.w;
      const f32x4 wk = w[k * 2 + hf];
      a.x = fmaf(wk.x, bflo(w0), a.x); a.y = fmaf(wk.y, bfhi(w0), a.y);
      a.z = fmaf(wk.z, bflo(w1), a.z); a.w = fmaf(wk.w, bfhi(w1), a.w);
    }
    o[hf * 4 + 0] = siluf_(a.x); o[hf * 4 + 1] = siluf_(a.y); o[hf * 4 + 2] = siluf_(a.z); o[hf * 4 + 3] = siluf_(a.w);
  }
}
__device__ __forceinline__ void store8f(float* dst, u32x4 v) {
  *(f32x4*)dst = (f32x4){bflo(v.x), bfhi(v.x), bflo(v.y), bfhi(v.y)};
  *(f32x4*)(dst + 4) = (f32x4){bflo(v.z), bfhi(v.z), bflo(v.w), bfhi(v.w)};
}

__device__ __forceinline__ void phase_conv(const Params& P, int l) {
  const int tid = opaque_tid();
  const int gsz = gridDim.x * 256, gid = blockIdx.x * 256 + tid;
  const bf16_t* proj = (const bf16_t*)(P.ws + WS_PROJ);
  bf16_t* xc = (bf16_t*)(P.ws + WS_XC);
  const float* cw = P.conv_w + (size_t)l * 4 * CONVD;
  const float* cb = P.conv_b + (size_t)l * CONVD;
#pragma unroll 1
  for (int it = gid; it < (MP / 8) * 512; it += gsz) {
    const int ch0 = (it & 511) * 8, row0 = (it >> 9) * 8, t0 = row0 & (SEQ - 1);
    u32x4 r[11];
#pragma unroll
    for (int j = 0; j < 11; ++j) {
      r[j] = (u32x4){0u, 0u, 0u, 0u};
      if (t0 - 3 + j >= 0) r[j] = *(const u32x4*)(proj + (size_t)(row0 - 3 + j) * NPROJ + 4096 + ch0);
    }
    f32x4 w[8], bias[2];
#pragma unroll
    for (int k = 0; k < 4; ++k) { w[k * 2] = *(const f32x4*)(cw + k * CONVD + ch0); w[k * 2 + 1] = *(const f32x4*)(cw + k * CONVD + ch0 + 4); }
    bias[0] = *(const f32x4*)(cb + ch0); bias[1] = *(const f32x4*)(cb + ch0 + 4);
#pragma unroll
    for (int i = 0; i < 8; ++i) {
      float o[8]; conv8(r, i, w, bias, o);
      u32x4 q; q.x = pk2(o[0], o[1]); q.y = pk2(o[2], o[3]); q.z = pk2(o[4], o[5]); q.w = pk2(o[6], o[7]);
      *(u32x4*)(xc + (size_t)(row0 + i) * CONVD + ch0) = q;
    }
    if (t0 == SEQ - 8) {
      const int bb = row0 >> 11;
#pragma unroll
      for (int j = 0; j < 3; ++j) store8f(P.out + O_CONVP + ((size_t)(l * NB + bb) * 3 + j) * CONVD + ch0, r[8 + j]);
    }
  }
#pragma unroll 1
  for (int it = gid; it < DB * 512; it += gsz) {
    const int ch0 = (it & 511) * 8, bb = it >> 9, row0 = MP + bb * 4;
    u32x4 r[7];
#pragma unroll
    for (int j = 0; j < 3; ++j) {
      const float* cp = P.cache_conv + ((size_t)(l * DB + bb) * 3 + j) * CONVD + ch0;
      const f32x4 c0 = *(const f32x4*)cp, c1 = *(const f32x4*)(cp + 4);
      r[j].x = pk2(c0.x, c0.y); r[j].y = pk2(c0.z, c0.w); r[j].z = pk2(c1.x, c1.y); r[j].w = pk2(c1.z, c1.w);
    }
#pragma unroll
    for (int j = 0; j < 4; ++j) r[3 + j] = *(const u32x4*)(proj + (size_t)(row0 + j) * NPROJ + 4096 + ch0);
    f32x4 w[8], bias[2];
#pragma unroll
    for (int k = 0; k < 4; ++k) { w[k * 2] = *(const f32x4*)(cw + k * CONVD + ch0); w[k * 2 + 1] = *(const f32x4*)(cw + k * CONVD + ch0 + 4); }
    bias[0] = *(const f32x4*)(cb + ch0); bias[1] = *(const f32x4*)(cb + ch0 + 4);
#pragma unroll
    for (int i = 0; i < 4; ++i) {
      float o[8]; conv8(r, i, w, bias, o);
      u32x4 q; q.x = pk2(o[0], o[1]); q.y = pk2(o[2], o[3]); q.z = pk2(o[4], o[5]); q.w = pk2(o[6], o[7]);
      *(u32x4*)(xc + (size_t)(row0 + i) * CONVD + ch0) = q;
    }
#pragma unroll
    for (int j = 0; j < 3; ++j) store8f(P.out + O_CONVS + ((size_t)(l * DB + bb) * 3 + j) * CONVD + ch0, r[4 + j]);
  }
  {
    const float* dtb = (const float*)(P.ws + WS_DT);
    float* dtv = (float*)(P.ws + WS_DTV);
    for (int i = gid; i < MT * 32; i += gsz) {
      const float x = dtb[i] + P.dt_bias[l * NH + (i & 31)];
      dtv[i] = fmaxf(x, 0.f) + log1pf(__expf(-fabsf(x)));
    }
  }
}

template <int MODE>
__device__ __forceinline__ void s5_wave(const Params& P, int l, int g, int rowbase, int nchunks, unsigned char* wl, float& hr, float& hi,
                                        const bf16x8 (&bbf)[8], const bf16x8 (&ccf)[4], float ar, float ai) {
  const int lane = opaque_tid() & 63, fr = lane & 15, fq = lane >> 4;
  unsigned char* bu = wl; unsigned char* Hb = wl + 8192;
  const bf16_t* proj = (const bf16_t*)(P.ws + WS_PROJ);
  bf16_t* gbuf = (bf16_t*)(P.ws + WS_G);
  f32x4 dv = {0.f, 0.f, 0.f, 0.f};
  if (MODE != 0) dv = *(const f32x4*)(P.s5_d + l * WA + g * NCH + fq * 4);
  const bf16x8 zero8 = {0, 0, 0, 0, 0, 0, 0, 0};
  bf16x8 uf = zero8;
  if (fq < 2) uf = *(const bf16x8*)(proj + (size_t)(rowbase + fr) * NPROJ + g * NCH + fq * 8);
#pragma unroll 1
  for (int c = 0; c < nchunks; ++c) {
    const int row0 = rowbase + c * 16;
    f32x4 t[8];
#pragma unroll
    for (int i = 0; i < 8; ++i) t[i] = MFMA16(uf, bbf[i], ((f32x4){0.f, 0.f, 0.f, 0.f}));
    u32x2 uw = {0u, 0u};
    if (MODE != 0) uw = *(const u32x2*)(proj + (size_t)(row0 + fr) * NPROJ + g * NCH + fq * 4);
    if (c + 1 < nchunks) { if (fq < 2) uf = *(const bf16x8*)(proj + (size_t)(row0 + 16 + fr) * NPROJ + g * NCH + fq * 8); }
#pragma unroll
    for (int pt = 0; pt < 4; ++pt)
#pragma unroll
      for (int r = 0; r < 4; ++r) {
        f32x2 v; v.x = t[2 * pt][r]; v.y = t[2 * pt + 1][r];
        *(f32x2*)(bu + (fq * 4 + r) * 512 + (pt * 16 + fr) * 8) = v;
      }
    LDS_FENCE();
#pragma unroll
    for (int tt = 0; tt < 16; ++tt) {
      if (MODE == 2 && (tt & 3) == 0) {
        const int b = ((row0 - MP) >> 2) + (tt >> 2);
        hr = P.st_s5_re[((size_t)(l * DB + b) * NG + g) * NP + lane];
        hi = P.st_s5_im[((size_t)(l * DB + b) * NG + g) * NP + lane];
      }
      const f32x2 bv = *(const f32x2*)(bu + tt * 512 + lane * 8);
      const float nr = fmaf(ar, hr, fmaf(-ai, hi, bv.x));
      const float ni = fmaf(ar, hi, fmaf(ai, hr, bv.y));
      hr = nr; hi = ni;
      if (MODE != 0) *(unsigned*)(Hb + tt * 272 + lane * 4) = pk2(hr, hi);
      if (MODE == 2 && (tt & 3) == 3) {
        const int b = ((row0 - MP) >> 2) + (tt >> 2);
        P.out[O_S5RS + ((size_t)(l * DB + b) * NG + g) * NP + lane] = hr;
        P.out[O_S5IS + ((size_t)(l * DB + b) * NG + g) * NP + lane] = hi;
      }
    }
    LDS_FENCE();
    if (MODE != 0) {
      f32x4 y = {0.f, 0.f, 0.f, 0.f};
#pragma unroll
      for (int ks = 0; ks < 4; ++ks) {
        const bf16x8 hf = *(const bf16x8*)(Hb + fr * 272 + ks * 64 + fq * 16);
        y = MFMA16(ccf[ks], hf, y);
      }
      LDS_FENCE();
      const float y0 = gelu_tanh(y.x + dv.x * bflo(uw.x)), y1 = gelu_tanh(y.y + dv.y * bfhi(uw.x));
      const float y2 = gelu_tanh(y.z + dv.z * bflo(uw.y)), y3 = gelu_tanh(y.w + dv.w * bfhi(uw.y));
      u32x2 o; o.x = pk2(y0, y1); o.y = pk2(y2, y3);
      *(u32x2*)(gbuf + (size_t)(row0 + fr) * 2048 + g * NCH + fq * 4) = o;
    }
  }
}

constexpr int L_S5X = 64 + 4 * 12544;
template <bool SAMPLE>
__device__ __forceinline__ void s5_block_task(const Params& P, int l, int g, int b, unsigned char* lds) {
  const int tid = opaque_tid(), lane = tid & 63, wave = tid >> 6;
  const bf16x8* bbp = (const bf16x8*)((const bf16_t*)(P.ws + WS_BBF) + (size_t)(l * NG + g) * 8 * 64 * 8);
  const bf16x8* ccp = (const bf16x8*)((const bf16_t*)(P.ws + WS_CCF) + (size_t)(l * NG + g) * 4 * 64 * 8);
  bf16x8 bbf[8], ccf[4];
#pragma unroll
  for (int i = 0; i < 8; ++i) bbf[i] = bbp[i * 64 + lane];
#pragma unroll
  for (int i = 0; i < 4; ++i) ccf[i] = ccp[i * 64 + lane];
  const float* ab = (const float*)(P.ws + WS_AB);
  const float ar = ab[(l * NG + g) * NP + lane], ai = ab[2 * NG * NP + (l * NG + g) * NP + lane];
  unsigned char* wl = lds + 64 + wave * 12544;
  float hr = 0.f, hi = 0.f;
  if (SAMPLE) {
    s5_wave<2>(P, l, g, MP + wave * 128, 8, wl, hr, hi, bbf, ccf, ar, ai);
  } else {
    const int rowbase = b * SEQ + (wave < 3 ? wave * 448 : 1344), nch = wave < 3 ? 28 : 44;
    if (wave < 3) s5_wave<0>(P, l, g, rowbase, 28, wl, hr, hi, bbf, ccf, ar, ai);
    f32x2* xch = (f32x2*)(lds + L_S5X);
    xch[wave * 64 + lane] = (f32x2){hr, hi};
    float pr = ar, pi = ai;
#pragma unroll
    for (int i = 0; i < 6; ++i) { const float nr = pr * pr - pi * pi, ni = 2.f * pr * pi; pr = nr; pi = ni; }
    const float q64r = pr, q64i = pi;
    { const float nr = pr * pr - pi * pi, ni = 2.f * pr * pi; pr = nr; pi = ni; }
    const float q128r = pr, q128i = pi;
    { const float nr = pr * pr - pi * pi, ni = 2.f * pr * pi; pr = nr; pi = ni; }
    { const float tr = pr * q128r - pi * q128i, ti = pr * q128i + pi * q128r; pr = tr * q64r - ti * q64i; pi = tr * q64i + ti * q64r; }
    __syncthreads();
    hr = 0.f; hi = 0.f;
    for (int j = 0; j < wave; ++j) {
      const f32x2 e = xch[j * 64 + lane];
      const float nr = fmaf(pr, hr, fmaf(-pi, hi, e.x)), ni = fmaf(pr, hi, fmaf(pi, hr, e.y));
      hr = nr; hi = ni;
    }
    s5_wave<1>(P, l, g, rowbase, nch, wl, hr, hi, bbf, ccf, ar, ai);
    if (wave == 3) {
      P.out[O_S5RP + ((size_t)(l * NB + b) * NG + g) * NP + lane] = hr;
      P.out[O_S5IP + ((size_t)(l * NB + b) * NG + g) * NP + lane] = hi;
    }
  }
}

constexpr int L_CN = 64, L_BN = L_CN + 17408, L_BT = L_BN + 17408, L_XT = L_BT + 18432, L_MM = L_XT + 9216, L_DT = L_MM + 9216, L_CS = L_DT + 256;

__device__ __forceinline__ void ssd_prompt_task(const Params& P, int l, int b, int h, unsigned char* lds, int dummy, int c1, int cfull) {
  const int tid = opaque_tid(), lane = tid & 63, wave = tid >> 6, fr = lane & 15, fq = lane >> 4;
  const int gi = h >> 2, pw = wave * 16;
  const bf16_t* proj = (const bf16_t*)(P.ws + WS_PROJ);
  const bf16_t* xc = (const bf16_t*)(P.ws + WS_XC);
  const float* dtvb = (const float*)(P.ws + WS_DTV);
  bf16_t* act = (bf16_t*)(P.ws + WS_ACT);
  float* sss = (float*)(P.ws + WS_SS) + (dummy ? 8 : 5 + l) * MT;
  const float a_h = -expf(P.a_log[l * NH + h]), dsk = P.ssd_d[l * NH + h];
  f32x4 S[8];
#pragma unroll
  for (int i = 0; i < 8; ++i) S[i] = (f32x4){0.f, 0.f, 0.f, 0.f};
  const int crow = tid >> 4, cch = tid & 15;
  u32x4 pc[4], pb[4], px[2]; float pdt;
  {
    const bf16_t* base = xc + (size_t)(b * SEQ) * CONVD;
#pragma unroll
    for (int i = 0; i < 4; ++i) { pc[i] = (u32x4){0u, 0u, 0u, 0u}; if (cfull == 0) pc[i] = *(const u32x4*)(base + (size_t)(i * 16 + crow) * CONVD + 3072 + gi * 128 + cch * 8); }
#pragma unroll
    for (int i = 0; i < 2; ++i) {
      pb[i * 2] = *(const u32x4*)(base + (size_t)((i * 16 + crow) * 2) * CONVD + 2048 + gi * 128 + cch * 8);
      pb[i * 2 + 1] = *(const u32x4*)(base + (size_t)((i * 16 + crow) * 2 + 1) * CONVD + 2048 + gi * 128 + cch * 8);
    }
    px[0] = *(const u32x4*)(base + (size_t)((tid >> 3) * 2) * CONVD + h * 64 + (tid & 7) * 8);
    px[1] = *(const u32x4*)(base + (size_t)((tid >> 3) * 2 + 1) * CONVD + h * 64 + (tid & 7) * 8);
    pdt = dtvb[(size_t)(b * SEQ + lane) * 32 + h];
  }
#pragma unroll 1
  for (int c = 0; c < c1; ++c) {
    const int rowc = b * SEQ + c * 64;
    const bool full = c >= cfull;
    float* DTs = (float*)(lds + L_DT + (c & 1) * 512); float* CSs = DTs + 64;
    {
      float cs = pdt * a_h;
#pragma unroll
      for (int o = 1; o < 64; o <<= 1) { const float v = __shfl_up(cs, o); if (lane >= o) cs += v; }
      if (wave == 0) { DTs[lane] = pdt; CSs[lane] = cs; }
    }
    __syncthreads();
    const float cs_end = CSs[63];
    {
      if (full) {
#pragma unroll
        for (int i = 0; i < 4; ++i) *(u32x4*)(lds + L_CN + (i * 16 + crow) * 272 + cch * 16) = pc[i];
      }
#pragma unroll
      for (int i = 0; i < 2; ++i) {
        const int t0 = (i * 16 + crow) * 2;
        const u32x4 v0 = pb[i * 2], v1 = pb[i * 2 + 1];
        if (full) {
          *(u32x4*)(lds + L_BN + t0 * 272 + cch * 16) = v0;
          *(u32x4*)(lds + L_BN + (t0 + 1) * 272 + cch * 16) = v1;
        }
        const float d0 = __expf(cs_end - CSs[t0]) * DTs[t0], d1 = __expf(cs_end - CSs[t0 + 1]) * DTs[t0 + 1];
        unsigned char* bt = lds + L_BT + (cch * 8) * 144 + t0 * 2;
        *(unsigned*)(bt + 0 * 144) = pk2(bflo(v0.x) * d0, bflo(v1.x) * d1);
        *(unsigned*)(bt + 1 * 144) = pk2(bfhi(v0.x) * d0, bfhi(v1.x) * d1);
        *(unsigned*)(bt + 2 * 144) = pk2(bflo(v0.y) * d0, bflo(v1.y) * d1);
        *(unsigned*)(bt + 3 * 144) = pk2(bfhi(v0.y) * d0, bfhi(v1.y) * d1);
        *(unsigned*)(bt + 4 * 144) = pk2(bflo(v0.z) * d0, bflo(v1.z) * d1);
        *(unsigned*)(bt + 5 * 144) = pk2(bfhi(v0.z) * d0, bfhi(v1.z) * d1);
        *(unsigned*)(bt + 6 * 144) = pk2(bflo(v0.w) * d0, bflo(v1.w) * d1);
        *(unsigned*)(bt + 7 * 144) = pk2(bfhi(v0.w) * d0, bfhi(v1.w) * d1);
      }
      {
        const u32x4 v0 = px[0], v1 = px[1];
        unsigned char* xt = lds + L_XT + ((tid & 7) * 8) * 144 + (tid >> 3) * 4;
        *(unsigned*)(xt + 0 * 144) = (v0.x & 0xffffu) | (v1.x << 16);
        *(unsigned*)(xt + 1 * 144) = (v0.x >> 16) | (v1.x & 0xffff0000u);
        *(unsigned*)(xt + 2 * 144) = (v0.y & 0xffffu) | (v1.y << 16);
        *(unsigned*)(xt + 3 * 144) = (v0.y >> 16) | (v1.y & 0xffff0000u);
        *(unsigned*)(xt + 4 * 144) = (v0.z & 0xffffu) | (v1.z << 16);
        *(unsigned*)(xt + 5 * 144) = (v0.z >> 16) | (v1.z & 0xffff0000u);
        *(unsigned*)(xt + 6 * 144) = (v0.w & 0xffffu) | (v1.w << 16);
        *(unsigned*)(xt + 7 * 144) = (v0.w >> 16) | (v1.w & 0xffff0000u);
      }
    }
    if (c + 1 < c1) {
      const bf16_t* base = xc + (size_t)(rowc + 64) * CONVD;
      if (c + 1 >= cfull) {
#pragma unroll
        for (int i = 0; i < 4; ++i) pc[i] = *(const u32x4*)(base + (size_t)(i * 16 + crow) * CONVD + 3072 + gi * 128 + cch * 8);
      }
#pragma unroll
      for (int i = 0; i < 2; ++i) {
        pb[i * 2] = *(const u32x4*)(base + (size_t)((i * 16 + crow) * 2) * CONVD + 2048 + gi * 128 + cch * 8);
        pb[i * 2 + 1] = *(const u32x4*)(base + (size_t)((i * 16 + crow) * 2 + 1) * CONVD + 2048 + gi * 128 + cch * 8);
      }
      px[0] = *(const u32x4*)(base + (size_t)((tid >> 3) * 2) * CONVD + h * 64 + (tid & 7) * 8);
      px[1] = *(const u32x4*)(base + (size_t)((tid >> 3) * 2 + 1) * CONVD + h * 64 + (tid & 7) * 8);
      pdt = dtvb[(size_t)(rowc + 64 + lane) * 32 + h];
    }
    __syncthreads();
    u32x2 zwv[4];
#pragma unroll
    for (int tt = 0; tt < 4; ++tt) { zwv[tt] = (u32x2){0u, 0u}; if (full) zwv[tt] = *(const u32x2*)(proj + (size_t)(rowc + tt * 16 + fr) * NPROJ + 8192 + h * 64 + pw + fq * 4); }
    if (full) {
      bf16x8 cf[4];
#pragma unroll
      for (int ks = 0; ks < 4; ++ks) cf[ks] = *(const bf16x8*)(lds + L_CN + (wave * 16 + fr) * 272 + ks * 64 + fq * 16);
      const int tcol = wave * 16 + fr; const float cst = CSs[tcol];
#pragma unroll
      for (int st = 0; st < 4; ++st) {
        f32x4 g = {0.f, 0.f, 0.f, 0.f};
#pragma unroll
        for (int ks = 0; ks < 4; ++ks) {
          const bf16x8 bf = *(const bf16x8*)(lds + L_BN + (st * 16 + fr) * 272 + ks * 64 + fq * 16);
          g = MFMA16(bf, cf[ks], g);
        }
        float m[4];
#pragma unroll
        for (int r = 0; r < 4; ++r) {
          const int s_ = st * 16 + fq * 4 + r;
          m[r] = s_ <= tcol ? g[r] * __expf(cst - CSs[s_]) * DTs[s_] : 0.f;
        }
        u32x2 o; o.x = pk2(m[0], m[1]); o.y = pk2(m[2], m[3]);
        *(u32x2*)(lds + L_MM + tcol * 144 + (st * 16 + fq * 4) * 2) = o;
      }
    }
    __syncthreads();
    {
      bf16x8 sf[4];
#pragma unroll
      for (int ks = 0; ks < 4; ++ks) {
        u32x4 v; v.x = pk2(S[2 * ks].x, S[2 * ks].y); v.y = pk2(S[2 * ks].z, S[2 * ks].w); v.z = pk2(S[2 * ks + 1].x, S[2 * ks + 1].y); v.w = pk2(S[2 * ks + 1].z, S[2 * ks + 1].w);
        sf[ks] = __builtin_bit_cast(bf16x8, v);
      }
      bf16x8 xf[2];
#pragma unroll
      for (int k2 = 0; k2 < 2; ++k2) xf[k2] = *(const bf16x8*)(lds + L_XT + (pw + fr) * 144 + k2 * 64 + fq * 16);
      if (full) {
#pragma unroll
      for (int tt = 0; tt < 4; ++tt) {
        const int t = tt * 16 + fr;
        f32x4 y = {0.f, 0.f, 0.f, 0.f};
#pragma unroll
        for (int ks = 0; ks < 4; ++ks) {
          const u32x2 c0 = *(const u32x2*)(lds + L_CN + t * 272 + ((2 * ks) * 16 + fq * 4) * 2);
          const u32x2 c1 = *(const u32x2*)(lds + L_CN + t * 272 + ((2 * ks + 1) * 16 + fq * 4) * 2);
          u32x4 cv; cv.x = c0.x; cv.y = c0.y; cv.z = c1.x; cv.w = c1.y;
          y = MFMA16(sf[ks], __builtin_bit_cast(bf16x8, cv), y);
        }
        y *= __expf(CSs[t]);
#pragma unroll
        for (int k2 = 0; k2 < 2; ++k2) {
          const bf16x8 mf = *(const bf16x8*)(lds + L_MM + t * 144 + k2 * 64 + fq * 16);
          y = MFMA16(xf[k2], mf, y);
        }
        const int row = rowc + t, pc_ = pw + fq * 4;
        const u32x2 zw = zwv[tt];
        const float x0 = bf1(*(const bf16_t*)(lds + L_XT + (pc_ + 0) * 144 + t * 2)), x1 = bf1(*(const bf16_t*)(lds + L_XT + (pc_ + 1) * 144 + t * 2));
        const float x2 = bf1(*(const bf16_t*)(lds + L_XT + (pc_ + 2) * 144 + t * 2)), x3 = bf1(*(const bf16_t*)(lds + L_XT + (pc_ + 3) * 144 + t * 2));
        const float v0 = (y.x + dsk * x0) * siluf_(bflo(zw.x)), v1 = (y.y + dsk * x1) * siluf_(bfhi(zw.x));
        const float v2 = (y.z + dsk * x2) * siluf_(bflo(zw.y)), v3 = (y.w + dsk * x3) * siluf_(bfhi(zw.y));
        u32x2 o; o.x = pk2(v0, v1); o.y = pk2(v2, v3);
        *(u32x2*)(act + (size_t)row * 4096 + 2048 + h * 64 + pc_) = o;
        float ss = v0 * v0 + v1 * v1 + v2 * v2 + v3 * v3;
        ss += __shfl_xor(ss, 16); ss += __shfl_xor(ss, 32);
        if (fq == 0) atomicAdd(sss + row, ss);
      }
      }
      const float dec = __expf(cs_end);
#pragma unroll
      for (int nt = 0; nt < 8; ++nt) {
        S[nt] *= dec;
#pragma unroll
        for (int k2 = 0; k2 < 2; ++k2) {
          const bf16x8 bt = *(const bf16x8*)(lds + L_BT + (nt * 16 + fr) * 144 + k2 * 64 + fq * 16);
          S[nt] = MFMA16(bt, xf[k2], S[nt]);
        }
      }
    }
  }
  if (c1 == SEQ / 64) {
    float* so = P.out + O_SSDP + ((size_t)(l * NB + b) * NH + h) * HD * SN;
#pragma unroll
    for (int nt = 0; nt < 8; ++nt) *(f32x4*)(so + (size_t)(pw + fr) * SN + nt * 16 + fq * 4) = S[nt];
  }
}

struct SampLd { f32x4 st[8]; u32x4 xcv; float dtv; float zt[4]; };
__device__ __forceinline__ void ssd_sample_load(const Params& P, int l, int task, int tid, SampLd& L) {
  const int b = task >> 5, h = task & 31, gi = h >> 2, row0 = MP + b * 4;
  const float* sin_ = P.st_ssd + ((size_t)(l * DB + b) * NH + h) * HD * SN;
#pragma unroll
  for (int j = 0; j < 8; ++j) L.st[j] = *(const f32x4*)(sin_ + (j * 256 + tid) * 4);
  L.xcv = (u32x4){0u, 0u, 0u, 0u}; L.dtv = 0.f;
  if (tid < 160) {
    const int t = tid / 40, q = tid % 40;
    const int ch = q < 8 ? h * 64 + q * 8 : q < 24 ? 2048 + gi * 128 + (q - 8) * 8 : 3072 + gi * 128 + (q - 24) * 8;
    L.xcv = *(const u32x4*)((const bf16_t*)(P.ws + WS_XC) + (size_t)(row0 + t) * CONVD + ch);
  }
  if (tid >= 192 && tid < 196) L.dtv = ((const float*)(P.ws + WS_DTV))[(size_t)(row0 + tid - 192) * 32 + h];
  const int p = tid >> 2;
#pragma unroll
  for (int t = 0; t < 4; ++t) L.zt[t] = bf1(((const bf16_t*)(P.ws + WS_PROJ))[(size_t)(row0 + t) * NPROJ + 8192 + h * 64 + p]);
}

__device__ __forceinline__ void ssd_sample_batch(const Params& P, int l, int batch, unsigned char* lds, int dummy) {
  const int tid = opaque_tid(), lane = tid & 63;
  bf16_t* act = (bf16_t*)(P.ws + WS_ACT);
  float* sss = (float*)(P.ws + WS_SS) + (dummy ? 8 : 5 + l) * MT;
  float* xs = (float*)(lds + 64);
  float* Bs = xs + 256;
  float* Cs = Bs + 512;
  float* dts = Cs + 512;
  float* St0 = dts + 16;
  const int p = tid >> 2, nq = tid & 3, n0 = nq * 32;
  SampLd L;
  ssd_sample_load(P, l, batch * 8, tid, L);
#pragma unroll 1
  for (int i = 0; i < 8; ++i) {
    const int task = batch * 8 + i, b = task >> 5, h = task & 31, row0 = MP + b * 4;
    float* St = St0 + (i & 1) * (64 * 132);
    const float a_h = -expf(P.a_log[l * NH + h]), dsk = P.ssd_d[l * NH + h];
#pragma unroll
    for (int j = 0; j < 8; ++j) { const int f = (j * 256 + tid) * 4; *(f32x4*)(St + (f >> 7) * 132 + (f & 127)) = L.st[j]; }
    if (tid < 160) {
      const int t = tid / 40, q = tid % 40;
      float* dst = q < 8 ? xs + t * 64 + q * 8 : q < 24 ? Bs + t * 128 + (q - 8) * 8 : Cs + t * 128 + (q - 24) * 8;
      const u32x4 v = L.xcv;
      *(f32x4*)dst = (f32x4){bflo(v.x), bfhi(v.x), bflo(v.y), bfhi(v.y)};
      *(f32x4*)(dst + 4) = (f32x4){bflo(v.z), bfhi(v.z), bflo(v.w), bfhi(v.w)};
    }
    if (tid >= 192 && tid < 196) dts[tid - 192] = L.dtv;
    float zt[4];
#pragma unroll
    for (int t = 0; t < 4; ++t) zt[t] = L.zt[t];
    __syncthreads();
    if (i + 1 < 8) ssd_sample_load(P, l, task + 1, tid, L);
    f32x4 hs[8];
#pragma unroll
    for (int j = 0; j < 8; ++j) hs[j] = *(const f32x4*)(St + p * 132 + n0 + j * 4);
#pragma unroll
    for (int t = 0; t < 4; ++t) {
      const float dtv = dts[t], dA = __expf(dtv * a_h), xv = xs[t * 64 + p], xdt = xv * dtv;
      float yp = 0.f;
#pragma unroll
      for (int j = 0; j < 8; ++j) {
        const f32x4 bv = *(const f32x4*)(Bs + t * 128 + n0 + j * 4);
        const f32x4 cv = *(const f32x4*)(Cs + t * 128 + n0 + j * 4);
        hs[j] = hs[j] * dA + bv * xdt;
        yp += hs[j].x * cv.x + hs[j].y * cv.y + hs[j].z * cv.z + hs[j].w * cv.w;
      }
      yp += __shfl_xor(yp, 1); yp += __shfl_xor(yp, 2);
      const int row = row0 + t;
      float v = 0.f;
      if (nq == 0) {
        v = (yp + dsk * xv) * siluf_(zt[t]);
        act[(size_t)row * 4096 + 2048 + h * 64 + p] = (bf16_t)(pk2(v, 0.f) & 0xffff);
      }
      const float ss = wave_sum(v * v);
      if (lane == 0) atomicAdd(sss + row, ss);
    }
#pragma unroll
    for (int j = 0; j < 8; ++j) *(f32x4*)(St + p * 132 + n0 + j * 4) = hs[j];
    __syncthreads();
    float* so = P.out + O_SSDS + ((size_t)(l * DB + b) * NH + h) * HD * SN;
#pragma unroll
    for (int j = 0; j < 8; ++j) { const int f = (j * 256 + tid) * 4; *(f32x4*)(so + f) = *(const f32x4*)(St + (f >> 7) * 132 + (f & 127)); }
  }
}

__device__ __forceinline__ void phase_mix(const Params& P, int l, unsigned char* lds, int dummy = 0) {
  int* counter = (int*)(P.ws + WS_CNT) + l + (dummy ? 8 : 0);
  int* slot = (int*)lds;
  constexpr int T0 = 256, T1 = T0 + 512, T2 = T1 + DB * NH / 8, T3 = T2 + NG;
  for (;;) {
    const int t = next_task(counter, slot);
    if (t >= T3) break;
    const int mask = dummy ? (P.probe >> 4) : 15;
    if (t < T0) { if (mask & 1) { const int q = t & 127; if (t < 128) ssd_prompt_task(P, l, q >> 5, q & 31, lds, dummy, 32, 16); else ssd_prompt_task(P, l, q >> 5, q & 31, lds, dummy, 16, 0); } }
    else if (t < T1) { const int q = t - T0; if (mask & 2) s5_block_task<false>(P, l, q & 127, q >> 7, lds); }
    else if (t < T2) { if (mask & 4) ssd_sample_batch(P, l, t - T1, lds, dummy); }
    else { if (mask & 8) s5_block_task<true>(P, l, t - T2, 0, lds); }
  }
}

__device__ __forceinline__ int* panel_flag(const Params& P, int l, int kind, int pm);
__device__ __forceinline__ void panel_wait(int* flag, int need);
__device__ __forceinline__ void phase_final(const Params& P, int gated) {
  const int tid = opaque_tid(), lane = tid & 63, wave = tid >> 6;
  const float* xres = (const float*)(P.ws + WS_XRES);
  const float* ssx = (const float*)(P.ws + WS_SS) + 2 * MT;
  for (int r4 = blockIdx.x; r4 < MT / 4; r4 += gridDim.x) {
    if (gated) panel_wait(panel_flag(P, 1, 1, (r4 * 4) >> 8), 16);
    const int row = r4 * 4 + wave;
    const float rs = rsqrtf(ssx[row] * (1.f / 2048.f) + EPS);
    float* dst = P.out + (size_t)row * DM;
#pragma unroll
    for (int j = 0; j < 8; ++j) {
      const f32x4 v = *(const f32x4*)(xres + (size_t)row * DM + (j * 64 + lane) * 4);
      const f32x4 w = *(const f32x4*)(P.final_w + (j * 64 + lane) * 4);
      *(f32x4*)(dst + (j * 64 + lane) * 4) = v * rs * w;
    }
  }
}

__global__ void __launch_bounds__(256, 2) hymba_fwd(Params P) {
  extern __shared__ __attribute__((aligned(16))) unsigned char lds[];
  cg::grid_group grid = cg::this_grid();
  for (int ph = P.ph_lo; ph < P.ph_hi; ++ph) {
    if (ph > P.ph_lo) grid.sync();
#ifndef TEST_PH
#define TEST_PH -1
#endif
    if (ph == 0) phase_prep(P, lds);
    else if (ph == 1) { phase_gemm<G_IN>(P, 0, lds); deferred_weights(P, lds); }
    else if (ph == 2 || ph == 5) phase_conv(P, ph == 2 ? 0 : 1);
    else if (ph == 3 || ph == 6) phase_mix(P, ph == 3 ? 0 : 1, lds);
    else if (ph == 4) phase_chain(P, 0, lds);
    else { phase_chain(P, 1, lds); phase_final(P, 1); }
  }
}

extern "C" void kernel_launch(void* const* d_in, const int* in_sizes, int n_in, void* d_out, int out_size, void* d_ws, size_t ws_size, hipStream_t stream) {
  static int grid_blocks = 0;
  if (!grid_blocks) {
    int dev = 0, cus = 0, per_cu = 0;
    hipGetDevice(&dev);
    hipDeviceGetAttribute(&cus, hipDeviceAttributeMultiprocessorCount, dev);
    hipFuncSetAttribute((const void*)hymba_fwd, hipFuncAttributeMaxDynamicSharedMemorySize, LDS_BYTES);
    hipOccupancyMaxActiveBlocksPerMultiprocessor(&per_cu, (const void*)hymba_fwd, 256, LDS_BYTES);
    if (per_cu > 2) per_cu = 2;
    if (per_cu < 1) per_cu = 1;
    grid_blocks = cus * per_cu;
    if (ws_size < WS_END) fprintf(stderr, "workspace too small: %zu < %zu\n", ws_size, (size_t)WS_END);
  }
  Params p{};
  const float** ip = (const float**)&p;
  for (int i = 0; i < 27; ++i) ip[i] = (const float*)d_in[i];
  p.out = (float*)d_out; p.ws = (unsigned char*)d_ws; p.ph_lo = 0; p.ph_hi = 8; p.probe = PROBE_BITS;
  void* args[] = {&p};
  hipError_t e = hipLaunchCooperativeKernel((const void*)hymba_fwd, dim3(grid_blocks), dim3(256), args, LDS_BYTES, stream);
  if (e != hipSuccess) fprintf(stderr, "cooperative launch failed: %s (grid %d)\n", hipGetErrorString(e), grid_blocks);
}
```

```cpp
#include <hip/hip_runtime.h>
#include <hip/hip_cooperative_groups.h>
#include <cstdio>
#include <cstdint>
namespace cg = cooperative_groups;

typedef unsigned short bf16_t;
typedef short bf16x8 __attribute__((ext_vector_type(8)));
typedef float f32x4 __attribute__((ext_vector_type(4)));
typedef float f32x2 __attribute__((ext_vector_type(2)));
typedef unsigned u32x4 __attribute__((ext_vector_type(4)));
typedef unsigned u32x2 __attribute__((ext_vector_type(2)));

constexpr int DM = 2048, MP = 8192, MS = 512, MT = MP + MS;
constexpr int SEQ = 2048, NB = 4, DB = 128, DSEQ = 4;
constexpr int INC = 10272, NPROJ = 10240, NPAD = 10368;
constexpr int WA = 2048, NG = 128, NP = 64, NCH = 16;
constexpr int NH = 32, HD = 64, SN = 128, CONVD = 4096;
constexpr float EPS = 1e-5f;

constexpr size_t al256(size_t x) { return (x + 255) & ~(size_t)255; }
constexpr size_t WS_WIN = 0;
constexpr size_t WS_WGLU = WS_WIN + al256((size_t)2 * NPAD * DM * 2);
constexpr size_t WS_WOUT = WS_WGLU + al256((size_t)2 * 2048 * 2048 * 2);
constexpr size_t WS_PROJ = WS_WOUT + al256((size_t)2 * 2048 * 4096 * 2);
constexpr size_t WS_DT = WS_PROJ + al256((size_t)MT * NPROJ * 2);
constexpr size_t WS_G = WS_DT + al256((size_t)MT * 32 * 4);
constexpr size_t WS_ACT = WS_G + al256((size_t)MT * 2048 * 2);
constexpr size_t WS_XRES = WS_ACT + al256((size_t)MT * 4096 * 2);
constexpr size_t WS_XB = WS_XRES + al256((size_t)MT * 2048 * 4);
constexpr size_t WS_SS = WS_XB + al256((size_t)MT * 2048 * 2);
constexpr size_t WS_AB = WS_SS + al256((size_t)9 * MT * 4);
constexpr size_t WS_BBF = WS_AB + al256((size_t)2 * 2 * NG * NP * 4);
constexpr size_t WS_CCF = WS_BBF + al256((size_t)2 * NG * 8 * 64 * 8 * 2);
constexpr size_t WS_CNT = WS_CCF + al256((size_t)2 * NG * 4 * 64 * 8 * 2);
constexpr size_t WS_FLG = WS_CNT + 256;
constexpr size_t WS_XC = WS_FLG + al256((size_t)2 * 3 * 34 * 64);
constexpr size_t WS_DTV = WS_XC + al256((size_t)MT * CONVD * 2);
constexpr size_t WS_END = WS_DTV + al256((size_t)MT * 32 * 4);

constexpr int LDS_BYTES = 73728;
#ifndef PROBE_BITS
#define PROBE_BITS 0
#endif

struct Params {
  const float *x_prompt, *x_sample, *st_s5_re, *st_s5_im, *st_ssd, *cache_conv;
  const float *norm_w, *w_in, *lam_re, *lam_im, *log_step, *b_re, *b_im, *c_re, *c_im, *s5_d;
  const float *glu_w, *glu_b, *s5_norm_w, *conv_w, *conv_b, *dt_bias, *a_log, *ssd_d, *ssd_norm_w, *w_out, *final_w;
  float* out; unsigned char* ws; int ph_lo, ph_hi, probe, pad_;
};

constexpr size_t O_YP = 0;
constexpr size_t O_YS = O_YP + (size_t)MP * DM;
constexpr size_t O_S5RP = O_YS + (size_t)MS * DM;
constexpr size_t O_S5IP = O_S5RP + (size_t)2 * NB * NG * NP;
constexpr size_t O_SSDP = O_S5IP + (size_t)2 * NB * NG * NP;
constexpr size_t O_CONVP = O_SSDP + (size_t)2 * NB * NH * HD * SN;
constexpr size_t O_S5RS = O_CONVP + (size_t)2 * NB * 3 * CONVD;
constexpr size_t O_S5IS = O_S5RS + (size_t)2 * DB * NG * NP;
constexpr size_t O_SSDS = O_S5IS + (size_t)2 * DB * NG * NP;
constexpr size_t O_CONVS = O_SSDS + (size_t)2 * DB * NH * HD * SN;

typedef __bf16 bf16n2 __attribute__((ext_vector_type(2)));
__device__ __forceinline__ unsigned pk2(float lo, float hi) { const f32x2 v = {lo, hi}; return __builtin_bit_cast(unsigned, __builtin_convertvector(v, bf16n2)); }
__device__ __forceinline__ float bflo(unsigned w) { return __uint_as_float(w << 16); }
__device__ __forceinline__ float bfhi(unsigned w) { return __uint_as_float(w & 0xffff0000u); }
__device__ __forceinline__ float bf1(bf16_t h) { return __uint_as_float((unsigned)h << 16); }
__device__ __forceinline__ float sigmoidf_(float x) { return __builtin_amdgcn_rcpf(1.f + __expf(-x)); }
__device__ __forceinline__ float siluf_(float x) { return x * __builtin_amdgcn_rcpf(1.f + __expf(-x)); }
__device__ __forceinline__ float gelu_tanh(float y) { const float z = 0.7978845608028654f * (y + 0.044715f * y * y * y); return y * __builtin_amdgcn_rcpf(1.f + __expf(-2.f * z)); }
__device__ __forceinline__ float wave_sum(float v) {
#pragma unroll
  for (int o = 1; o < 64; o <<= 1) v += __shfl_xor(v, o);
  return v;
}
__device__ __forceinline__ int opaque_tid() { int t = threadIdx.x; asm volatile("" : "+v"(t)); return t; }
__device__ __forceinline__ void st_wt8(void* p, u32x2 v) {
  __hip_atomic_store((unsigned long long*)p, ((unsigned long long)v.y << 32) | v.x, __ATOMIC_RELAXED, __HIP_MEMORY_SCOPE_AGENT);
}
#define LDS_FENCE() asm volatile("s_waitcnt lgkmcnt(0)" ::: "memory")
#define MFMA16(a, b, c) __builtin_amdgcn_mfma_f32_16x16x32_bf16((a), (b), (c), 0, 0, 0)

__device__ __forceinline__ int next_task(int* counter, int* slot) {
  __syncthreads();
  if (threadIdx.x == 0) *slot = atomicAdd(counter, 1);
  __syncthreads();
  return *slot;
}

__device__ __forceinline__ void transpose_tile(const float* W, int K, int N, bf16_t* WT, const float* sc0, const float* sc1, int tile, float* tl) {
  const int tid = opaque_tid();
  const int nkb = K / 64, kb = tile % nkb, nb = tile / nkb, k0 = kb * 64, n0 = nb * 64;
#pragma unroll
  for (int i = 0; i < 4; ++i) {
    const int idx = tid + i * 256, kk = idx >> 4, n4 = (idx & 15) * 4, k = k0 + kk, n = n0 + n4;
    f32x4 v = {0.f, 0.f, 0.f, 0.f};
    if (n < N) { v = *(const f32x4*)(W + (size_t)k * N + n); if (sc0) v *= (k < 2048 ? sc0[k] : sc1[k - 2048]); }
    tl[(n4 + 0) * 65 + kk] = v.x; tl[(n4 + 1) * 65 + kk] = v.y; tl[(n4 + 2) * 65 + kk] = v.z; tl[(n4 + 3) * 65 + kk] = v.w;
  }
  __syncthreads();
  {
    const int n = tid >> 2, kc = (tid & 3) * 16;
    const float* s = tl + n * 65 + kc;
    u32x4 o0, o1;
    o0.x = pk2(s[0], s[1]); o0.y = pk2(s[2], s[3]); o0.z = pk2(s[4], s[5]); o0.w = pk2(s[6], s[7]);
    o1.x = pk2(s[8], s[9]); o1.y = pk2(s[10], s[11]); o1.z = pk2(s[12], s[13]); o1.w = pk2(s[14], s[15]);
    u32x4* dst = (u32x4*)(WT + (size_t)(n0 + n) * K + k0 + kc);
    dst[0] = o0; dst[1] = o1;
  }
  __syncthreads();
}

__device__ __forceinline__ void sincos_own(float ang, float& s, float& c) {
  const float k = rintf(ang * 0.15915494309189535f);
  float r = fmaf(-k, 6.28125f, ang); r = fmaf(-k, 1.9353071795864769e-3f, r);
  const float r2 = r * r;
  float ps = -1.f / 121645100408832000.f;
  ps = fmaf(ps, r2, 1.f / 355687428096000.f);
  ps = fmaf(ps, r2, -1.f / 1307674368000.f);
  ps = fmaf(ps, r2, 1.f / 6227020800.f);
  ps = fmaf(ps, r2, -1.f / 39916800.f);
  ps = fmaf(ps, r2, 1.f / 362880.f);
  ps = fmaf(ps, r2, -1.f / 5040.f);
  ps = fmaf(ps, r2, 1.f / 120.f);
  ps = fmaf(ps, r2, -1.f / 6.f);
  s = fmaf(ps * r2, r, r);
  float pc = 1.f / 2432902008176640000.f;
  pc = fmaf(pc, r2, -1.f / 6402373705728000.f);
  pc = fmaf(pc, r2, 1.f / 20922789888000.f);
  pc = fmaf(pc, r2, -1.f / 87178291200.f);
  pc = fmaf(pc, r2, 1.f / 479001600.f);
  pc = fmaf(pc, r2, -1.f / 3628800.f);
  pc = fmaf(pc, r2, 1.f / 40320.f);
  pc = fmaf(pc, r2, -1.f / 720.f);
  pc = fmaf(pc, r2, 1.f / 24.f);
  pc = fmaf(pc, r2, -0.5f);
  c = fmaf(pc, r2, 1.f);
}

__device__ __forceinline__ void s5_precompute(const Params& P, int l, int g, float* tl) {
  const int tid = opaque_tid();
  float* gre = tl; float* gim = tl + 64;
  if (tid < 64) {
    const int idx = (l * NG + g) * NP + tid;
    const float lr = fminf(P.lam_re[idx], -1e-4f), li = P.lam_im[idx];
    const float step = expf(P.log_step[l * NG + g]);
    const float mag = expf(lr * step);
    float sn, cs; sincos_own(li * step, sn, cs);
    const float abr = mag * cs, abi = mag * sn;
    const float den = lr * lr + li * li, nr = abr - 1.f;
    gre[tid] = (nr * lr + abi * li) / den;
    gim[tid] = (abi * lr - nr * li) / den;
    float* ab = (float*)(P.ws + WS_AB);
    ab[idx] = abr; ab[2 * NG * NP + idx] = abi;
  }
  __syncthreads();
  bf16_t* bbf = (bf16_t*)(P.ws + WS_BBF) + (size_t)(l * NG + g) * 8 * 64 * 8;
  const float* br = P.b_re + (size_t)(l * NG + g) * NP * NCH;
  const float* bi = P.b_im + (size_t)(l * NG + g) * NP * NCH;
  for (int j = 0; j < 16; ++j) {
    const int idx = tid * 16 + j, tile = idx >> 9, lane = (idx >> 3) & 63, e = idx & 7;
    const int pt = tile >> 1, part = tile & 1, p = pt * 16 + (lane & 15), q = lane >> 4, c = q * 8 + e;
    float v = 0.f;
    if (q < 2) { const float a = br[p * NCH + c], b = bi[p * NCH + c]; v = part == 0 ? gre[p] * a - gim[p] * b : gre[p] * b + gim[p] * a; }
    bbf[idx] = (bf16_t)(pk2(v, 0.f) & 0xffff);
  }
  bf16_t* ccf = (bf16_t*)(P.ws + WS_CCF) + (size_t)(l * NG + g) * 4 * 64 * 8;
  const float* cr = P.c_re + (size_t)(l * NG + g) * NCH * NP;
  const float* ci = P.c_im + (size_t)(l * NG + g) * NCH * NP;
  for (int j = 0; j < 8; ++j) {
    const int idx = tid * 8 + j, ks = idx >> 9, lane = (idx >> 3) & 63, e = idx & 7;
    const int c = lane & 15, q = lane >> 4, k = ks * 32 + q * 8 + e, p = k >> 1, part = k & 1;
    const float v = part == 0 ? cr[c * NP + p] : -ci[c * NP + p];
    ccf[idx] = (bf16_t)(pk2(v, 0.f) & 0xffff);
  }
  __syncthreads();
}

constexpr int TW_WIN = 2 * 32 * (NPAD / 64), TW_GLU = 2 * 32 * 32, TW_OUT = 2 * 64 * 32, TW_ALL = TW_WIN + TW_GLU + TW_OUT;
__device__ __forceinline__ void weight_tile_task(const Params& P, int r, float* tl) {
  if (r < TW_WIN) { const int per = 32 * (NPAD / 64), l = r / per; transpose_tile(P.w_in + (size_t)l * DM * INC, DM, INC, (bf16_t*)(P.ws + WS_WIN) + (size_t)l * NPAD * DM, P.norm_w + l * DM, P.norm_w + l * DM, r % per, tl); return; }
  r -= TW_WIN;
  if (r < TW_GLU) { const int per = 32 * 32, l = r / per; transpose_tile(P.glu_w + (size_t)l * 2048 * 2048, 2048, 2048, (bf16_t*)(P.ws + WS_WGLU) + (size_t)l * 2048 * 2048, nullptr, nullptr, r % per, tl); return; }
  r -= TW_GLU;
  { const int per = 64 * 32, l = r / per; transpose_tile(P.w_out + (size_t)l * 4096 * 2048, 4096, 2048, (bf16_t*)(P.ws + WS_WOUT) + (size_t)l * 2048 * 4096, P.s5_norm_w + l * 2048, P.ssd_norm_w + l * 2048, r % per, tl); }
}
__device__ __forceinline__ void deferred_weights(const Params& P, unsigned char* lds) {
  float* tl = (float*)(lds + 64);
  const int grid = gridDim.x, slots = grid >> 3, q = (blockIdx.x & 7) * slots + (blockIdx.x >> 3);
  const int leftover = (34 * 81) % grid;
  int rank = q, n = grid;
  if (leftover != 0) { if (q < leftover) return; rank = q - leftover; n = grid - leftover; }
  __syncthreads();
  for (int r = 32 * (NPAD / 64) + rank; r < TW_ALL; r += n) weight_tile_task(P, r, tl);
}

__device__ __forceinline__ void phase_prep(const Params& P, unsigned char* lds) {
  float* tl = (float*)(lds + 64);
  const int tid = opaque_tid(), lane = tid & 63, wave = tid >> 6;
  {
    float* ss = (float*)(P.ws + WS_SS);
    for (int i = blockIdx.x * 256 + tid; i < 8 * MT; i += gridDim.x * 256) ss[MT + i] = 0.f;
    if (blockIdx.x == 0 && tid < 64) ((int*)(P.ws + WS_CNT))[tid] = 0;
    if (blockIdx.x == 1) for (int i = tid; i < 2 * 3 * 34 * 16; i += 256) ((int*)(P.ws + WS_FLG))[i] = 0;
  }
  constexpr int T_W0 = 32 * (NPAD / 64), T_X = MT / 4, T_S5 = 2 * NG;
  constexpr int T_ALL = T_W0 + T_X + T_S5;
  for (int t = blockIdx.x; t < T_ALL; t += gridDim.x) {
    int r = t;
    if (r < T_W0) { weight_tile_task(P, r, tl); continue; }
    r -= T_W0;
    if (r < T_X) {
      const int row = r * 4 + wave;
      const float* src = row < MP ? P.x_prompt + (size_t)row * DM : P.x_sample + (size_t)(row - MP) * DM;
      bf16_t* dst = (bf16_t*)(P.ws + WS_XB) + (size_t)row * DM;
      float s = 0.f;
#pragma unroll
      for (int j = 0; j < 8; ++j) {
        const f32x4 v = *(const f32x4*)(src + (j * 64 + lane) * 4);
        s += v.x * v.x + v.y * v.y + v.z * v.z + v.w * v.w;
        u32x2 o; o.x = pk2(v.x, v.y); o.y = pk2(v.z, v.w);
        *(u32x2*)(dst + (j * 64 + lane) * 4) = o;
      }
      s = wave_sum(s);
      if (lane == 0) ((float*)(P.ws + WS_SS))[row] = s;
      continue;
    }
    r -= T_X;
    s5_precompute(P, r / NG, r % NG, tl);
  }
}

constexpr int G_IN = 0, G_GLU = 1, G_OUT = 2;

__device__ __forceinline__ bool gemm_unit_of(int v, int NT, int& pm, int& pn) {
  const int total = 34 * NT;
  if (v >= total) return false;
  const int ng = NT >> 3, rem = NT & 7;
  if (v < ng * 272) { const int pg = v / 272, w = v % 272; pm = w >> 3; pn = pg * 8 + (w & 7); }
  else { const int w = v - ng * 272; pm = w / rem; pn = ng * 8 + w % rem; }
  return true;
}

template <int MODE>
__device__ __forceinline__ void gemm_unit(const Params& P, int l, int pm, int pn, unsigned char* lds, int dummy) {
  constexpr int K = MODE == G_OUT ? 4096 : 2048;
  constexpr int NK = K / 32;
  const bf16_t* A = MODE == G_IN ? (const bf16_t*)(P.ws + WS_XB) : MODE == G_GLU ? (const bf16_t*)(P.ws + WS_G) : (const bf16_t*)(P.ws + WS_ACT);
  const bf16_t* Bt = MODE == G_IN ? (const bf16_t*)(P.ws + WS_WIN) + (size_t)l * NPAD * DM
                   : MODE == G_GLU ? (const bf16_t*)(P.ws + WS_WGLU) + (size_t)l * 2048 * 2048
                                   : (const bf16_t*)(P.ws + WS_WOUT) + (size_t)l * 2048 * 4096;
  const int tid = opaque_tid(), lane = tid & 63, wave = tid >> 6, wr = wave >> 1, wc = wave & 1, fr = lane & 15, fq = lane >> 4;
  unsigned char* base = lds + 64;
  const int grow = tid >> 2, gch = (tid & 3) ^ ((((tid >> 2) >> 3) & 1) << 1);
  const bf16_t* Ag = A + (size_t)(pm * 256 + grow) * K + gch * 8;
  const bf16_t* Bg = Bt + (size_t)(pn * 128 + grow) * K + gch * 8;
  const int swz = (fq ^ ((fr >> 3) << 1)) << 4;
  const int a_rd = (wr * 128 + fr) * 64 + swz;
  const int b_rd = 16384 + (wc * 64 + fr) * 64 + swz;

  f32x4 acc[8][4];
#pragma unroll
  for (int mi = 0; mi < 8; ++mi)
#pragma unroll
    for (int ni = 0; ni < 4; ++ni) acc[mi][ni] = (f32x4){0.f, 0.f, 0.f, 0.f};

  auto stage_tile = [&](int kt, unsigned char* st) __attribute__((always_inline)) {
#pragma unroll
    for (int i = 0; i < 4; ++i) __builtin_amdgcn_global_load_lds((const unsigned*)(Ag + (size_t)i * 64 * K + kt * 32), (unsigned*)(st + (tid + i * 256) * 16), 16, 0, 0);
#pragma unroll
    for (int i = 0; i < 2; ++i) __builtin_amdgcn_global_load_lds((const unsigned*)(Bg + (size_t)i * 64 * K + kt * 32), (unsigned*)(st + 16384 + (tid + i * 256) * 16), 16, 0, 0);
  };
  stage_tile(0, base);
  __syncthreads();

  for (int kt = 0; kt < NK; ++kt) {
    unsigned char* cur = base + (kt & 1) * 24576;
    unsigned char* nxt = base + ((kt & 1) ^ 1) * 24576;
    if (kt + 1 < NK) stage_tile(kt + 1, nxt);
    __builtin_amdgcn_sched_barrier(0);
    if (MODE == G_OUT && kt == NK / 2) {
      const float* ssa = (const float*)(P.ws + WS_SS) + (3 + l) * MT;
      const float* sss = (const float*)(P.ws + WS_SS) + (5 + l) * MT;
#pragma unroll
      for (int mi = 0; mi < 8; ++mi) {
        const int row = pm * 256 + wr * 128 + mi * 16 + fr;
        const float ra = rsqrtf(ssa[row] * (1.f / 2048.f) + EPS), rs = rsqrtf(sss[row] * (1.f / 2048.f) + EPS);
        const float ratio = ra / rs;
#pragma unroll
        for (int ni = 0; ni < 4; ++ni) acc[mi][ni] *= ratio;
      }
    }
    bf16x8 af[8], bfr[4];
#pragma unroll
    for (int mi = 0; mi < 8; ++mi) af[mi] = *(const bf16x8*)(cur + a_rd + mi * 1024);
#pragma unroll
    for (int ni = 0; ni < 4; ++ni) bfr[ni] = *(const bf16x8*)(cur + b_rd + ni * 1024);
    __builtin_amdgcn_s_setprio(1);
#pragma unroll
    for (int mi = 0; mi < 8; ++mi)
#pragma unroll
      for (int ni = 0; ni < 4; ++ni) acc[mi][ni] = MFMA16(bfr[ni], af[mi], acc[mi][ni]);
    __builtin_amdgcn_s_setprio(0);
    __syncthreads();
  }

  const int row0 = pm * 256 + wr * 128 + fr, col0 = pn * 128 + wc * 64 + fq * 4;
  if (MODE == G_IN) {
    const float* ssx = (const float*)(P.ws + WS_SS) + l * MT;
    bf16_t* proj = (bf16_t*)(P.ws + WS_PROJ);
    float* dtv = (float*)(P.ws + WS_DTV);
    const bool wt = dummy == 4 && pn >= 32 && pn < 64;
#pragma unroll
    for (int mi = 0; mi < 8; ++mi) {
      const int row = row0 + mi * 16;
      const float rs = rsqrtf(ssx[row] * (1.f / 2048.f) + EPS);
#pragma unroll
      for (int ni = 0; ni < 4; ++ni) {
        const f32x4 v = acc[mi][ni] * rs;
        const int col = col0 + ni * 16;
        if (pn < 80) {
          u32x2 o; o.x = pk2(v.x, v.y); o.y = pk2(v.z, v.w);
          if (wt) st_wt8(proj + (size_t)row * NPROJ + col, o); else *(u32x2*)(proj + (size_t)row * NPROJ + col) = o;
        } else if (col < NPROJ + 32) {
          const f32x4 bb = *(const f32x4*)(P.dt_bias + l * NH + (col - NPROJ));
          f32x4 x = v + bb, o;
          o.x = fmaxf(x.x, 0.f) + log1pf(__expf(-fabsf(x.x))); o.y = fmaxf(x.y, 0.f) + log1pf(__expf(-fabsf(x.y)));
          o.z = fmaxf(x.z, 0.f) + log1pf(__expf(-fabsf(x.z))); o.w = fmaxf(x.w, 0.f) + log1pf(__expf(-fabsf(x.w)));
          *(f32x4*)(dtv + (size_t)row * 32 + (col - NPROJ)) = o;
        }
      }
    }
  } else if (MODE == G_GLU) {
    const bf16_t* gbuf = (const bf16_t*)(P.ws + WS_G);
    const bf16_t* proj = (const bf16_t*)(P.ws + WS_PROJ);
    bf16_t* act = (bf16_t*)(P.ws + WS_ACT);
    float* ssa = (float*)(P.ws + WS_SS) + (dummy ? 7 : 3 + l) * MT;
    const float* gb_ = P.glu_b + l * 2048;
#pragma unroll
    for (int mi = 0; mi < 8; ++mi) {
      const int row = row0 + mi * 16;
      float ss = 0.f;
#pragma unroll
      for (int ni = 0; ni < 4; ++ni) {
        const int col = col0 + ni * 16;
        const f32x4 bv = *(const f32x4*)(gb_ + col);
        const u32x2 gw = *(const u32x2*)(gbuf + (size_t)row * 2048 + col);
        const u32x2 zw = *(const u32x2*)(proj + (size_t)row * NPROJ + 2048 + col);
        const f32x4 a = acc[mi][ni] + bv;
        const float v0 = bflo(gw.x) * sigmoidf_(a.x) * siluf_(bflo(zw.x));
        const float v1 = bfhi(gw.x) * sigmoidf_(a.y) * siluf_(bfhi(zw.x));
        const float v2 = bflo(gw.y) * sigmoidf_(a.z) * siluf_(bflo(zw.y));
        const float v3 = bfhi(gw.y) * sigmoidf_(a.w) * siluf_(bfhi(zw.y));
        ss += v0 * v0 + v1 * v1 + v2 * v2 + v3 * v3;
        u32x2 o; o.x = pk2(v0, v1); o.y = pk2(v2, v3);
        st_wt8(act + (size_t)row * 4096 + col, o);
      }
      ss += __shfl_xor(ss, 16); ss += __shfl_xor(ss, 32);
      if (fq == 0) atomicAdd(ssa + row, ss);
    }
  } else {
    const float* sss = (const float*)(P.ws + WS_SS) + (5 + l) * MT;
    float* ssx = (float*)(P.ws + WS_SS) + (l + 1) * MT;
    float* xres = (float*)(P.ws + WS_XRES);
    bf16_t* xb = (bf16_t*)(P.ws + WS_XB);
#pragma unroll
    for (int mi = 0; mi < 8; ++mi) {
      const int row = row0 + mi * 16;
      const float rs = rsqrtf(sss[row] * (1.f / 2048.f) + EPS);
      const float* xold = l == 0 ? (row < MP ? P.x_prompt + (size_t)row * DM : P.x_sample + (size_t)(row - MP) * DM) : xres + (size_t)row * DM;
      float ss = 0.f;
#pragma unroll
      for (int ni = 0; ni < 4; ++ni) {
        const int col = col0 + ni * 16;
        const f32x4 xo = *(const f32x4*)(xold + col);
        const f32x4 v = xo + acc[mi][ni] * rs;
        ss += v.x * v.x + v.y * v.y + v.z * v.z + v.w * v.w;
        st_wt8(xres + (size_t)row * DM + col, (u32x2){__float_as_uint(v.x), __float_as_uint(v.y)});
        st_wt8(xres + (size_t)row * DM + col + 2, (u32x2){__float_as_uint(v.z), __float_as_uint(v.w)});
        u32x2 o; o.x = pk2(v.x, v.y); o.y = pk2(v.z, v.w);
        st_wt8(xb + (size_t)row * DM + col, o);
      }
      ss += __shfl_xor(ss, 16); ss += __shfl_xor(ss, 32);
      if (fq == 0) atomicAdd(ssx + row, ss);
    }
  }
}

template <int MODE>
__device__ __forceinline__ void phase_gemm(const Params& P, int l, unsigned char* lds, int dummy = 0) {
  constexpr int NT = MODE == G_IN ? 81 : 16;
  const int slots = gridDim.x >> 3, xcd = blockIdx.x & 7, slot = blockIdx.x >> 3;
  for (int i = 0;; ++i) {
    const int v = (i * 8 + xcd) * slots + slot;
    int pm, pn;
    if (!gemm_unit_of(v, NT, pm, pn)) break;
    gemm_unit<MODE>(P, l, pm, pn, lds, dummy);
  }
}


__device__ __forceinline__ int* panel_flag(const Params& P, int l, int kind, int pm) { return (int*)(P.ws + WS_FLG) + ((l * 3 + kind) * 34 + pm) * 16; }
__device__ __forceinline__ void panel_wait(int* flag, int need) {
  if (threadIdx.x == 0) { while (__hip_atomic_load(flag, __ATOMIC_RELAXED, __HIP_MEMORY_SCOPE_AGENT) < need) __builtin_amdgcn_s_sleep(4); }
  __syncthreads();
  asm volatile("" ::: "memory");
}
__device__ __forceinline__ void panel_signal(int* flag) {
  asm volatile("s_waitcnt vmcnt(0)" ::: "memory");
  __syncthreads();
  if (threadIdx.x == 0) __hip_atomic_fetch_add(flag, 1, __ATOMIC_RELAXED, __HIP_MEMORY_SCOPE_AGENT);
}
__device__ __forceinline__ void phase_chain(const Params& P, int l, unsigned char* lds) {
  const int nGLU = 34 * 16, nOUT = 34 * 16, nIN = l == 0 ? 34 * 81 : 0, total = nGLU + nOUT + nIN;
  const int slots = gridDim.x >> 3, xcd = blockIdx.x & 7, slot = blockIdx.x >> 3;
  for (int i = 0;; ++i) {
    const int v = (i * 8 + xcd) * slots + slot;
    if (v >= total) break;
    int pm, pn;
    if (v < nGLU) {
      gemm_unit_of(v, 16, pm, pn);
      gemm_unit<G_GLU>(P, l, pm, pn, lds, 0);
      panel_signal(panel_flag(P, l, 0, pm));
    } else if (v < nGLU + nOUT) {
      gemm_unit_of(v - nGLU, 16, pm, pn);
      panel_wait(panel_flag(P, l, 0, pm), 16);
      gemm_unit<G_OUT>(P, l, pm, pn, lds, 0);
      panel_signal(panel_flag(P, l, 1, pm));
    } else {
      gemm_unit_of(v - nGLU - nOUT, 81, pm, pn);
      panel_wait(panel_flag(P, l, 1, pm), 16);
      gemm_unit<G_IN>(P, l + 1, pm, pn, lds, 4);
      if (pn >= 32 && pn < 64) panel_signal(panel_flag(P, l, 2, pm));
    }
  }
}

__device__ __forceinline__ void conv8(const u32x4* r, int i, const f32x4* w, const f32x4* bias, float* o) {
#pragma unroll
  for (int hf = 0; hf < 2; ++hf) {
    f32x4 a = bias[hf];
#pragma unroll
    for (int k = 0; k < 4; ++k) {
      const u32x4 rv = r[i + k];
      const unsigned w0 = hf == 0 ? rv.x : rv.z, w1 = hf == 0 ? rv.y : rv.w;
      const f32x4 wk = w[k * 2 + hf];
      a.x = fmaf(wk.x, bflo(w0), a.x); a.y = fmaf(wk.y, bfhi(w0), a.y);
      a.z = fmaf(wk.z, bflo(w1), a.z); a.w = fmaf(wk.w, bfhi(w1), a.w);
    }
    o[hf * 4 + 0] = siluf_(a.x); o[hf * 4 + 1] = siluf_(a.y); o[hf * 4 + 2] = siluf_(a.z); o[hf * 4 + 3] = siluf_(a.w);
  }
}
__device__ __forceinline__ void store8f(float* dst, u32x4 v) {
  *(f32x4*)dst = (f32x4){bflo(v.x), bfhi(v.x), bflo(v.y), bfhi(v.y)};
  *(f32x4*)(dst + 4) = (f32x4){bflo(v.z), bfhi(v.z), bflo(v.w), bfhi(v.w)};
}

__device__ __forceinline__ void phase_conv(const Params& P, int l, int gated) {
  const int tid = opaque_tid();
  const int gsz = gridDim.x * 256, gid = blockIdx.x * 256 + tid;
  const bf16_t* proj = (const bf16_t*)(P.ws + WS_PROJ);
  bf16_t* xc = (bf16_t*)(P.ws + WS_XC);
  const float* cw = P.conv_w + (size_t)l * 4 * CONVD;
  const float* cb = P.conv_b + (size_t)l * CONVD;
#pragma unroll 1
  for (int it = gid; it < (MP / 8) * 512; it += gsz) {
    const int ch0 = (it & 511) * 8, row0 = (it >> 9) * 8, t0 = row0 & (SEQ - 1);
    if (gated) {
      panel_wait(panel_flag(P, 0, 2, row0 >> 8), 32);
      if (t0 > 0 && (row0 & 255) == 0) panel_wait(panel_flag(P, 0, 2, (row0 >> 8) - 1), 32);
    }
    u32x4 r[11];
#pragma unroll
    for (int j = 0; j < 11; ++j) {
      r[j] = (u32x4){0u, 0u, 0u, 0u};
      if (t0 - 3 + j >= 0) r[j] = *(const u32x4*)(proj + (size_t)(row0 - 3 + j) * NPROJ + 4096 + ch0);
    }
    f32x4 w[8], bias[2];
#pragma unroll
    for (int k = 0; k < 4; ++k) { w[k * 2] = *(const f32x4*)(cw + k * CONVD + ch0); w[k * 2 + 1] = *(const f32x4*)(cw + k * CONVD + ch0 + 4); }
    bias[0] = *(const f32x4*)(cb + ch0); bias[1] = *(const f32x4*)(cb + ch0 + 4);
#pragma unroll
    for (int i = 0; i < 8; ++i) {
      float o[8]; conv8(r, i, w, bias, o);
      u32x4 q; q.x = pk2(o[0], o[1]); q.y = pk2(o[2], o[3]); q.z = pk2(o[4], o[5]); q.w = pk2(o[6], o[7]);
      *(u32x4*)(xc + (size_t)(row0 + i) * CONVD + ch0) = q;
    }
    if (t0 == SEQ - 8) {
      const int bb = row0 >> 11;
#pragma unroll
      for (int j = 0; j < 3; ++j) store8f(P.out + O_CONVP + ((size_t)(l * NB + bb) * 3 + j) * CONVD + ch0, r[8 + j]);
    }
  }
#pragma unroll 1
  for (int it = gid; it < DB * 512; it += gsz) {
    const int ch0 = (it & 511) * 8, bb = it >> 9, row0 = MP + bb * 4;
    if (gated) panel_wait(panel_flag(P, 0, 2, row0 >> 8), 32);
    u32x4 r[7];
#pragma unroll
    for (int j = 0; j < 3; ++j) {
      const float* cp = P.cache_conv + ((size_t)(l * DB + bb) * 3 + j) * CONVD + ch0;
      const f32x4 c0 = *(const f32x4*)cp, c1 = *(const f32x4*)(cp + 4);
      r[j].x = pk2(c0.x, c0.y); r[j].y = pk2(c0.z, c0.w); r[j].z = pk2(c1.x, c1.y); r[j].w = pk2(c1.z, c1.w);
    }
#pragma unroll
    for (int j = 0; j < 4; ++j) r[3 + j] = *(const u32x4*)(proj + (size_t)(row0 + j) * NPROJ + 4096 + ch0);
    f32x4 w[8], bias[2];
#pragma unroll
    for (int k = 0; k < 4; ++k) { w[k * 2] = *(const f32x4*)(cw + k * CONVD + ch0); w[k * 2 + 1] = *(const f32x4*)(cw + k * CONVD + ch0 + 4); }
    bias[0] = *(const f32x4*)(cb + ch0); bias[1] = *(const f32x4*)(cb + ch0 + 4);
#pragma unroll
    for (int i = 0; i < 4; ++i) {
      float o[8]; conv8(r, i, w, bias, o);
      u32x4 q; q.x = pk2(o[0], o[1]); q.y = pk2(o[2], o[3]); q.z = pk2(o[4], o[5]); q.w = pk2(o[6], o[7]);
      *(u32x4*)(xc + (size_t)(row0 + i) * CONVD + ch0) = q;
    }
#pragma unroll
    for (int j = 0; j < 3; ++j) store8f(P.out + O_CONVS + ((size_t)(l * DB + bb) * 3 + j) * CONVD + ch0, r[4 + j]);
  }
}

template <int MODE>
__device__ __forceinline__ void s5_wave(const Params& P, int l, int g, int rowbase, int nchunks, unsigned char* wl, float& hr, float& hi,
                                        const bf16x8 (&bbf)[8], const bf16x8 (&ccf)[4], float ar, float ai) {
  const int lane = opaque_tid() & 63, fr = lane & 15, fq = lane >> 4;
  unsigned char* bu = wl; unsigned char* Hb = wl + 8192;
  const bf16_t* proj = (const bf16_t*)(P.ws + WS_PROJ);
  bf16_t* gbuf = (bf16_t*)(P.ws + WS_G);
  f32x4 dv = {0.f, 0.f, 0.f, 0.f};
  if (MODE != 0) dv = *(const f32x4*)(P.s5_d + l * WA + g * NCH + fq * 4);
  const bf16x8 zero8 = {0, 0, 0, 0, 0, 0, 0, 0};
  bf16x8 uf = zero8;
  if (fq < 2) uf = *(const bf16x8*)(proj + (size_t)(rowbase + fr) * NPROJ + g * NCH + fq * 8);
#pragma unroll 1
  for (int c = 0; c < nchunks; ++c) {
    const int row0 = rowbase + c * 16;
    f32x4 t[8];
#pragma unroll
    for (int i = 0; i < 8; ++i) t[i] = MFMA16(uf, bbf[i], ((f32x4){0.f, 0.f, 0.f, 0.f}));
    u32x2 uw = {0u, 0u};
    if (MODE != 0) uw = *(const u32x2*)(proj + (size_t)(row0 + fr) * NPROJ + g * NCH + fq * 4);
    if (c + 1 < nchunks) { if (fq < 2) uf = *(const bf16x8*)(proj + (size_t)(row0 + 16 + fr) * NPROJ + g * NCH + fq * 8); }
#pragma unroll
    for (int pt = 0; pt < 4; ++pt)
#pragma unroll
      for (int r = 0; r < 4; ++r) {
        f32x2 v; v.x = t[2 * pt][r]; v.y = t[2 * pt + 1][r];
        *(f32x2*)(bu + (fq * 4 + r) * 512 + (pt * 16 + fr) * 8) = v;
      }
    LDS_FENCE();
#pragma unroll
    for (int tt = 0; tt < 16; ++tt) {
      if (MODE == 2 && (tt & 3) == 0) {
        const int b = ((row0 - MP) >> 2) + (tt >> 2);
        hr = P.st_s5_re[((size_t)(l * DB + b) * NG + g) * NP + lane];
        hi = P.st_s5_im[((size_t)(l * DB + b) * NG + g) * NP + lane];
      }
      const f32x2 bv = *(const f32x2*)(bu + tt * 512 + lane * 8);
      const float nr = fmaf(ar, hr, fmaf(-ai, hi, bv.x));
      const float ni = fmaf(ar, hi, fmaf(ai, hr, bv.y));
      hr = nr; hi = ni;
      if (MODE != 0) *(unsigned*)(Hb + tt * 272 + lane * 4) = pk2(hr, hi);
      if (MODE == 2 && (tt & 3) == 3) {
        const int b = ((row0 - MP) >> 2) + (tt >> 2);
        P.out[O_S5RS + ((size_t)(l * DB + b) * NG + g) * NP + lane] = hr;
        P.out[O_S5IS + ((size_t)(l * DB + b) * NG + g) * NP + lane] = hi;
      }
    }
    LDS_FENCE();
    if (MODE != 0) {
      f32x4 y = {0.f, 0.f, 0.f, 0.f};
#pragma unroll
      for (int ks = 0; ks < 4; ++ks) {
        const bf16x8 hf = *(const bf16x8*)(Hb + fr * 272 + ks * 64 + fq * 16);
        y = MFMA16(ccf[ks], hf, y);
      }
      LDS_FENCE();
      const float y0 = gelu_tanh(y.x + dv.x * bflo(uw.x)), y1 = gelu_tanh(y.y + dv.y * bfhi(uw.x));
      const float y2 = gelu_tanh(y.z + dv.z * bflo(uw.y)), y3 = gelu_tanh(y.w + dv.w * bfhi(uw.y));
      u32x2 o; o.x = pk2(y0, y1); o.y = pk2(y2, y3);
      *(u32x2*)(gbuf + (size_t)(row0 + fr) * 2048 + g * NCH + fq * 4) = o;
    }
  }
}

constexpr int L_S5X = 64 + 4 * 12544;
template <bool SAMPLE>
__device__ __forceinline__ void s5_block_task(const Params& P, int l, int g, int b, unsigned char* lds) {
  const int tid = opaque_tid(), lane = tid & 63, wave = tid >> 6;
  const bf16x8* bbp = (const bf16x8*)((const bf16_t*)(P.ws + WS_BBF) + (size_t)(l * NG + g) * 8 * 64 * 8);
  const bf16x8* ccp = (const bf16x8*)((const bf16_t*)(P.ws + WS_CCF) + (size_t)(l * NG + g) * 4 * 64 * 8);
  bf16x8 bbf[8], ccf[4];
#pragma unroll
  for (int i = 0; i < 8; ++i) bbf[i] = bbp[i * 64 + lane];
#pragma unroll
  for (int i = 0; i < 4; ++i) ccf[i] = ccp[i * 64 + lane];
  const float* ab = (const float*)(P.ws + WS_AB);
  const float ar = ab[(l * NG + g) * NP + lane], ai = ab[2 * NG * NP + (l * NG + g) * NP + lane];
  unsigned char* wl = lds + 64 + wave * 12544;
  float hr = 0.f, hi = 0.f;
  if (SAMPLE) {
    s5_wave<2>(P, l, g, MP + wave * 128, 8, wl, hr, hi, bbf, ccf, ar, ai);
  } else {
    const int rowbase = b * SEQ + (wave < 3 ? wave * 448 : 1344), nch = wave < 3 ? 28 : 44;
    if (wave < 3) s5_wave<0>(P, l, g, rowbase, 28, wl, hr, hi, bbf, ccf, ar, ai);
    f32x2* xch = (f32x2*)(lds + L_S5X);
    xch[wave * 64 + lane] = (f32x2){hr, hi};
    float pr = ar, pi = ai;
#pragma unroll
    for (int i = 0; i < 6; ++i) { const float nr = pr * pr - pi * pi, ni = 2.f * pr * pi; pr = nr; pi = ni; }
    const float q64r = pr, q64i = pi;
    { const float nr = pr * pr - pi * pi, ni = 2.f * pr * pi; pr = nr; pi = ni; }
    const float q128r = pr, q128i = pi;
    { const float nr = pr * pr - pi * pi, ni = 2.f * pr * pi; pr = nr; pi = ni; }
    { const float tr = pr * q128r - pi * q128i, ti = pr * q128i + pi * q128r; pr = tr * q64r - ti * q64i; pi = tr * q64i + ti * q64r; }
    __syncthreads();
    hr = 0.f; hi = 0.f;
    for (int j = 0; j < wave; ++j) {
      const f32x2 e = xch[j * 64 + lane];
      const float nr = fmaf(pr, hr, fmaf(-pi, hi, e.x)), ni = fmaf(pr, hi, fmaf(pi, hr, e.y));
      hr = nr; hi = ni;
    }
    s5_wave<1>(P, l, g, rowbase, nch, wl, hr, hi, bbf, ccf, ar, ai);
    if (wave == 3) {
      P.out[O_S5RP + ((size_t)(l * NB + b) * NG + g) * NP + lane] = hr;
      P.out[O_S5IP + ((size_t)(l * NB + b) * NG + g) * NP + lane] = hi;
    }
  }
}

constexpr int L_CN = 64, L_BN = L_CN + 17408, L_BT = L_BN + 17408, L_XT = L_BT + 18432, L_MM = L_XT + 9216, L_DT = L_MM + 9216, L_CS = L_DT + 256;

__device__ __forceinline__ void ssd_prompt_task(const Params& P, int l, int b, int h, unsigned char* lds, int dummy, int c1, int cfull) {
  const int tid = opaque_tid(), lane = tid & 63, wave = tid >> 6, fr = lane & 15, fq = lane >> 4;
  const int gi = h >> 2, pw = wave * 16;
  const bf16_t* proj = (const bf16_t*)(P.ws + WS_PROJ);
  const bf16_t* xc = (const bf16_t*)(P.ws + WS_XC);
  const float* dtvb = (const float*)(P.ws + WS_DTV);
  bf16_t* act = (bf16_t*)(P.ws + WS_ACT);
  float* sss = (float*)(P.ws + WS_SS) + (dummy ? 8 : 5 + l) * MT;
  const float a_h = -expf(P.a_log[l * NH + h]), dsk = P.ssd_d[l * NH + h];
  f32x4 S[8];
#pragma unroll
  for (int i = 0; i < 8; ++i) S[i] = (f32x4){0.f, 0.f, 0.f, 0.f};
  const int crow = tid >> 4, cch = tid & 15;
  u32x4 pc[4], pb[4], px[2]; float pdt;
  {
    const bf16_t* base = xc + (size_t)(b * SEQ) * CONVD;
#pragma unroll
    for (int i = 0; i < 4; ++i) { pc[i] = (u32x4){0u, 0u, 0u, 0u}; if (cfull == 0) pc[i] = *(const u32x4*)(base + (size_t)(i * 16 + crow) * CONVD + 3072 + gi * 128 + cch * 8); }
#pragma unroll
    for (int i = 0; i < 2; ++i) {
      pb[i * 2] = *(const u32x4*)(base + (size_t)((i * 16 + crow) * 2) * CONVD + 2048 + gi * 128 + cch * 8);
      pb[i * 2 + 1] = *(const u32x4*)(base + (size_t)((i * 16 + crow) * 2 + 1) * CONVD + 2048 + gi * 128 + cch * 8);
    }
    px[0] = *(const u32x4*)(base + (size_t)((tid >> 3) * 2) * CONVD + h * 64 + (tid & 7) * 8);
    px[1] = *(const u32x4*)(base + (size_t)((tid >> 3) * 2 + 1) * CONVD + h * 64 + (tid & 7) * 8);
    pdt = dtvb[(size_t)(b * SEQ + lane) * 32 + h];
  }
#pragma unroll 1
  for (int c = 0; c < c1; ++c) {
    const int rowc = b * SEQ + c * 64;
    const bool full = c >= cfull;
    float* DTs = (float*)(lds + L_DT + (c & 1) * 512); float* CSs = DTs + 64;
    {
      float cs = pdt * a_h;
#pragma unroll
      for (int o = 1; o < 64; o <<= 1) { const float v = __shfl_up(cs, o); if (lane >= o) cs += v; }
      if (wave == 0) { DTs[lane] = pdt; CSs[lane] = cs; }
    }
    __syncthreads();
    const float cs_end = CSs[63];
    {
      if (full) {
#pragma unroll
        for (int i = 0; i < 4; ++i) *(u32x4*)(lds + L_CN + (i * 16 + crow) * 272 + cch * 16) = pc[i];
      }
#pragma unroll
      for (int i = 0; i < 2; ++i) {
        const int t0 = (i * 16 + crow) * 2;
        const u32x4 v0 = pb[i * 2], v1 = pb[i * 2 + 1];
        if (full) {
          *(u32x4*)(lds + L_BN + t0 * 272 + cch * 16) = v0;
          *(u32x4*)(lds + L_BN + (t0 + 1) * 272 + cch * 16) = v1;
        }
        const float d0 = __expf(cs_end - CSs[t0]) * DTs[t0], d1 = __expf(cs_end - CSs[t0 + 1]) * DTs[t0 + 1];
        unsigned char* bt = lds + L_BT + (cch * 8) * 144 + t0 * 2;
        *(unsigned*)(bt + 0 * 144) = pk2(bflo(v0.x) * d0, bflo(v1.x) * d1);
        *(unsigned*)(bt + 1 * 144) = pk2(bfhi(v0.x) * d0, bfhi(v1.x) * d1);
        *(unsigned*)(bt + 2 * 144) = pk2(bflo(v0.y) * d0, bflo(v1.y) * d1);
        *(unsigned*)(bt + 3 * 144) = pk2(bfhi(v0.y) * d0, bfhi(v1.y) * d1);
        *(unsigned*)(bt + 4 * 144) = pk2(bflo(v0.z) * d0, bflo(v1.z) * d1);
        *(unsigned*)(bt + 5 * 144) = pk2(bfhi(v0.z) * d0, bfhi(v1.z) * d1);
        *(unsigned*)(bt + 6 * 144) = pk2(bflo(v0.w) * d0, bflo(v1.w) * d1);
        *(unsigned*)(bt + 7 * 144) = pk2(bfhi(v0.w) * d0, bfhi(v1.w) * d1);
      }
      {
        const u32x4 v0 = px[0], v1 = px[1];
        unsigned char* xt = lds + L_XT + ((tid & 7) * 8) * 144 + (tid >> 3) * 4;
        *(unsigned*)(xt + 0 * 144) = (v0.x & 0xffffu) | (v1.x << 16);
        *(unsigned*)(xt + 1 * 144) = (v0.x >> 16) | (v1.x & 0xffff0000u);
        *(unsigned*)(xt + 2 * 144) = (v0.y & 0xffffu) | (v1.y << 16);
        *(unsigned*)(xt + 3 * 144) = (v0.y >> 16) | (v1.y & 0xffff0000u);
        *(unsigned*)(xt + 4 * 144) = (v0.z & 0xffffu) | (v1.z << 16);
        *(unsigned*)(xt + 5 * 144) = (v0.z >> 16) | (v1.z & 0xffff0000u);
        *(unsigned*)(xt + 6 * 144) = (v0.w & 0xffffu) | (v1.w << 16);
        *(unsigned*)(xt + 7 * 144) = (v0.w >> 16) | (v1.w & 0xffff0000u);
      }
    }
    if (c + 1 < c1) {
      const bf16_t* base = xc + (size_t)(rowc + 64) * CONVD;
      if (c + 1 >= cfull) {
#pragma unroll
        for (int i = 0; i < 4; ++i) pc[i] = *(const u32x4*)(base + (size_t)(i * 16 + crow) * CONVD + 3072 + gi * 128 + cch * 8);
      }
#pragma unroll
      for (int i = 0; i < 2; ++i) {
        pb[i * 2] = *(const u32x4*)(base + (size_t)((i * 16 + crow) * 2) * CONVD + 2048 + gi * 128 + cch * 8);
        pb[i * 2 + 1] = *(const u32x4*)(base + (size_t)((i * 16 + crow) * 2 + 1) * CONVD + 2048 + gi * 128 + cch * 8);
      }
      px[0] = *(const u32x4*)(base + (size_t)((tid >> 3) * 2) * CONVD + h * 64 + (tid & 7) * 8);
      px[1] = *(const u32x4*)(base + (size_t)((tid >> 3) * 2 + 1) * CONVD + h * 64 + (tid & 7) * 8);
      pdt = dtvb[(size_t)(rowc + 64 + lane) * 32 + h];
    }
    __syncthreads();
    u32x2 zwv[4];
#pragma unroll
    for (int tt = 0; tt < 4; ++tt) { zwv[tt] = (u32x2){0u, 0u}; if (full) zwv[tt] = *(const u32x2*)(proj + (size_t)(rowc + tt * 16 + fr) * NPROJ + 8192 + h * 64 + pw + fq * 4); }
    if (full) {
      bf16x8 cf[4];
#pragma unroll
      for (int ks = 0; ks < 4; ++ks) cf[ks] = *(const bf16x8*)(lds + L_CN + (wave * 16 + fr) * 272 + ks * 64 + fq * 16);
      const int tcol = wave * 16 + fr; const float cst = CSs[tcol];
#pragma unroll
      for (int st = 0; st < 4; ++st) {
        f32x4 g = {0.f, 0.f, 0.f, 0.f};
#pragma unroll
        for (int ks = 0; ks < 4; ++ks) {
          const bf16x8 bf = *(const bf16x8*)(lds + L_BN + (st * 16 + fr) * 272 + ks * 64 + fq * 16);
          g = MFMA16(bf, cf[ks], g);
        }
        float m[4];
#pragma unroll
        for (int r = 0; r < 4; ++r) {
          const int s_ = st * 16 + fq * 4 + r;
          m[r] = s_ <= tcol ? g[r] * __expf(cst - CSs[s_]) * DTs[s_] : 0.f;
        }
        u32x2 o; o.x = pk2(m[0], m[1]); o.y = pk2(m[2], m[3]);
        *(u32x2*)(lds + L_MM + tcol * 144 + (st * 16 + fq * 4) * 2) = o;
      }
    }
    __syncthreads();
    {
      bf16x8 sf[4];
#pragma unroll
      for (int ks = 0; ks < 4; ++ks) {
        u32x4 v; v.x = pk2(S[2 * ks].x, S[2 * ks].y); v.y = pk2(S[2 * ks].z, S[2 * ks].w); v.z = pk2(S[2 * ks + 1].x, S[2 * ks + 1].y); v.w = pk2(S[2 * ks + 1].z, S[2 * ks + 1].w);
        sf[ks] = __builtin_bit_cast(bf16x8, v);
      }
      bf16x8 xf[2];
#pragma unroll
      for (int k2 = 0; k2 < 2; ++k2) xf[k2] = *(const bf16x8*)(lds + L_XT + (pw + fr) * 144 + k2 * 64 + fq * 16);
      if (full) {
#pragma unroll
      for (int tt = 0; tt < 4; ++tt) {
        const int t = tt * 16 + fr;
        f32x4 y = {0.f, 0.f, 0.f, 0.f};
#pragma unroll
        for (int ks = 0; ks < 4; ++ks) {
          const u32x2 c0 = *(const u32x2*)(lds + L_CN + t * 272 + ((2 * ks) * 16 + fq * 4) * 2);
          const u32x2 c1 = *(const u32x2*)(lds + L_CN + t * 272 + ((2 * ks + 1) * 16 + fq * 4) * 2);
          u32x4 cv; cv.x = c0.x; cv.y = c0.y; cv.z = c1.x; cv.w = c1.y;
          y = MFMA16(sf[ks], __builtin_bit_cast(bf16x8, cv), y);
        }
        y *= __expf(CSs[t]);
#pragma unroll
        for (int k2 = 0; k2 < 2; ++k2) {
          const bf16x8 mf = *(const bf16x8*)(lds + L_MM + t * 144 + k2 * 64 + fq * 16);
          y = MFMA16(xf[k2], mf, y);
        }
        const int row = rowc + t, pc_ = pw + fq * 4;
        const u32x2 zw = zwv[tt];
        const float x0 = bf1(*(const bf16_t*)(lds + L_XT + (pc_ + 0) * 144 + t * 2)), x1 = bf1(*(const bf16_t*)(lds + L_XT + (pc_ + 1) * 144 + t * 2));
        const float x2 = bf1(*(const bf16_t*)(lds + L_XT + (pc_ + 2) * 144 + t * 2)), x3 = bf1(*(const bf16_t*)(lds + L_XT + (pc_ + 3) * 144 + t * 2));
        const float v0 = (y.x + dsk * x0) * siluf_(bflo(zw.x)), v1 = (y.y + dsk * x1) * siluf_(bfhi(zw.x));
        const float v2 = (y.z + dsk * x2) * siluf_(bflo(zw.y)), v3 = (y.w + dsk * x3) * siluf_(bfhi(zw.y));
        u32x2 o; o.x = pk2(v0, v1); o.y = pk2(v2, v3);
        *(u32x2*)(act + (size_t)row * 4096 + 2048 + h * 64 + pc_) = o;
        float ss = v0 * v0 + v1 * v1 + v2 * v2 + v3 * v3;
        ss += __shfl_xor(ss, 16); ss += __shfl_xor(ss, 32);
        if (fq == 0) atomicAdd(sss + row, ss);
      }
      }
      const float dec = __expf(cs_end);
#pragma unroll
      for (int nt = 0; nt < 8; ++nt) {
        S[nt] *= dec;
#pragma unroll
        for (int k2 = 0; k2 < 2; ++k2) {
          const bf16x8 bt = *(const bf16x8*)(lds + L_BT + (nt * 16 + fr) * 144 + k2 * 64 + fq * 16);
          S[nt] = MFMA16(bt, xf[k2], S[nt]);
        }
      }
    }
  }
  if (c1 == SEQ / 64) {
    float* so = P.out + O_SSDP + ((size_t)(l * NB + b) * NH + h) * HD * SN;
#pragma unroll
    for (int nt = 0; nt < 8; ++nt) *(f32x4*)(so + (size_t)(pw + fr) * SN + nt * 16 + fq * 4) = S[nt];
  }
}

struct SampLd { f32x4 st[8]; u32x4 xcv; float dtv; float zt[4]; };
__device__ __forceinline__ void ssd_sample_load(const Params& P, int l, int task, int tid, SampLd& L) {
  const int b = task >> 5, h = task & 31, gi = h >> 2, row0 = MP + b * 4;
  const float* sin_ = P.st_ssd + ((size_t)(l * DB + b) * NH + h) * HD * SN;
#pragma unroll
  for (int j = 0; j < 8; ++j) L.st[j] = *(const f32x4*)(sin_ + (j * 256 + tid) * 4);
  L.xcv = (u32x4){0u, 0u, 0u, 0u}; L.dtv = 0.f;
  if (tid < 160) {
    const int t = tid / 40, q = tid % 40;
    const int ch = q < 8 ? h * 64 + q * 8 : q < 24 ? 2048 + gi * 128 + (q - 8) * 8 : 3072 + gi * 128 + (q - 24) * 8;
    L.xcv = *(const u32x4*)((const bf16_t*)(P.ws + WS_XC) + (size_t)(row0 + t) * CONVD + ch);
  }
  if (tid >= 192 && tid < 196) L.dtv = ((const float*)(P.ws + WS_DTV))[(size_t)(row0 + tid - 192) * 32 + h];
  const int p = tid >> 2;
#pragma unroll
  for (int t = 0; t < 4; ++t) L.zt[t] = bf1(((const bf16_t*)(P.ws + WS_PROJ))[(size_t)(row0 + t) * NPROJ + 8192 + h * 64 + p]);
}

__device__ __forceinline__ void ssd_sample_batch(const Params& P, int l, int batch, unsigned char* lds, int dummy) {
  const int tid = opaque_tid(), lane = tid & 63;
  bf16_t* act = (bf16_t*)(P.ws + WS_ACT);
  float* sss = (float*)(P.ws + WS_SS) + (dummy ? 8 : 5 + l) * MT;
  float* xs = (float*)(lds + 64);
  float* Bs = xs + 256;
  float* Cs = Bs + 512;
  float* dts = Cs + 512;
  float* St0 = dts + 16;
  const int p = tid >> 2, nq = tid & 3, n0 = nq * 32;
  SampLd L;
  ssd_sample_load(P, l, batch * 8, tid, L);
#pragma unroll 1
  for (int i = 0; i < 8; ++i) {
    const int task = batch * 8 + i, b = task >> 5, h = task & 31, row0 = MP + b * 4;
    float* St = St0 + (i & 1) * (64 * 132);
    const float a_h = -expf(P.a_log[l * NH + h]), dsk = P.ssd_d[l * NH + h];
#pragma unroll
    for (int j = 0; j < 8; ++j) { const int f = (j * 256 + tid) * 4; *(f32x4*)(St + (f >> 7) * 132 + (f & 127)) = L.st[j]; }
    if (tid < 160) {
      const int t = tid / 40, q = tid % 40;
      float* dst = q < 8 ? xs + t * 64 + q * 8 : q < 24 ? Bs + t * 128 + (q - 8) * 8 : Cs + t * 128 + (q - 24) * 8;
      const u32x4 v = L.xcv;
      *(f32x4*)dst = (f32x4){bflo(v.x), bfhi(v.x), bflo(v.y), bfhi(v.y)};
      *(f32x4*)(dst + 4) = (f32x4){bflo(v.z), bfhi(v.z), bflo(v.w), bfhi(v.w)};
    }
    if (tid >= 192 && tid < 196) dts[tid - 192] = L.dtv;
    float zt[4];
#pragma unroll
    for (int t = 0; t < 4; ++t) zt[t] = L.zt[t];
    __syncthreads();
    if (i + 1 < 8) ssd_sample_load(P, l, task + 1, tid, L);
    f32x4 hs[8];
#pragma unroll
    for (int j = 0; j < 8; ++j) hs[j] = *(const f32x4*)(St + p * 132 + n0 + j * 4);
#pragma unroll
    for (int t = 0; t < 4; ++t) {
      const float dtv = dts[t], dA = __expf(dtv * a_h), xv = xs[t * 64 + p], xdt = xv * dtv;
      float yp = 0.f;
#pragma unroll
      for (int j = 0; j < 8; ++j) {
        const f32x4 bv = *(const f32x4*)(Bs + t * 128 + n0 + j * 4);
        const f32x4 cv = *(const f32x4*)(Cs + t * 128 + n0 + j * 4);
        hs[j] = hs[j] * dA + bv * xdt;
        yp += hs[j].x * cv.x + hs[j].y * cv.y + hs[j].z * cv.z + hs[j].w * cv.w;
      }
      yp += __shfl_xor(yp, 1); yp += __shfl_xor(yp, 2);
      const int row = row0 + t;
      float v = 0.f;
      if (nq == 0) {
        v = (yp + dsk * xv) * siluf_(zt[t]);
        act[(size_t)row * 4096 + 2048 + h * 64 + p] = (bf16_t)(pk2(v, 0.f) & 0xffff);
      }
      const float ss = wave_sum(v * v);
      if (lane == 0) atomicAdd(sss + row, ss);
    }
#pragma unroll
    for (int j = 0; j < 8; ++j) *(f32x4*)(St + p * 132 + n0 + j * 4) = hs[j];
    __syncthreads();
    float* so = P.out + O_SSDS + ((size_t)(l * DB + b) * NH + h) * HD * SN;
#pragma unroll
    for (int j = 0; j < 8; ++j) { const int f = (j * 256 + tid) * 4; *(f32x4*)(so + f) = *(const f32x4*)(St + (f >> 7) * 132 + (f & 127)); }
  }
}

__device__ __forceinline__ void phase_mix(const Params& P, int l, unsigned char* lds, int dummy = 0) {
  int* counter = (int*)(P.ws + WS_CNT) + l + (dummy ? 8 : 0);
  int* slot = (int*)lds;
  constexpr int T0 = 256, T1 = T0 + 512, T2 = T1 + DB * NH / 8, T3 = T2 + NG;
  for (;;) {
    const int t = next_task(counter, slot);
    if (t >= T3) break;
    const int mask = dummy ? (P.probe >> 4) : 15;
    if (t < T0) { if (mask & 1) { const int q = t & 127; if (t < 128) ssd_prompt_task(P, l, q >> 5, q & 31, lds, dummy, 32, 16); else ssd_prompt_task(P, l, q >> 5, q & 31, lds, dummy, 16, 0); } }
    else if (t < T1) { const int q = t - T0; if (mask & 2) s5_block_task<false>(P, l, q & 127, q >> 7, lds); }
    else if (t < T2) { if (mask & 4) ssd_sample_batch(P, l, t - T1, lds, dummy); }
    else { if (mask & 8) s5_block_task<true>(P, l, t - T2, 0, lds); }
  }
}

__device__ __forceinline__ int* panel_flag(const Params& P, int l, int kind, int pm);
__device__ __forceinline__ void panel_wait(int* flag, int need);
__device__ __forceinline__ void phase_final(const Params& P, int gated) {
  const int tid = opaque_tid(), lane = tid & 63, wave = tid >> 6;
  const float* xres = (const float*)(P.ws + WS_XRES);
  const float* ssx = (const float*)(P.ws + WS_SS) + 2 * MT;
  for (int r4 = blockIdx.x; r4 < MT / 4; r4 += gridDim.x) {
    if (gated) panel_wait(panel_flag(P, 1, 1, (r4 * 4) >> 8), 16);
    const int row = r4 * 4 + wave;
    const float rs = rsqrtf(ssx[row] * (1.f / 2048.f) + EPS);
    float* dst = P.out + (size_t)row * DM;
#pragma unroll
    for (int j = 0; j < 8; ++j) {
      const f32x4 v = *(const f32x4*)(xres + (size_t)row * DM + (j * 64 + lane) * 4);
      const f32x4 w = *(const f32x4*)(P.final_w + (j * 64 + lane) * 4);
      *(f32x4*)(dst + (j * 64 + lane) * 4) = v * rs * w;
    }
  }
}

__global__ void __launch_bounds__(256, 2) hymba_fwd(Params P) {
  extern __shared__ __attribute__((aligned(16))) unsigned char lds[];
  cg::grid_group grid = cg::this_grid();
  for (int ph = P.ph_lo; ph < P.ph_hi; ++ph) {
    if (ph > P.ph_lo) grid.sync();
#ifndef TEST_PH
#define TEST_PH -1
#endif
    if (ph == 0) phase_prep(P, lds);
    else if (ph == 1) { phase_gemm<G_IN>(P, 0, lds); deferred_weights(P, lds); }
    else if (ph == 2) phase_conv(P, 0, 0);
    else if (ph == 3 || ph == 5) phase_mix(P, ph == 3 ? 0 : 1, lds);
    else if (ph == 4) { phase_chain(P, 0, lds); phase_conv(P, 1, 1); }
    else { phase_chain(P, 1, lds); phase_final(P, 1); }
  }
}

extern "C" void kernel_launch(void* const* d_in, const int* in_sizes, int n_in, void* d_out, int out_size, void* d_ws, size_t ws_size, hipStream_t stream) {
  static int grid_blocks = 0;
  if (!grid_blocks) {
    int dev = 0, cus = 0, per_cu = 0;
    hipGetDevice(&dev);
    hipDeviceGetAttribute(&cus, hipDeviceAttributeMultiprocessorCount, dev);
    hipFuncSetAttribute((const void*)hymba_fwd, hipFuncAttributeMaxDynamicSharedMemorySize, LDS_BYTES);
    hipOccupancyMaxActiveBlocksPerMultiprocessor(&per_cu, (const void*)hymba_fwd, 256, LDS_BYTES);
    if (per_cu > 2) per_cu = 2;
    if (per_cu < 1) per_cu = 1;
    grid_blocks = cus * per_cu;
    if (ws_size < WS_END) fprintf(stderr, "workspace too small: %zu < %zu\n", ws_size, (size_t)WS_END);
  }
  Params p{};
  const float** ip = (const float**)&p;
  for (int i = 0; i < 27; ++i) ip[i] = (const float*)d_in[i];
  p.out = (float*)d_out; p.ws = (unsigned char*)d_ws; p.ph_lo = 0; p.ph_hi = 7; p.probe = PROBE_BITS;
  void* args[] = {&p};
  hipError_t e = hipLaunchCooperativeKernel((const void*)hymba_fwd, dim3(grid_blocks), dim3(256), args, LDS_BYTES, stream);
  if (e != hipSuccess) fprintf(stderr, "cooperative launch failed: %s (grid %d)\n", hipGetErrorString(e), grid_blocks);
}
```

```cpp
#include <hip/hip_runtime.h>
#include <hip/hip_cooperative_groups.h>
#include <cstdio>
#include <cstdint>
namespace cg = cooperative_groups;

typedef unsigned short bf16_t;
typedef short bf16x8 __attribute__((ext_vector_type(8)));
typedef float f32x4 __attribute__((ext_vector_type(4)));
typedef float f32x2 __attribute__((ext_vector_type(2)));
typedef unsigned u32x4 __attribute__((ext_vector_type(4)));
typedef unsigned u32x2 __attribute__((ext_vector_type(2)));

constexpr int DM = 2048, MP = 8192, MS = 512, MT = MP + MS;
constexpr int SEQ = 2048, NB = 4, DB = 128, DSEQ = 4;
constexpr int INC = 10272, NPROJ = 10240, NPAD = 10368;
constexpr int WA = 2048, NG = 128, NP = 64, NCH = 16;
constexpr int NH = 32, HD = 64, SN = 128, CONVD = 4096;
constexpr float EPS = 1e-5f;

constexpr size_t al256(size_t x) { return (x + 255) & ~(size_t)255; }
constexpr size_t WS_WIN = 0;
constexpr size_t WS_WGLU = WS_WIN + al256((size_t)2 * NPAD * DM * 2);
constexpr size_t WS_WOUT = WS_WGLU + al256((size_t)2 * 2048 * 2048 * 2);
constexpr size_t WS_PROJ = WS_WOUT + al256((size_t)2 * 2048 * 4096 * 2);
constexpr size_t WS_DT = WS_PROJ + al256((size_t)MT * NPROJ * 2);
constexpr size_t WS_G = WS_DT + al256((size_t)MT * 32 * 4);
constexpr size_t WS_ACT = WS_G + al256((size_t)MT * 2048 * 2);
constexpr size_t WS_XRES = WS_ACT + al256((size_t)MT * 4096 * 2);
constexpr size_t WS_XB = WS_XRES + al256((size_t)MT * 2048 * 4);
constexpr size_t WS_SS = WS_XB + al256((size_t)MT * 2048 * 2);
constexpr size_t WS_AB = WS_SS + al256((size_t)9 * MT * 4);
constexpr size_t WS_BBF = WS_AB + al256((size_t)2 * 2 * NG * NP * 4);
constexpr size_t WS_CCF = WS_BBF + al256((size_t)2 * NG * 8 * 64 * 8 * 2);
constexpr size_t WS_CNT = WS_CCF + al256((size_t)2 * NG * 4 * 64 * 8 * 2);
constexpr size_t WS_FLG = WS_CNT + 256;
constexpr size_t WS_XC = WS_FLG + al256((size_t)2 * 3 * 34 * 64);
constexpr size_t WS_DTV = WS_XC + al256((size_t)MT * CONVD * 2);
constexpr size_t WS_END = WS_DTV + al256((size_t)MT * 32 * 4);

constexpr int LDS_BYTES = 73728;
#ifndef PROBE_BITS
#define PROBE_BITS 0
#endif

struct Params {
  const float *x_prompt, *x_sample, *st_s5_re, *st_s5_im, *st_ssd, *cache_conv;
  const float *norm_w, *w_in, *lam_re, *lam_im, *log_step, *b_re, *b_im, *c_re, *c_im, *s5_d;
  const float *glu_w, *glu_b, *s5_norm_w, *conv_w, *conv_b, *dt_bias, *a_log, *ssd_d, *ssd_norm_w, *w_out, *final_w;
  float* out; unsigned char* ws; int ph_lo, ph_hi, probe, pad_;
};

constexpr size_t O_YP = 0;
constexpr size_t O_YS = O_YP + (size_t)MP * DM;
constexpr size_t O_S5RP = O_YS + (size_t)MS * DM;
constexpr size_t O_S5IP = O_S5RP + (size_t)2 * NB * NG * NP;
constexpr size_t O_SSDP = O_S5IP + (size_t)2 * NB * NG * NP;
constexpr size_t O_CONVP = O_SSDP + (size_t)2 * NB * NH * HD * SN;
constexpr size_t O_S5RS = O_CONVP + (size_t)2 * NB * 3 * CONVD;
constexpr size_t O_S5IS = O_S5RS + (size_t)2 * DB * NG * NP;
constexpr size_t O_SSDS = O_S5IS + (size_t)2 * DB * NG * NP;
constexpr size_t O_CONVS = O_SSDS + (size_t)2 * DB * NH * HD * SN;

typedef __bf16 bf16n2 __attribute__((ext_vector_type(2)));
__device__ __forceinline__ unsigned pk2(float lo, float hi) { const f32x2 v = {lo, hi}; return __builtin_bit_cast(unsigned, __builtin_convertvector(v, bf16n2)); }
__device__ __forceinline__ float bflo(unsigned w) { return __uint_as_float(w << 16); }
__device__ __forceinline__ float bfhi(unsigned w) { return __uint_as_float(w & 0xffff0000u); }
__device__ __forceinline__ float bf1(bf16_t h) { return __uint_as_float((unsigned)h << 16); }
__device__ __forceinline__ float sigmoidf_(float x) { return __builtin_amdgcn_rcpf(1.f + __expf(-x)); }
__device__ __forceinline__ float siluf_(float x) { return x * __builtin_amdgcn_rcpf(1.f + __expf(-x)); }
__device__ __forceinline__ float gelu_tanh(float y) { const float z = 0.7978845608028654f * (y + 0.044715f * y * y * y); return y * __builtin_amdgcn_rcpf(1.f + __expf(-2.f * z)); }
__device__ __forceinline__ float wave_sum(float v) {
#pragma unroll
  for (int o = 1; o < 64; o <<= 1) v += __shfl_xor(v, o);
  return v;
}
__device__ __forceinline__ int opaque_tid() { int t = threadIdx.x; asm volatile("" : "+v"(t)); return t; }
__device__ __forceinline__ void st_wt8(void* p, u32x2 v) {
  __hip_atomic_store((unsigned long long*)p, ((unsigned long long)v.y << 32) | v.x, __ATOMIC_RELAXED, __HIP_MEMORY_SCOPE_AGENT);
}
#define LDS_FENCE() asm volatile("s_waitcnt lgkmcnt(0)" ::: "memory")
#define MFMA16(a, b, c) __builtin_amdgcn_mfma_f32_16x16x32_bf16((a), (b), (c), 0, 0, 0)

__device__ __forceinline__ int next_task(int* counter, int* slot) {
  __syncthreads();
  if (threadIdx.x == 0) *slot = atomicAdd(counter, 1);
  __syncthreads();
  return *slot;
}

__device__ __forceinline__ void transpose_tile(const float* W, int K, int N, bf16_t* WT, const float* sc0, const float* sc1, int tile, float* tl) {
  const int tid = opaque_tid();
  const int nkb = K / 64, kb = tile % nkb, nb = tile / nkb, k0 = kb * 64, n0 = nb * 64;
#pragma unroll
  for (int i = 0; i < 4; ++i) {
    const int idx = tid + i * 256, kk = idx >> 4, n4 = (idx & 15) * 4, k = k0 + kk, n = n0 + n4;
    f32x4 v = {0.f, 0.f, 0.f, 0.f};
    if (n < N) { v = *(const f32x4*)(W + (size_t)k * N + n); if (sc0) v *= (k < 2048 ? sc0[k] : sc1[k - 2048]); }
    tl[(n4 + 0) * 65 + kk] = v.x; tl[(n4 + 1) * 65 + kk] = v.y; tl[(n4 + 2) * 65 + kk] = v.z; tl[(n4 + 3) * 65 + kk] = v.w;
  }
  __syncthreads();
  {
    const int n = tid >> 2, kc = (tid & 3) * 16;
    const float* s = tl + n * 65 + kc;
    u32x4 o0, o1;
    o0.x = pk2(s[0], s[1]); o0.y = pk2(s[2], s[3]); o0.z = pk2(s[4], s[5]); o0.w = pk2(s[6], s[7]);
    o1.x = pk2(s[8], s[9]); o1.y = pk2(s[10], s[11]); o1.z = pk2(s[12], s[13]); o1.w = pk2(s[14], s[15]);
    u32x4* dst = (u32x4*)(WT + (size_t)(n0 + n) * K + k0 + kc);
    dst[0] = o0; dst[1] = o1;
  }
  __syncthreads();
}

__device__ __forceinline__ void sincos_own(float ang, float& s, float& c) {
  const float k = rintf(ang * 0.15915494309189535f);
  float r = fmaf(-k, 6.28125f, ang); r = fmaf(-k, 1.9353071795864769e-3f, r);
  const float r2 = r * r;
  float ps = -1.f / 121645100408832000.f;
  ps = fmaf(ps, r2, 1.f / 355687428096000.f);
  ps = fmaf(ps, r2, -1.f / 1307674368000.f);
  ps = fmaf(ps, r2, 1.f / 6227020800.f);
  ps = fmaf(ps, r2, -1.f / 39916800.f);
  ps = fmaf(ps, r2, 1.f / 362880.f);
  ps = fmaf(ps, r2, -1.f / 5040.f);
  ps = fmaf(ps, r2, 1.f / 120.f);
  ps = fmaf(ps, r2, -1.f / 6.f);
  s = fmaf(ps * r2, r, r);
  float pc = 1.f / 2432902008176640000.f;
  pc = fmaf(pc, r2, -1.f / 6402373705728000.f);
  pc = fmaf(pc, r2, 1.f / 20922789888000.f);
  pc = fmaf(pc, r2, -1.f / 87178291200.f);
  pc = fmaf(pc, r2, 1.f / 479001600.f);
  pc = fmaf(pc, r2, -1.f / 3628800.f);
  pc = fmaf(pc, r2, 1.f / 40320.f);
  pc = fmaf(pc, r2, -1.f / 720.f);
  pc = fmaf(pc, r2, 1.f / 24.f);
  pc = fmaf(pc, r2, -0.5f);
  c = fmaf(pc, r2, 1.f);
}

__device__ __forceinline__ void s5_precompute(const Params& P, int l, int g, float* tl) {
  const int tid = opaque_tid();
  float* gre = tl; float* gim = tl + 64;
  if (tid < 64) {
    const int idx = (l * NG + g) * NP + tid;
    const float lr = fminf(P.lam_re[idx], -1e-4f), li = P.lam_im[idx];
    const float step = expf(P.log_step[l * NG + g]);
    const float mag = expf(lr * step);
    float sn, cs; sincos_own(li * step, sn, cs);
    const float abr = mag * cs, abi = mag * sn;
    const float den = lr * lr + li * li, nr = abr - 1.f;
    gre[tid] = (nr * lr + abi * li) / den;
    gim[tid] = (abi * lr - nr * li) / den;
    float* ab = (float*)(P.ws + WS_AB);
    ab[idx] = abr; ab[2 * NG * NP + idx] = abi;
  }
  __syncthreads();
  bf16_t* bbf = (bf16_t*)(P.ws + WS_BBF) + (size_t)(l * NG + g) * 8 * 64 * 8;
  const float* br = P.b_re + (size_t)(l * NG + g) * NP * NCH;
  const float* bi = P.b_im + (size_t)(l * NG + g) * NP * NCH;
  for (int j = 0; j < 16; ++j) {
    const int idx = tid * 16 + j, tile = idx >> 9, lane = (idx >> 3) & 63, e = idx & 7;
    const int pt = tile >> 1, part = tile & 1, p = pt * 16 + (lane & 15), q = lane >> 4, c = q * 8 + e;
    float v = 0.f;
    if (q < 2) { const float a = br[p * NCH + c], b = bi[p * NCH + c]; v = part == 0 ? gre[p] * a - gim[p] * b : gre[p] * b + gim[p] * a; }
    bbf[idx] = (bf16_t)(pk2(v, 0.f) & 0xffff);
  }
  bf16_t* ccf = (bf16_t*)(P.ws + WS_CCF) + (size_t)(l * NG + g) * 4 * 64 * 8;
  const float* cr = P.c_re + (size_t)(l * NG + g) * NCH * NP;
  const float* ci = P.c_im + (size_t)(l * NG + g) * NCH * NP;
  for (int j = 0; j < 8; ++j) {
    const int idx = tid * 8 + j, ks = idx >> 9, lane = (idx >> 3) & 63, e = idx & 7;
    const int c = lane & 15, q = lane >> 4, k = ks * 32 + q * 8 + e, p = k >> 1, part = k & 1;
    const float v = part == 0 ? cr[c * NP + p] : -ci[c * NP + p];
    ccf[idx] = (bf16_t)(pk2(v, 0.f) & 0xffff);
  }
  __syncthreads();
}

constexpr int TW_WIN = 2 * 32 * (NPAD / 64), TW_GLU = 2 * 32 * 32, TW_OUT = 2 * 64 * 32, TW_ALL = TW_WIN + TW_GLU + TW_OUT;
__device__ __forceinline__ void weight_tile_task(const Params& P, int r, float* tl) {
  if (r < TW_WIN) { const int per = 32 * (NPAD / 64), l = r / per; transpose_tile(P.w_in + (size_t)l * DM * INC, DM, INC, (bf16_t*)(P.ws + WS_WIN) + (size_t)l * NPAD * DM, P.norm_w + l * DM, P.norm_w + l * DM, r % per, tl); return; }
  r -= TW_WIN;
  if (r < TW_GLU) { const int per = 32 * 32, l = r / per; transpose_tile(P.glu_w + (size_t)l * 2048 * 2048, 2048, 2048, (bf16_t*)(P.ws + WS_WGLU) + (size_t)l * 2048 * 2048, nullptr, nullptr, r % per, tl); return; }
  r -= TW_GLU;
  { const int per = 64 * 32, l = r / per; transpose_tile(P.w_out + (size_t)l * 4096 * 2048, 4096, 2048, (bf16_t*)(P.ws + WS_WOUT) + (size_t)l * 2048 * 4096, P.s5_norm_w + l * 2048, P.ssd_norm_w + l * 2048, r % per, tl); }
}
__device__ __forceinline__ void deferred_weights(const Params& P, unsigned char* lds) {
  float* tl = (float*)(lds + 64);
  const int grid = gridDim.x, slots = grid >> 3, q = (blockIdx.x & 7) * slots + (blockIdx.x >> 3);
  const int leftover = (34 * 81) % grid;
  int rank = q, n = grid;
  if (leftover != 0) { if (q < leftover) return; rank = q - leftover; n = grid - leftover; }
  __syncthreads();
  for (int r = 32 * (NPAD / 64) + rank; r < TW_ALL; r += n) weight_tile_task(P, r, tl);
}

__device__ __forceinline__ void phase_prep(const Params& P, unsigned char* lds) {
  float* tl = (float*)(lds + 64);
  const int tid = opaque_tid(), lane = tid & 63, wave = tid >> 6;
  {
    float* ss = (float*)(P.ws + WS_SS);
    for (int i = blockIdx.x * 256 + tid; i < 8 * MT; i += gridDim.x * 256) ss[MT + i] = 0.f;
    if (blockIdx.x == 0 && tid < 64) ((int*)(P.ws + WS_CNT))[tid] = 0;
    if (blockIdx.x == 1) for (int i = tid; i < 2 * 3 * 34 * 16; i += 256) ((int*)(P.ws + WS_FLG))[i] = 0;
  }
  constexpr int T_W0 = 32 * (NPAD / 64), T_X = MT / 4, T_S5 = 2 * NG;
  constexpr int T_ALL = T_W0 + T_X + T_S5;
  for (int t = blockIdx.x; t < T_ALL; t += gridDim.x) {
    int r = t;
    if (r < T_W0) { weight_tile_task(P, r, tl); continue; }
    r -= T_W0;
    if (r < T_X) {
      const int row = r * 4 + wave;
      const float* src = row < MP ? P.x_prompt + (size_t)row * DM : P.x_sample + (size_t)(row - MP) * DM;
      bf16_t* dst = (bf16_t*)(P.ws + WS_XB) + (size_t)row * DM;
      float s = 0.f;
#pragma unroll
      for (int j = 0; j < 8; ++j) {
        const f32x4 v = *(const f32x4*)(src + (j * 64 + lane) * 4);
        s += v.x * v.x + v.y * v.y + v.z * v.z + v.w * v.w;
        u32x2 o; o.x = pk2(v.x, v.y); o.y = pk2(v.z, v.w);
        *(u32x2*)(dst + (j * 64 + lane) * 4) = o;
      }
      s = wave_sum(s);
      if (lane == 0) ((float*)(P.ws + WS_SS))[row] = s;
      continue;
    }
    r -= T_X;
    s5_precompute(P, r / NG, r % NG, tl);
  }
}

constexpr int G_IN = 0, G_GLU = 1, G_OUT = 2;

__device__ __forceinline__ bool gemm_unit_of(int v, int NT, int& pm, int& pn) {
  const int total = 34 * NT;
  if (v >= total) return false;
  const int ng = NT >> 3, rem = NT & 7;
  if (v < ng * 272) { const int pg = v / 272, w = v % 272; pm = w >> 3; pn = pg * 8 + (w & 7); }
  else { const int w = v - ng * 272; pm = w / rem; pn = ng * 8 + w % rem; }
  return true;
}

template <int MODE>
__device__ __forceinline__ void gemm_unit(const Params& P, int l, int pm, int pn, unsigned char* lds, int dummy) {
  constexpr int K = MODE == G_OUT ? 4096 : 2048;
  constexpr int NK = K / 32;
  const bf16_t* A = MODE == G_IN ? (const bf16_t*)(P.ws + WS_XB) : MODE == G_GLU ? (const bf16_t*)(P.ws + WS_G) : (const bf16_t*)(P.ws + WS_ACT);
  const bf16_t* Bt = MODE == G_IN ? (const bf16_t*)(P.ws + WS_WIN) + (size_t)l * NPAD * DM
                   : MODE == G_GLU ? (const bf16_t*)(P.ws + WS_WGLU) + (size_t)l * 2048 * 2048
                                   : (const bf16_t*)(P.ws + WS_WOUT) + (size_t)l * 2048 * 4096;
  const int tid = opaque_tid(), lane = tid & 63, wave = tid >> 6, wr = wave >> 1, wc = wave & 1, fr = lane & 15, fq = lane >> 4;
  unsigned char* base = lds + 64;
  const int grow = tid >> 2, gch = (tid & 3) ^ ((((tid >> 2) >> 3) & 1) << 1);
  const bf16_t* Ag = A + (size_t)(pm * 256 + grow) * K + gch * 8;
  const bf16_t* Bg = Bt + (size_t)(pn * 128 + grow) * K + gch * 8;
  const int swz = (fq ^ ((fr >> 3) << 1)) << 4;
  const int a_rd = (wr * 128 + fr) * 64 + swz;
  const int b_rd = 16384 + (wc * 64 + fr) * 64 + swz;

  f32x4 acc[8][4];
#pragma unroll
  for (int mi = 0; mi < 8; ++mi)
#pragma unroll
    for (int ni = 0; ni < 4; ++ni) acc[mi][ni] = (f32x4){0.f, 0.f, 0.f, 0.f};

  auto stage_tile = [&](int kt, unsigned char* st) __attribute__((always_inline)) {
#pragma unroll
    for (int i = 0; i < 4; ++i) __builtin_amdgcn_global_load_lds((const unsigned*)(Ag + (size_t)i * 64 * K + kt * 32), (unsigned*)(st + (tid + i * 256) * 16), 16, 0, 0);
#pragma unroll
    for (int i = 0; i < 2; ++i) __builtin_amdgcn_global_load_lds((const unsigned*)(Bg + (size_t)i * 64 * K + kt * 32), (unsigned*)(st + 16384 + (tid + i * 256) * 16), 16, 0, 0);
  };
  stage_tile(0, base);
  __syncthreads();

  for (int kt = 0; kt < NK; ++kt) {
    unsigned char* cur = base + (kt & 1) * 24576;
    unsigned char* nxt = base + ((kt & 1) ^ 1) * 24576;
    if (kt + 1 < NK) stage_tile(kt + 1, nxt);
    __builtin_amdgcn_sched_barrier(0);
    if (MODE == G_OUT && kt == NK / 2) {
      const float* ssa = (const float*)(P.ws + WS_SS) + (3 + l) * MT;
      const float* sss = (const float*)(P.ws + WS_SS) + (5 + l) * MT;
#pragma unroll
      for (int mi = 0; mi < 8; ++mi) {
        const int row = pm * 256 + wr * 128 + mi * 16 + fr;
        const float ra = rsqrtf(ssa[row] * (1.f / 2048.f) + EPS), rs = rsqrtf(sss[row] * (1.f / 2048.f) + EPS);
        const float ratio = ra / rs;
#pragma unroll
        for (int ni = 0; ni < 4; ++ni) acc[mi][ni] *= ratio;
      }
    }
    bf16x8 af[8], bfr[4];
#pragma unroll
    for (int mi = 0; mi < 8; ++mi) af[mi] = *(const bf16x8*)(cur + a_rd + mi * 1024);
#pragma unroll
    for (int ni = 0; ni < 4; ++ni) bfr[ni] = *(const bf16x8*)(cur + b_rd + ni * 1024);
    __builtin_amdgcn_s_setprio(1);
#pragma unroll
    for (int mi = 0; mi < 8; ++mi)
#pragma unroll
      for (int ni = 0; ni < 4; ++ni) acc[mi][ni] = MFMA16(bfr[ni], af[mi], acc[mi][ni]);
    __builtin_amdgcn_s_setprio(0);
    __syncthreads();
  }

  const int row0 = pm * 256 + wr * 128 + fr, col0 = pn * 128 + wc * 64 + fq * 4;
  if (MODE == G_IN) {
    const float* ssx = (const float*)(P.ws + WS_SS) + l * MT;
    bf16_t* proj = (bf16_t*)(P.ws + WS_PROJ);
    float* dtv = (float*)(P.ws + WS_DTV);
    const bool wt = dummy == 4 && pn >= 32 && pn < 64;
#pragma unroll
    for (int mi = 0; mi < 8; ++mi) {
      const int row = row0 + mi * 16;
      const float rs = rsqrtf(ssx[row] * (1.f / 2048.f) + EPS);
#pragma unroll
      for (int ni = 0; ni < 4; ++ni) {
        const f32x4 v = acc[mi][ni] * rs;
        const int col = col0 + ni * 16;
        if (pn < 80) {
          u32x2 o; o.x = pk2(v.x, v.y); o.y = pk2(v.z, v.w);
          if (wt) st_wt8(proj + (size_t)row * NPROJ + col, o); else *(u32x2*)(proj + (size_t)row * NPROJ + col) = o;
        } else if (col < NPROJ + 32) {
          const f32x4 bb = *(const f32x4*)(P.dt_bias + l * NH + (col - NPROJ));
          f32x4 x = v + bb, o;
          o.x = fmaxf(x.x, 0.f) + log1pf(__expf(-fabsf(x.x))); o.y = fmaxf(x.y, 0.f) + log1pf(__expf(-fabsf(x.y)));
          o.z = fmaxf(x.z, 0.f) + log1pf(__expf(-fabsf(x.z))); o.w = fmaxf(x.w, 0.f) + log1pf(__expf(-fabsf(x.w)));
          *(f32x4*)(dtv + (size_t)row * 32 + (col - NPROJ)) = o;
        }
      }
    }
  } else if (MODE == G_GLU) {
    const bf16_t* gbuf = (const bf16_t*)(P.ws + WS_G);
    const bf16_t* proj = (const bf16_t*)(P.ws + WS_PROJ);
    bf16_t* act = (bf16_t*)(P.ws + WS_ACT);
    float* ssa = (float*)(P.ws + WS_SS) + (dummy ? 7 : 3 + l) * MT;
    const float* gb_ = P.glu_b + l * 2048;
#pragma unroll
    for (int mi = 0; mi < 8; ++mi) {
      const int row = row0 + mi * 16;
      float ss = 0.f;
#pragma unroll
      for (int ni = 0; ni < 4; ++ni) {
        const int col = col0 + ni * 16;
        const f32x4 bv = *(const f32x4*)(gb_ + col);
        const u32x2 gw = *(const u32x2*)(gbuf + (size_t)row * 2048 + col);
        const u32x2 zw = *(const u32x2*)(proj + (size_t)row * NPROJ + 2048 + col);
        const f32x4 a = acc[mi][ni] + bv;
        const float v0 = bflo(gw.x) * sigmoidf_(a.x) * siluf_(bflo(zw.x));
        const float v1 = bfhi(gw.x) * sigmoidf_(a.y) * siluf_(bfhi(zw.x));
        const float v2 = bflo(gw.y) * sigmoidf_(a.z) * siluf_(bflo(zw.y));
        const float v3 = bfhi(gw.y) * sigmoidf_(a.w) * siluf_(bfhi(zw.y));
        ss += v0 * v0 + v1 * v1 + v2 * v2 + v3 * v3;
        u32x2 o; o.x = pk2(v0, v1); o.y = pk2(v2, v3);
        st_wt8(act + (size_t)row * 4096 + col, o);
      }
      ss += __shfl_xor(ss, 16); ss += __shfl_xor(ss, 32);
      if (fq == 0) atomicAdd(ssa + row, ss);
    }
  } else {
    const float* sss = (const float*)(P.ws + WS_SS) + (5 + l) * MT;
    float* ssx = (float*)(P.ws + WS_SS) + (l + 1) * MT;
    float* xres = (float*)(P.ws + WS_XRES);
    bf16_t* xb = (bf16_t*)(P.ws + WS_XB);
#pragma unroll
    for (int mi = 0; mi < 8; ++mi) {
      const int row = row0 + mi * 16;
      const float rs = rsqrtf(sss[row] * (1.f / 2048.f) + EPS);
      const float* xold = l == 0 ? (row < MP ? P.x_prompt + (size_t)row * DM : P.x_sample + (size_t)(row - MP) * DM) : xres + (size_t)row * DM;
      float ss = 0.f;
#pragma unroll
      for (int ni = 0; ni < 4; ++ni) {
        const int col = col0 + ni * 16;
        const f32x4 xo = *(const f32x4*)(xold + col);
        const f32x4 v = xo + acc[mi][ni] * rs;
        ss += v.x * v.x + v.y * v.y + v.z * v.z + v.w * v.w;
        st_wt8(xres + (size_t)row * DM + col, (u32x2){__float_as_uint(v.x), __float_as_uint(v.y)});
        st_wt8(xres + (size_t)row * DM + col + 2, (u32x2){__float_as_uint(v.z), __float_as_uint(v.w)});
        u32x2 o; o.x = pk2(v.x, v.y); o.y = pk2(v.z, v.w);
        st_wt8(xb + (size_t)row * DM + col, o);
      }
      ss += __shfl_xor(ss, 16); ss += __shfl_xor(ss, 32);
      if (fq == 0) atomicAdd(ssx + row, ss);
    }
  }
}

__device__ __forceinline__ int* panel_flag(const Params& P, int l, int kind, int pm);
__device__ __forceinline__ void panel_signal(int* flag);
template <int MODE>
__device__ __forceinline__ void phase_gemm(const Params& P, int l, unsigned char* lds, int dummy = 0) {
  constexpr int NT = MODE == G_IN ? 81 : 16;
  const int slots = gridDim.x >> 3, xcd = blockIdx.x & 7, slot = blockIdx.x >> 3;
  for (int i = 0;; ++i) {
    const int v = (i * 8 + xcd) * slots + slot;
    int pm, pn;
    if (!gemm_unit_of(v, NT, pm, pn)) break;
    gemm_unit<MODE>(P, l, pm, pn, lds, dummy);
    if (MODE == G_IN && dummy == 4 && pn >= 32 && pn < 64) panel_signal(panel_flag(P, 1, 2, pm));
  }
}


__device__ __forceinline__ int* panel_flag(const Params& P, int l, int kind, int pm) { return (int*)(P.ws + WS_FLG) + ((l * 3 + kind) * 34 + pm) * 16; }
__device__ __forceinline__ void panel_wait(int* flag, int need) {
  if (threadIdx.x == 0) { while (__hip_atomic_load(flag, __ATOMIC_RELAXED, __HIP_MEMORY_SCOPE_AGENT) < need) __builtin_amdgcn_s_sleep(4); }
  __syncthreads();
  asm volatile("" ::: "memory");
}
__device__ __forceinline__ void panel_signal(int* flag) {
  asm volatile("s_waitcnt vmcnt(0)" ::: "memory");
  __syncthreads();
  if (threadIdx.x == 0) __hip_atomic_fetch_add(flag, 1, __ATOMIC_RELAXED, __HIP_MEMORY_SCOPE_AGENT);
}
__device__ __forceinline__ void phase_chain(const Params& P, int l, unsigned char* lds) {
  const int nGLU = 34 * 16, nOUT = 34 * 16, nIN = l == 0 ? 34 * 81 : 0, total = nGLU + nOUT + nIN;
  const int slots = gridDim.x >> 3, xcd = blockIdx.x & 7, slot = blockIdx.x >> 3;
  for (int i = 0;; ++i) {
    const int v = (i * 8 + xcd) * slots + slot;
    if (v >= total) break;
    int pm, pn;
    if (v < nGLU) {
      gemm_unit_of(v, 16, pm, pn);
      gemm_unit<G_GLU>(P, l, pm, pn, lds, 0);
      panel_signal(panel_flag(P, l, 0, pm));
    } else if (v < nGLU + nOUT) {
      gemm_unit_of(v - nGLU, 16, pm, pn);
      panel_wait(panel_flag(P, l, 0, pm), 16);
      gemm_unit<G_OUT>(P, l, pm, pn, lds, 0);
      panel_signal(panel_flag(P, l, 1, pm));
    } else {
      gemm_unit_of(v - nGLU - nOUT, 81, pm, pn);
      panel_wait(panel_flag(P, l, 1, pm), 16);
      gemm_unit<G_IN>(P, l + 1, pm, pn, lds, 4);
      if (pn >= 32 && pn < 64) panel_signal(panel_flag(P, l, 2, pm));
    }
  }
}

__device__ __forceinline__ void conv8(const u32x4* r, int i, const f32x4* w, const f32x4* bias, float* o) {
#pragma unroll
  for (int hf = 0; hf < 2; ++hf) {
    f32x4 a = bias[hf];
#pragma unroll
    for (int k = 0; k < 4; ++k) {
      const u32x4 rv = r[i + k];
      const unsigned w0 = hf == 0 ? rv.x : rv.z, w1 = hf == 0 ? rv.y : rv.w;
      const f32x4 wk = w[k * 2 + hf];
      a.x = fmaf(wk.x, bflo(w0), a.x); a.y = fmaf(wk.y, bfhi(w0), a.y);
      a.z = fmaf(wk.z, bflo(w1), a.z); a.w = fmaf(wk.w, bfhi(w1), a.w);
    }
    o[hf * 4 + 0] = siluf_(a.x); o[hf * 4 + 1] = siluf_(a.y); o[hf * 4 + 2] = siluf_(a.z); o[hf * 4 + 3] = siluf_(a.w);
  }
}
__device__ __forceinline__ void store8f(float* dst, u32x4 v) {
  *(f32x4*)dst = (f32x4){bflo(v.x), bfhi(v.x), bflo(v.y), bfhi(v.y)};
  *(f32x4*)(dst + 4) = (f32x4){bflo(v.z), bfhi(v.z), bflo(v.w), bfhi(v.w)};
}

__device__ __forceinline__ void phase_conv(const Params& P, int l, int gated) {
  const int tid = opaque_tid();
  const int gsz = gridDim.x * 256, gid = blockIdx.x * 256 + tid;
  const bf16_t* proj = (const bf16_t*)(P.ws + WS_PROJ);
  bf16_t* xc = (bf16_t*)(P.ws + WS_XC);
  const float* cw = P.conv_w + (size_t)l * 4 * CONVD;
  const float* cb = P.conv_b + (size_t)l * CONVD;
#pragma unroll 1
  for (int it = gid; it < (MP / 8) * 512; it += gsz) {
    const int ch0 = (it & 511) * 8, row0 = (it >> 9) * 8, t0 = row0 & (SEQ - 1);
    if (gated) {
      panel_wait(panel_flag(P, 1 - l, 2, row0 >> 8), 32);
      if (t0 > 0 && (row0 & 255) == 0) panel_wait(panel_flag(P, 1 - l, 2, (row0 >> 8) - 1), 32);
    }
    u32x4 r[11];
#pragma unroll
    for (int j = 0; j < 11; ++j) {
      r[j] = (u32x4){0u, 0u, 0u, 0u};
      if (t0 - 3 + j >= 0) r[j] = *(const u32x4*)(proj + (size_t)(row0 - 3 + j) * NPROJ + 4096 + ch0);
    }
    f32x4 w[8], bias[2];
#pragma unroll
    for (int k = 0; k < 4; ++k) { w[k * 2] = *(const f32x4*)(cw + k * CONVD + ch0); w[k * 2 + 1] = *(const f32x4*)(cw + k * CONVD + ch0 + 4); }
    bias[0] = *(const f32x4*)(cb + ch0); bias[1] = *(const f32x4*)(cb + ch0 + 4);
#pragma unroll
    for (int i = 0; i < 8; ++i) {
      float o[8]; conv8(r, i, w, bias, o);
      u32x4 q; q.x = pk2(o[0], o[1]); q.y = pk2(o[2], o[3]); q.z = pk2(o[4], o[5]); q.w = pk2(o[6], o[7]);
      *(u32x4*)(xc + (size_t)(row0 + i) * CONVD + ch0) = q;
    }
    if (t0 == SEQ - 8) {
      const int bb = row0 >> 11;
#pragma unroll
      for (int j = 0; j < 3; ++j) store8f(P.out + O_CONVP + ((size_t)(l * NB + bb) * 3 + j) * CONVD + ch0, r[8 + j]);
    }
  }
#pragma unroll 1
  for (int it = gid; it < DB * 512; it += gsz) {
    const int ch0 = (it & 511) * 8, bb = it >> 9, row0 = MP + bb * 4;
    if (gated) panel_wait(panel_flag(P, 1 - l, 2, row0 >> 8), 32);
    u32x4 r[7];
#pragma unroll
    for (int j = 0; j < 3; ++j) {
      const float* cp = P.cache_conv + ((size_t)(l * DB + bb) * 3 + j) * CONVD + ch0;
      const f32x4 c0 = *(const f32x4*)cp, c1 = *(const f32x4*)(cp + 4);
      r[j].x = pk2(c0.x, c0.y); r[j].y = pk2(c0.z, c0.w); r[j].z = pk2(c1.x, c1.y); r[j].w = pk2(c1.z, c1.w);
    }
#pragma unroll
    for (int j = 0; j < 4; ++j) r[3 + j] = *(const u32x4*)(proj + (size_t)(row0 + j) * NPROJ + 4096 + ch0);
    f32x4 w[8], bias[2];
#pragma unroll
    for (int k = 0; k < 4; ++k) { w[k * 2] = *(const f32x4*)(cw + k * CONVD + ch0); w[k * 2 + 1] = *(const f32x4*)(cw + k * CONVD + ch0 + 4); }
    bias[0] = *(const f32x4*)(cb + ch0); bias[1] = *(const f32x4*)(cb + ch0 + 4);
#pragma unroll
    for (int i = 0; i < 4; ++i) {
      float o[8]; conv8(r, i, w, bias, o);
      u32x4 q; q.x = pk2(o[0], o[1]); q.y = pk2(o[2], o[3]); q.z = pk2(o[4], o[5]); q.w = pk2(o[6], o[7]);
      *(u32x4*)(xc + (size_t)(row0 + i) * CONVD + ch0) = q;
    }
#pragma unroll
    for (int j = 0; j < 3; ++j) store8f(P.out + O_CONVS + ((size_t)(l * DB + bb) * 3 + j) * CONVD + ch0, r[4 + j]);
  }
}

template <int MODE>
__device__ __forceinline__ void s5_wave(const Params& P, int l, int g, int rowbase, int nchunks, unsigned char* wl, float& hr, float& hi,
                                        const bf16x8 (&bbf)[8], const bf16x8 (&ccf)[4], float ar, float ai) {
  const int lane = opaque_tid() & 63, fr = lane & 15, fq = lane >> 4;
  unsigned char* bu = wl; unsigned char* Hb = wl + 8192;
  const bf16_t* proj = (const bf16_t*)(P.ws + WS_PROJ);
  bf16_t* gbuf = (bf16_t*)(P.ws + WS_G);
  f32x4 dv = {0.f, 0.f, 0.f, 0.f};
  if (MODE != 0) dv = *(const f32x4*)(P.s5_d + l * WA + g * NCH + fq * 4);
  const bf16x8 zero8 = {0, 0, 0, 0, 0, 0, 0, 0};
  bf16x8 uf = zero8;
  if (fq < 2) uf = *(const bf16x8*)(proj + (size_t)(rowbase + fr) * NPROJ + g * NCH + fq * 8);
#pragma unroll 1
  for (int c = 0; c < nchunks; ++c) {
    const int row0 = rowbase + c * 16;
    f32x4 t[8];
#pragma unroll
    for (int i = 0; i < 8; ++i) t[i] = MFMA16(uf, bbf[i], ((f32x4){0.f, 0.f, 0.f, 0.f}));
    u32x2 uw = {0u, 0u};
    if (MODE != 0) uw = *(const u32x2*)(proj + (size_t)(row0 + fr) * NPROJ + g * NCH + fq * 4);
    if (c + 1 < nchunks) { if (fq < 2) uf = *(const bf16x8*)(proj + (size_t)(row0 + 16 + fr) * NPROJ + g * NCH + fq * 8); }
#pragma unroll
    for (int pt = 0; pt < 4; ++pt)
#pragma unroll
      for (int r = 0; r < 4; ++r) {
        f32x2 v; v.x = t[2 * pt][r]; v.y = t[2 * pt + 1][r];
        *(f32x2*)(bu + (fq * 4 + r) * 512 + (pt * 16 + fr) * 8) = v;
      }
    LDS_FENCE();
#pragma unroll
    for (int tt = 0; tt < 16; ++tt) {
      if (MODE == 2 && (tt & 3) == 0) {
        const int b = ((row0 - MP) >> 2) + (tt >> 2);
        hr = P.st_s5_re[((size_t)(l * DB + b) * NG + g) * NP + lane];
        hi = P.st_s5_im[((size_t)(l * DB + b) * NG + g) * NP + lane];
      }
      const f32x2 bv = *(const f32x2*)(bu + tt * 512 + lane * 8);
      const float nr = fmaf(ar, hr, fmaf(-ai, hi, bv.x));
      const float ni = fmaf(ar, hi, fmaf(ai, hr, bv.y));
      hr = nr; hi = ni;
      if (MODE != 0) *(unsigned*)(Hb + tt * 272 + lane * 4) = pk2(hr, hi);
      if (MODE == 2 && (tt & 3) == 3) {
        const int b = ((row0 - MP) >> 2) + (tt >> 2);
        P.out[O_S5RS + ((size_t)(l * DB + b) * NG + g) * NP + lane] = hr;
        P.out[O_S5IS + ((size_t)(l * DB + b) * NG + g) * NP + lane] = hi;
      }
    }
    LDS_FENCE();
    if (MODE != 0) {
      f32x4 y = {0.f, 0.f, 0.f, 0.f};
#pragma unroll
      for (int ks = 0; ks < 4; ++ks) {
        const bf16x8 hf = *(const bf16x8*)(Hb + fr * 272 + ks * 64 + fq * 16);
        y = MFMA16(ccf[ks], hf, y);
      }
      LDS_FENCE();
      const float y0 = gelu_tanh(y.x + dv.x * bflo(uw.x)), y1 = gelu_tanh(y.y + dv.y * bfhi(uw.x));
      const float y2 = gelu_tanh(y.z + dv.z * bflo(uw.y)), y3 = gelu_tanh(y.w + dv.w * bfhi(uw.y));
      u32x2 o; o.x = pk2(y0, y1); o.y = pk2(y2, y3);
      *(u32x2*)(gbuf + (size_t)(row0 + fr) * 2048 + g * NCH + fq * 4) = o;
    }
  }
}

constexpr int L_S5X = 64 + 4 * 12544;
template <bool SAMPLE>
__device__ __forceinline__ void s5_block_task(const Params& P, int l, int g, int b, unsigned char* lds) {
  const int tid = opaque_tid(), lane = tid & 63, wave = tid >> 6;
  const bf16x8* bbp = (const bf16x8*)((const bf16_t*)(P.ws + WS_BBF) + (size_t)(l * NG + g) * 8 * 64 * 8);
  const bf16x8* ccp = (const bf16x8*)((const bf16_t*)(P.ws + WS_CCF) + (size_t)(l * NG + g) * 4 * 64 * 8);
  bf16x8 bbf[8], ccf[4];
#pragma unroll
  for (int i = 0; i < 8; ++i) bbf[i] = bbp[i * 64 + lane];
#pragma unroll
  for (int i = 0; i < 4; ++i) ccf[i] = ccp[i * 64 + lane];
  const float* ab = (const float*)(P.ws + WS_AB);
  const float ar = ab[(l * NG + g) * NP + lane], ai = ab[2 * NG * NP + (l * NG + g) * NP + lane];
  unsigned char* wl = lds + 64 + wave * 12544;
  float hr = 0.f, hi = 0.f;
  if (SAMPLE) {
    s5_wave<2>(P, l, g, MP + wave * 128, 8, wl, hr, hi, bbf, ccf, ar, ai);
  } else {
    const int rowbase = b * SEQ + (wave < 3 ? wave * 448 : 1344), nch = wave < 3 ? 28 : 44;
    if (wave < 3) s5_wave<0>(P, l, g, rowbase, 28, wl, hr, hi, bbf, ccf, ar, ai);
    f32x2* xch = (f32x2*)(lds + L_S5X);
    xch[wave * 64 + lane] = (f32x2){hr, hi};
    float pr = ar, pi = ai;
#pragma unroll
    for (int i = 0; i < 6; ++i) { const float nr = pr * pr - pi * pi, ni = 2.f * pr * pi; pr = nr; pi = ni; }
    const float q64r = pr, q64i = pi;
    { const float nr = pr * pr - pi * pi, ni = 2.f * pr * pi; pr = nr; pi = ni; }
    const float q128r = pr, q128i = pi;
    { const float nr = pr * pr - pi * pi, ni = 2.f * pr * pi; pr = nr; pi = ni; }
    { const float tr = pr * q128r - pi * q128i, ti = pr * q128i + pi * q128r; pr = tr * q64r - ti * q64i; pi = tr * q64i + ti * q64r; }
    __syncthreads();
    hr = 0.f; hi = 0.f;
    for (int j = 0; j < wave; ++j) {
      const f32x2 e = xch[j * 64 + lane];
      const float nr = fmaf(pr, hr, fmaf(-pi, hi, e.x)), ni = fmaf(pr, hi, fmaf(pi, hr, e.y));
      hr = nr; hi = ni;
    }
    s5_wave<1>(P, l, g, rowbase, nch, wl, hr, hi, bbf, ccf, ar, ai);
    if (wave == 3) {
      P.out[O_S5RP + ((size_t)(l * NB + b) * NG + g) * NP + lane] = hr;
      P.out[O_S5IP + ((size_t)(l * NB + b) * NG + g) * NP + lane] = hi;
    }
  }
}

constexpr int L_CN = 64, L_BN = L_CN + 17408, L_BT = L_BN + 17408, L_XT = L_BT + 18432, L_MM = L_XT + 9216, L_DT = L_MM + 9216, L_CS = L_DT + 256;

__device__ __forceinline__ void ssd_prompt_task(const Params& P, int l, int b, int h, unsigned char* lds, int dummy, int c1, int cfull) {
  const int tid = opaque_tid(), lane = tid & 63, wave = tid >> 6, fr = lane & 15, fq = lane >> 4;
  const int gi = h >> 2, pw = wave * 16;
  const bf16_t* proj = (const bf16_t*)(P.ws + WS_PROJ);
  const bf16_t* xc = (const bf16_t*)(P.ws + WS_XC);
  const float* dtvb = (const float*)(P.ws + WS_DTV);
  bf16_t* act = (bf16_t*)(P.ws + WS_ACT);
  float* sss = (float*)(P.ws + WS_SS) + (dummy ? 8 : 5 + l) * MT;
  const float a_h = -expf(P.a_log[l * NH + h]), dsk = P.ssd_d[l * NH + h];
  f32x4 S[8];
#pragma unroll
  for (int i = 0; i < 8; ++i) S[i] = (f32x4){0.f, 0.f, 0.f, 0.f};
  const int crow = tid >> 4, cch = tid & 15;
  u32x4 pc[4], pb[4], px[2]; float pdt;
  {
    const bf16_t* base = xc + (size_t)(b * SEQ) * CONVD;
#pragma unroll
    for (int i = 0; i < 4; ++i) { pc[i] = (u32x4){0u, 0u, 0u, 0u}; if (cfull == 0) pc[i] = *(const u32x4*)(base + (size_t)(i * 16 + crow) * CONVD + 3072 + gi * 128 + cch * 8); }
#pragma unroll
    for (int i = 0; i < 2; ++i) {
      pb[i * 2] = *(const u32x4*)(base + (size_t)((i * 16 + crow) * 2) * CONVD + 2048 + gi * 128 + cch * 8);
      pb[i * 2 + 1] = *(const u32x4*)(base + (size_t)((i * 16 + crow) * 2 + 1) * CONVD + 2048 + gi * 128 + cch * 8);
    }
    px[0] = *(const u32x4*)(base + (size_t)((tid >> 3) * 2) * CONVD + h * 64 + (tid & 7) * 8);
    px[1] = *(const u32x4*)(base + (size_t)((tid >> 3) * 2 + 1) * CONVD + h * 64 + (tid & 7) * 8);
    pdt = dtvb[(size_t)(b * SEQ + lane) * 32 + h];
  }
#pragma unroll 1
  for (int c = 0; c < c1; ++c) {
    const int rowc = b * SEQ + c * 64;
    const bool full = c >= cfull;
    float* DTs = (float*)(lds + L_DT + (c & 1) * 512); float* CSs = DTs + 64;
    {
      float cs = pdt * a_h;
#pragma unroll
      for (int o = 1; o < 64; o <<= 1) { const float v = __shfl_up(cs, o); if (lane >= o) cs += v; }
      if (wave == 0) { DTs[lane] = pdt; CSs[lane] = cs; }
    }
    __syncthreads();
    const float cs_end = CSs[63];
    {
      if (full) {
#pragma unroll
        for (int i = 0; i < 4; ++i) *(u32x4*)(lds + L_CN + (i * 16 + crow) * 272 + cch * 16) = pc[i];
      }
#pragma unroll
      for (int i = 0; i < 2; ++i) {
        const int t0 = (i * 16 + crow) * 2;
        const u32x4 v0 = pb[i * 2], v1 = pb[i * 2 + 1];
        if (full) {
          *(u32x4*)(lds + L_BN + t0 * 272 + cch * 16) = v0;
          *(u32x4*)(lds + L_BN + (t0 + 1) * 272 + cch * 16) = v1;
        }
        const float d0 = __expf(cs_end - CSs[t0]) * DTs[t0], d1 = __expf(cs_end - CSs[t0 + 1]) * DTs[t0 + 1];
        unsigned char* bt = lds + L_BT + (cch * 8) * 144 + t0 * 2;
        *(unsigned*)(bt + 0 * 144) = pk2(bflo(v0.x) * d0, bflo(v1.x) * d1);
        *(unsigned*)(bt + 1 * 144) = pk2(bfhi(v0.x) * d0, bfhi(v1.x) * d1);
        *(unsigned*)(bt + 2 * 144) = pk2(bflo(v0.y) * d0, bflo(v1.y) * d1);
        *(unsigned*)(bt + 3 * 144) = pk2(bfhi(v0.y) * d0, bfhi(v1.y) * d1);
        *(unsigned*)(bt + 4 * 144) = pk2(bflo(v0.z) * d0, bflo(v1.z) * d1);
        *(unsigned*)(bt + 5 * 144) = pk2(bfhi(v0.z) * d0, bfhi(v1.z) * d1);
        *(unsigned*)(bt + 6 * 144) = pk2(bflo(v0.w) * d0, bflo(v1.w) * d1);
        *(unsigned*)(bt + 7 * 144) = pk2(bfhi(v0.w) * d0, bfhi(v1.w) * d1);
      }
      {
        const u32x4 v0 = px[0], v1 = px[1];
        unsigned char* xt = lds + L_XT + ((tid & 7) * 8) * 144 + (tid >> 3) * 4;
        *(unsigned*)(xt + 0 * 144) = (v0.x & 0xffffu) | (v1.x << 16);
        *(unsigned*)(xt + 1 * 144) = (v0.x >> 16) | (v1.x & 0xffff0000u);
        *(unsigned*)(xt + 2 * 144) = (v0.y & 0xffffu) | (v1.y << 16);
        *(unsigned*)(xt + 3 * 144) = (v0.y >> 16) | (v1.y & 0xffff0000u);
        *(unsigned*)(xt + 4 * 144) = (v0.z & 0xffffu) | (v1.z << 16);
        *(unsigned*)(xt + 5 * 144) = (v0.z >> 16) | (v1.z & 0xffff0000u);
        *(unsigned*)(xt + 6 * 144) = (v0.w & 0xffffu) | (v1.w << 16);
        *(unsigned*)(xt + 7 * 144) = (v0.w >> 16) | (v1.w & 0xffff0000u);
      }
    }
    if (c + 1 < c1) {
      const bf16_t* base = xc + (size_t)(rowc + 64) * CONVD;
      if (c + 1 >= cfull) {
#pragma unroll
        for (int i = 0; i < 4; ++i) pc[i] = *(const u32x4*)(base + (size_t)(i * 16 + crow) * CONVD + 3072 + gi * 128 + cch * 8);
      }
#pragma unroll
      for (int i = 0; i < 2; ++i) {
        pb[i * 2] = *(const u32x4*)(base + (size_t)((i * 16 + crow) * 2) * CONVD + 2048 + gi * 128 + cch * 8);
        pb[i * 2 + 1] = *(const u32x4*)(base + (size_t)((i * 16 + crow) * 2 + 1) * CONVD + 2048 + gi * 128 + cch * 8);
      }
      px[0] = *(const u32x4*)(base + (size_t)((tid >> 3) * 2) * CONVD + h * 64 + (tid & 7) * 8);
      px[1] = *(const u32x4*)(base + (size_t)((tid >> 3) * 2 + 1) * CONVD + h * 64 + (tid & 7) * 8);
      pdt = dtvb[(size_t)(rowc + 64 + lane) * 32 + h];
    }
    __syncthreads();
    u32x2 zwv[4];
#pragma unroll
    for (int tt = 0; tt < 4; ++tt) { zwv[tt] = (u32x2){0u, 0u}; if (full) zwv[tt] = *(const u32x2*)(proj + (size_t)(rowc + tt * 16 + fr) * NPROJ + 8192 + h * 64 + pw + fq * 4); }
    if (full) {
      bf16x8 cf[4];
#pragma unroll
      for (int ks = 0; ks < 4; ++ks) cf[ks] = *(const bf16x8*)(lds + L_CN + (wave * 16 + fr) * 272 + ks * 64 + fq * 16);
      const int tcol = wave * 16 + fr; const float cst = CSs[tcol];
#pragma unroll
      for (int st = 0; st < 4; ++st) {
        f32x4 g = {0.f, 0.f, 0.f, 0.f};
#pragma unroll
        for (int ks = 0; ks < 4; ++ks) {
          const bf16x8 bf = *(const bf16x8*)(lds + L_BN + (st * 16 + fr) * 272 + ks * 64 + fq * 16);
          g = MFMA16(bf, cf[ks], g);
        }
        float m[4];
#pragma unroll
        for (int r = 0; r < 4; ++r) {
          const int s_ = st * 16 + fq * 4 + r;
          m[r] = s_ <= tcol ? g[r] * __expf(cst - CSs[s_]) * DTs[s_] : 0.f;
        }
        u32x2 o; o.x = pk2(m[0], m[1]); o.y = pk2(m[2], m[3]);
        *(u32x2*)(lds + L_MM + tcol * 144 + (st * 16 + fq * 4) * 2) = o;
      }
    }
    __syncthreads();
    {
      bf16x8 sf[4];
#pragma unroll
      for (int ks = 0; ks < 4; ++ks) {
        u32x4 v; v.x = pk2(S[2 * ks].x, S[2 * ks].y); v.y = pk2(S[2 * ks].z, S[2 * ks].w); v.z = pk2(S[2 * ks + 1].x, S[2 * ks + 1].y); v.w = pk2(S[2 * ks + 1].z, S[2 * ks + 1].w);
        sf[ks] = __builtin_bit_cast(bf16x8, v);
      }
      bf16x8 xf[2];
#pragma unroll
      for (int k2 = 0; k2 < 2; ++k2) xf[k2] = *(const bf16x8*)(lds + L_XT + (pw + fr) * 144 + k2 * 64 + fq * 16);
      if (full) {
#pragma unroll
      for (int tt = 0; tt < 4; ++tt) {
        const int t = tt * 16 + fr;
        f32x4 y = {0.f, 0.f, 0.f, 0.f};
#pragma unroll
        for (int ks = 0; ks < 4; ++ks) {
          const u32x2 c0 = *(const u32x2*)(lds + L_CN + t * 272 + ((2 * ks) * 16 + fq * 4) * 2);
          const u32x2 c1 = *(const u32x2*)(lds + L_CN + t * 272 + ((2 * ks + 1) * 16 + fq * 4) * 2);
          u32x4 cv; cv.x = c0.x; cv.y = c0.y; cv.z = c1.x; cv.w = c1.y;
          y = MFMA16(sf[ks], __builtin_bit_cast(bf16x8, cv), y);
        }
        y *= __expf(CSs[t]);
#pragma unroll
        for (int k2 = 0; k2 < 2; ++k2) {
          const bf16x8 mf = *(const bf16x8*)(lds + L_MM + t * 144 + k2 * 64 + fq * 16);
          y = MFMA16(xf[k2], mf, y);
        }
        const int row = rowc + t, pc_ = pw + fq * 4;
        const u32x2 zw = zwv[tt];
        const float x0 = bf1(*(const bf16_t*)(lds + L_XT + (pc_ + 0) * 144 + t * 2)), x1 = bf1(*(const bf16_t*)(lds + L_XT + (pc_ + 1) * 144 + t * 2));
        const float x2 = bf1(*(const bf16_t*)(lds + L_XT + (pc_ + 2) * 144 + t * 2)), x3 = bf1(*(const bf16_t*)(lds + L_XT + (pc_ + 3) * 144 + t * 2));
        const float v0 = (y.x + dsk * x0) * siluf_(bflo(zw.x)), v1 = (y.y + dsk * x1) * siluf_(bfhi(zw.x));
        const float v2 = (y.z + dsk * x2) * siluf_(bflo(zw.y)), v3 = (y.w + dsk * x3) * siluf_(bfhi(zw.y));
        u32x2 o; o.x = pk2(v0, v1); o.y = pk2(v2, v3);
        *(u32x2*)(act + (size_t)row * 4096 + 2048 + h * 64 + pc_) = o;
        float ss = v0 * v0 + v1 * v1 + v2 * v2 + v3 * v3;
        ss += __shfl_xor(ss, 16); ss += __shfl_xor(ss, 32);
        if (fq == 0) atomicAdd(sss + row, ss);
      }
      }
      const float dec = __expf(cs_end);
#pragma unroll
      for (int nt = 0; nt < 8; ++nt) {
        S[nt] *= dec;
#pragma unroll
        for (int k2 = 0; k2 < 2; ++k2) {
          const bf16x8 bt = *(const bf16x8*)(lds + L_BT + (nt * 16 + fr) * 144 + k2 * 64 + fq * 16);
          S[nt] = MFMA16(bt, xf[k2], S[nt]);
        }
      }
    }
  }
  if (c1 == SEQ / 64) {
    float* so = P.out + O_SSDP + ((size_t)(l * NB + b) * NH + h) * HD * SN;
#pragma unroll
    for (int nt = 0; nt < 8; ++nt) *(f32x4*)(so + (size_t)(pw + fr) * SN + nt * 16 + fq * 4) = S[nt];
  }
}

struct SampLd { f32x4 st[8]; u32x4 xcv; float dtv; float zt[4]; };
__device__ __forceinline__ void ssd_sample_load(const Params& P, int l, int task, int tid, SampLd& L) {
  const int b = task >> 5, h = task & 31, gi = h >> 2, row0 = MP + b * 4;
  const float* sin_ = P.st_ssd + ((size_t)(l * DB + b) * NH + h) * HD * SN;
#pragma unroll
  for (int j = 0; j < 8; ++j) L.st[j] = *(const f32x4*)(sin_ + (j * 256 + tid) * 4);
  L.xcv = (u32x4){0u, 0u, 0u, 0u}; L.dtv = 0.f;
  if (tid < 160) {
    const int t = tid / 40, q = tid % 40;
    const int ch = q < 8 ? h * 64 + q * 8 : q < 24 ? 2048 + gi * 128 + (q - 8) * 8 : 3072 + gi * 128 + (q - 24) * 8;
    L.xcv = *(const u32x4*)((const bf16_t*)(P.ws + WS_XC) + (size_t)(row0 + t) * CONVD + ch);
  }
  if (tid >= 192 && tid < 196) L.dtv = ((const float*)(P.ws + WS_DTV))[(size_t)(row0 + tid - 192) * 32 + h];
  const int p = tid >> 2;
#pragma unroll
  for (int t = 0; t < 4; ++t) L.zt[t] = bf1(((const bf16_t*)(P.ws + WS_PROJ))[(size_t)(row0 + t) * NPROJ + 8192 + h * 64 + p]);
}

__device__ __forceinline__ void ssd_sample_batch(const Params& P, int l, int batch, unsigned char* lds, int dummy) {
  const int tid = opaque_tid(), lane = tid & 63;
  bf16_t* act = (bf16_t*)(P.ws + WS_ACT);
  float* sss = (float*)(P.ws + WS_SS) + (dummy ? 8 : 5 + l) * MT;
  float* xs = (float*)(lds + 64);
  float* Bs = xs + 256;
  float* Cs = Bs + 512;
  float* dts = Cs + 512;
  float* St0 = dts + 16;
  const int p = tid >> 2, nq = tid & 3, n0 = nq * 32;
  SampLd L;
  ssd_sample_load(P, l, batch * 8, tid, L);
#pragma unroll 1
  for (int i = 0; i < 8; ++i) {
    const int task = batch * 8 + i, b = task >> 5, h = task & 31, row0 = MP + b * 4;
    float* St = St0 + (i & 1) * (64 * 132);
    const float a_h = -expf(P.a_log[l * NH + h]), dsk = P.ssd_d[l * NH + h];
#pragma unroll
    for (int j = 0; j < 8; ++j) { const int f = (j * 256 + tid) * 4; *(f32x4*)(St + (f >> 7) * 132 + (f & 127)) = L.st[j]; }
    if (tid < 160) {
      const int t = tid / 40, q = tid % 40;
      float* dst = q < 8 ? xs + t * 64 + q * 8 : q < 24 ? Bs + t * 128 + (q - 8) * 8 : Cs + t * 128 + (q - 24) * 8;
      const u32x4 v = L.xcv;
      *(f32x4*)dst = (f32x4){bflo(v.x), bfhi(v.x), bflo(v.y), bfhi(v.y)};
      *(f32x4*)(dst + 4) = (f32x4){bflo(v.z), bfhi(v.z), bflo(v.w), bfhi(v.w)};
    }
    if (tid >= 192 && tid < 196) dts[tid - 192] = L.dtv;
    float zt[4];
#pragma unroll
    for (int t = 0; t < 4; ++t) zt[t] = L.zt[t];
    __syncthreads();
    if (i + 1 < 8) ssd_sample_load(P, l, task + 1, tid, L);
    f32x4 hs[8];
#pragma unroll
    for (int j = 0; j < 8; ++j) hs[j] = *(const f32x4*)(St + p * 132 + n0 + j * 4);
#pragma unroll
    for (int t = 0; t < 4; ++t) {
      const float dtv = dts[t], dA = __expf(dtv * a_h), xv = xs[t * 64 + p], xdt = xv * dtv;
      float yp = 0.f;
#pragma unroll
      for (int j = 0; j < 8; ++j) {
        const f32x4 bv = *(const f32x4*)(Bs + t * 128 + n0 + j * 4);
        const f32x4 cv = *(const f32x4*)(Cs + t * 128 + n0 + j * 4);
        hs[j] = hs[j] * dA + bv * xdt;
        yp += hs[j].x * cv.x + hs[j].y * cv.y + hs[j].z * cv.z + hs[j].w * cv.w;
      }
      yp += __shfl_xor(yp, 1); yp += __shfl_xor(yp, 2);
      const int row = row0 + t;
      float v = 0.f;
      if (nq == 0) {
        v = (yp + dsk * xv) * siluf_(zt[t]);
        act[(size_t)row * 4096 + 2048 + h * 64 + p] = (bf16_t)(pk2(v, 0.f) & 0xffff);
      }
      const float ss = wave_sum(v * v);
      if (lane == 0) atomicAdd(sss + row, ss);
    }
#pragma unroll
    for (int j = 0; j < 8; ++j) *(f32x4*)(St + p * 132 + n0 + j * 4) = hs[j];
    __syncthreads();
    float* so = P.out + O_SSDS + ((size_t)(l * DB + b) * NH + h) * HD * SN;
#pragma unroll
    for (int j = 0; j < 8; ++j) { const int f = (j * 256 + tid) * 4; *(f32x4*)(so + f) = *(const f32x4*)(St + (f >> 7) * 132 + (f & 127)); }
  }
}

__device__ __forceinline__ void phase_mix(const Params& P, int l, unsigned char* lds, int dummy = 0) {
  int* counter = (int*)(P.ws + WS_CNT) + l + (dummy ? 8 : 0);
  int* slot = (int*)lds;
  constexpr int T0 = 256, T1 = T0 + 512, T2 = T1 + DB * NH / 8, T3 = T2 + NG;
  for (;;) {
    const int t = next_task(counter, slot);
    if (t >= T3) break;
    const int mask = dummy ? (P.probe >> 4) : 15;
    if (t < T0) { if (mask & 1) { const int q = t & 127; if (t < 128) ssd_prompt_task(P, l, q >> 5, q & 31, lds, dummy, 32, 16); else ssd_prompt_task(P, l, q >> 5, q & 31, lds, dummy, 16, 0); } }
    else if (t < T1) { const int q = t - T0; if (mask & 2) s5_block_task<false>(P, l, q & 127, q >> 7, lds); }
    else if (t < T2) { if (mask & 4) ssd_sample_batch(P, l, t - T1, lds, dummy); }
    else { if (mask & 8) s5_block_task<true>(P, l, t - T2, 0, lds); }
  }
}

__device__ __forceinline__ int* panel_flag(const Params& P, int l, int kind, int pm);
__device__ __forceinline__ void panel_wait(int* flag, int need);
__device__ __forceinline__ void phase_final(const Params& P, int gated) {
  const int tid = opaque_tid(), lane = tid & 63, wave = tid >> 6;
  const float* xres = (const float*)(P.ws + WS_XRES);
  const float* ssx = (const float*)(P.ws + WS_SS) + 2 * MT;
  for (int r4 = blockIdx.x; r4 < MT / 4; r4 += gridDim.x) {
    if (gated) panel_wait(panel_flag(P, 1, 1, (r4 * 4) >> 8), 16);
    const int row = r4 * 4 + wave;
    const float rs = rsqrtf(ssx[row] * (1.f / 2048.f) + EPS);
    float* dst = P.out + (size_t)row * DM;
#pragma unroll
    for (int j = 0; j < 8; ++j) {
      const f32x4 v = *(const f32x4*)(xres + (size_t)row * DM + (j * 64 + lane) * 4);
      const f32x4 w = *(const f32x4*)(P.final_w + (j * 64 + lane) * 4);
      *(f32x4*)(dst + (j * 64 + lane) * 4) = v * rs * w;
    }
  }
}

__global__ void __launch_bounds__(256, 2) hymba_fwd(Params P) {
  extern __shared__ __attribute__((aligned(16))) unsigned char lds[];
  cg::grid_group grid = cg::this_grid();
  for (int ph = P.ph_lo; ph < P.ph_hi; ++ph) {
    if (ph > P.ph_lo) grid.sync();
#ifndef TEST_PH
#define TEST_PH -1
#endif
    if (ph == 0) phase_prep(P, lds);
    else if (ph == 1) { phase_gemm<G_IN>(P, 0, lds, 4); deferred_weights(P, lds); phase_conv(P, 0, 1); }
    else if (ph == 2 || ph == 4) phase_mix(P, ph == 2 ? 0 : 1, lds);
    else if (ph == 3) { phase_chain(P, 0, lds); phase_conv(P, 1, 1); }
    else { phase_chain(P, 1, lds); phase_final(P, 1); }
  }
}

extern "C" void kernel_launch(void* const* d_in, const int* in_sizes, int n_in, void* d_out, int out_size, void* d_ws, size_t ws_size, hipStream_t stream) {
  static int grid_blocks = 0;
  if (!grid_blocks) {
    int dev = 0, cus = 0, per_cu = 0;
    hipGetDevice(&dev);
    hipDeviceGetAttribute(&cus, hipDeviceAttributeMultiprocessorCount, dev);
    hipFuncSetAttribute((const void*)hymba_fwd, hipFuncAttributeMaxDynamicSharedMemorySize, LDS_BYTES);
    hipOccupancyMaxActiveBlocksPerMultiprocessor(&per_cu, (const void*)hymba_fwd, 256, LDS_BYTES);
    if (per_cu > 2) per_cu = 2;
    if (per_cu < 1) per_cu = 1;
    grid_blocks = cus * per_cu;
    if (ws_size < WS_END) fprintf(stderr, "workspace too small: %zu < %zu\n", ws_size, (size_t)WS_END);
  }
  Params p{};
  const float** ip = (const float**)&p;
  for (int i = 0; i < 27; ++i) ip[i] = (const float*)d_in[i];
  p.out = (float*)d_out; p.ws = (unsigned char*)d_ws; p.ph_lo = 0; p.ph_hi = 6; p.probe = PROBE_BITS;
  void* args[] = {&p};
  hipError_t e = hipLaunchCooperativeKernel((const void*)hymba_fwd, dim3(grid_blocks), dim3(256), args, LDS_BYTES, stream);
  if (e != hipSuccess) fprintf(stderr, "cooperative launch failed: %s (grid %d)\n", hipGetErrorString(e), grid_blocks);
}
```

```cpp
#include <hip/hip_runtime.h>
#include <hip/hip_cooperative_groups.h>
#include <cstdio>
#include <cstdint>
namespace cg = cooperative_groups;

typedef unsigned short bf16_t;
typedef short bf16x8 __attribute__((ext_vector_type(8)));
typedef float f32x4 __attribute__((ext_vector_type(4)));
typedef float f32x2 __attribute__((ext_vector_type(2)));
typedef unsigned u32x4 __attribute__((ext_vector_type(4)));
typedef unsigned u32x2 __attribute__((ext_vector_type(2)));

constexpr int DM = 2048, MP = 8192, MS = 512, MT = MP + MS;
constexpr int SEQ = 2048, NB = 4, DB = 128, DSEQ = 4;
constexpr int INC = 10272, NPROJ = 10240, NPAD = 10368;
constexpr int WA = 2048, NG = 128, NP = 64, NCH = 16;
constexpr int NH = 32, HD = 64, SN = 128, CONVD = 4096;
constexpr float EPS = 1e-5f;

constexpr size_t al256(size_t x) { return (x + 255) & ~(size_t)255; }
constexpr size_t WS_WIN = 0;
constexpr size_t WS_WGLU = WS_WIN + al256((size_t)2 * NPAD * DM * 2);
constexpr size_t WS_WOUT = WS_WGLU + al256((size_t)2 * 2048 * 2048 * 2);
constexpr size_t WS_PROJ = WS_WOUT + al256((size_t)2 * 2048 * 4096 * 2);
constexpr size_t WS_DT = WS_PROJ + al256((size_t)MT * NPROJ * 2);
constexpr size_t WS_G = WS_DT + al256((size_t)MT * 32 * 4);
constexpr size_t WS_ACT = WS_G + al256((size_t)MT * 2048 * 2);
constexpr size_t WS_XRES = WS_ACT + al256((size_t)MT * 4096 * 2);
constexpr size_t WS_XB = WS_XRES + al256((size_t)MT * 2048 * 4);
constexpr size_t WS_SS = WS_XB + al256((size_t)MT * 2048 * 2);
constexpr size_t WS_AB = WS_SS + al256((size_t)9 * MT * 4);
constexpr size_t WS_BBF = WS_AB + al256((size_t)2 * 2 * NG * NP * 4);
constexpr size_t WS_CCF = WS_BBF + al256((size_t)2 * NG * 8 * 64 * 8 * 2);
constexpr size_t WS_CNT = WS_CCF + al256((size_t)2 * NG * 4 * 64 * 8 * 2);
constexpr size_t WS_FLG = WS_CNT + 256;
constexpr size_t WS_XC = WS_FLG + al256((size_t)2 * 3 * 34 * 64);
constexpr size_t WS_DTV = WS_XC + al256((size_t)MT * CONVD * 2);
constexpr size_t WS_END = WS_DTV + al256((size_t)MT * 32 * 4);

constexpr int LDS_BYTES = 73728;
#ifndef PROBE_BITS
#define PROBE_BITS 0
#endif

struct Params {
  const float *x_prompt, *x_sample, *st_s5_re, *st_s5_im, *st_ssd, *cache_conv;
  const float *norm_w, *w_in, *lam_re, *lam_im, *log_step, *b_re, *b_im, *c_re, *c_im, *s5_d;
  const float *glu_w, *glu_b, *s5_norm_w, *conv_w, *conv_b, *dt_bias, *a_log, *ssd_d, *ssd_norm_w, *w_out, *final_w;
  float* out; unsigned char* ws; int ph_lo, ph_hi, probe, pad_;
};

constexpr size_t O_YP = 0;
constexpr size_t O_YS = O_YP + (size_t)MP * DM;
constexpr size_t O_S5RP = O_YS + (size_t)MS * DM;
constexpr size_t O_S5IP = O_S5RP + (size_t)2 * NB * NG * NP;
constexpr size_t O_SSDP = O_S5IP + (size_t)2 * NB * NG * NP;
constexpr size_t O_CONVP = O_SSDP + (size_t)2 * NB * NH * HD * SN;
constexpr size_t O_S5RS = O_CONVP + (size_t)2 * NB * 3 * CONVD;
constexpr size_t O_S5IS = O_S5RS + (size_t)2 * DB * NG * NP;
constexpr size_t O_SSDS = O_S5IS + (size_t)2 * DB * NG * NP;
constexpr size_t O_CONVS = O_SSDS + (size_t)2 * DB * NH * HD * SN;

typedef __bf16 bf16n2 __attribute__((ext_vector_type(2)));
__device__ __forceinline__ unsigned pk2(float lo, float hi) { const f32x2 v = {lo, hi}; return __builtin_bit_cast(unsigned, __builtin_convertvector(v, bf16n2)); }
__device__ __forceinline__ float bflo(unsigned w) { return __uint_as_float(w << 16); }
__device__ __forceinline__ float bfhi(unsigned w) { return __uint_as_float(w & 0xffff0000u); }
__device__ __forceinline__ float bf1(bf16_t h) { return __uint_as_float((unsigned)h << 16); }
__device__ __forceinline__ float sigmoidf_(float x) { return __builtin_amdgcn_rcpf(1.f + __expf(-x)); }
__device__ __forceinline__ float siluf_(float x) { return x * __builtin_amdgcn_rcpf(1.f + __expf(-x)); }
__device__ __forceinline__ float gelu_tanh(float y) { const float z = 0.7978845608028654f * (y + 0.044715f * y * y * y); return y * __builtin_amdgcn_rcpf(1.f + __expf(-2.f * z)); }
__device__ __forceinline__ float wave_sum(float v) {
#pragma unroll
  for (int o = 1; o < 64; o <<= 1) v += __shfl_xor(v, o);
  return v;
}
__device__ __forceinline__ int opaque_tid() { int t = threadIdx.x; asm volatile("" : "+v"(t)); return t; }
__device__ __forceinline__ void st_wt8(void* p, u32x2 v) {
  __hip_atomic_store((unsigned long long*)p, ((unsigned long long)v.y << 32) | v.x, __ATOMIC_RELAXED, __HIP_MEMORY_SCOPE_AGENT);
}
#define LDS_FENCE() asm volatile("s_waitcnt lgkmcnt(0)" ::: "memory")
#define MFMA16(a, b, c) __builtin_amdgcn_mfma_f32_16x16x32_bf16((a), (b), (c), 0, 0, 0)

__device__ __forceinline__ int next_task(int* counter, int* slot) {
  __syncthreads();
  if (threadIdx.x == 0) *slot = atomicAdd(counter, 1);
  __syncthreads();
  return *slot;
}

__device__ __forceinline__ void transpose_tile(const float* W, int K, int N, bf16_t* WT, const float* sc0, const float* sc1, int tile, float* tl) {
  const int tid = opaque_tid();
  const int nkb = K / 64, kb = tile % nkb, nb = tile / nkb, k0 = kb * 64, n0 = nb * 64;
#pragma unroll
  for (int i = 0; i < 4; ++i) {
    const int idx = tid + i * 256, kk = idx >> 4, n4 = (idx & 15) * 4, k = k0 + kk, n = n0 + n4;
    f32x4 v = {0.f, 0.f, 0.f, 0.f};
    if (n < N) { v = *(const f32x4*)(W + (size_t)k * N + n); if (sc0) v *= (k < 2048 ? sc0[k] : sc1[k - 2048]); }
    tl[(n4 + 0) * 65 + kk] = v.x; tl[(n4 + 1) * 65 + kk] = v.y; tl[(n4 + 2) * 65 + kk] = v.z; tl[(n4 + 3) * 65 + kk] = v.w;
  }
  __syncthreads();
  {
    const int n = tid >> 2, kc = (tid & 3) * 16;
    const float* s = tl + n * 65 + kc;
    u32x4 o0, o1;
    o0.x = pk2(s[0], s[1]); o0.y = pk2(s[2], s[3]); o0.z = pk2(s[4], s[5]); o0.w = pk2(s[6], s[7]);
    o1.x = pk2(s[8], s[9]); o1.y = pk2(s[10], s[11]); o1.z = pk2(s[12], s[13]); o1.w = pk2(s[14], s[15]);
    u32x4* dst = (u32x4*)(WT + (size_t)(n0 + n) * K + k0 + kc);
    dst[0] = o0; dst[1] = o1;
  }
  __syncthreads();
}

__device__ __forceinline__ void sincos_own(float ang, float& s, float& c) {
  const float k = rintf(ang * 0.15915494309189535f);
  float r = fmaf(-k, 6.28125f, ang); r = fmaf(-k, 1.9353071795864769e-3f, r);
  const float r2 = r * r;
  float ps = -1.f / 121645100408832000.f;
  ps = fmaf(ps, r2, 1.f / 355687428096000.f);
  ps = fmaf(ps, r2, -1.f / 1307674368000.f);
  ps = fmaf(ps, r2, 1.f / 6227020800.f);
  ps = fmaf(ps, r2, -1.f / 39916800.f);
  ps = fmaf(ps, r2, 1.f / 362880.f);
  ps = fmaf(ps, r2, -1.f / 5040.f);
  ps = fmaf(ps, r2, 1.f / 120.f);
  ps = fmaf(ps, r2, -1.f / 6.f);
  s = fmaf(ps * r2, r, r);
  float pc = 1.f / 2432902008176640000.f;
  pc = fmaf(pc, r2, -1.f / 6402373705728000.f);
  pc = fmaf(pc, r2, 1.f / 20922789888000.f);
  pc = fmaf(pc, r2, -1.f / 87178291200.f);
  pc = fmaf(pc, r2, 1.f / 479001600.f);
  pc = fmaf(pc, r2, -1.f / 3628800.f);
  pc = fmaf(pc, r2, 1.f / 40320.f);
  pc = fmaf(pc, r2, -1.f / 720.f);
  pc = fmaf(pc, r2, 1.f / 24.f);
  pc = fmaf(pc, r2, -0.5f);
  c = fmaf(pc, r2, 1.f);
}

__device__ __forceinline__ void s5_precompute(const Params& P, int l, int g, float* tl) {
  const int tid = opaque_tid();
  float* gre = tl; float* gim = tl + 64;
  if (tid < 64) {
    const int idx = (l * NG + g) * NP + tid;
    const float lr = fminf(P.lam_re[idx], -1e-4f), li = P.lam_im[idx];
    const float step = expf(P.log_step[l * NG + g]);
    const float mag = expf(lr * step);
    float sn, cs; sincos_own(li * step, sn, cs);
    const float abr = mag * cs, abi = mag * sn;
    const float den = lr * lr + li * li, nr = abr - 1.f;
    gre[tid] = (nr * lr + abi * li) / den;
    gim[tid] = (abi * lr - nr * li) / den;
    float* ab = (float*)(P.ws + WS_AB);
    ab[idx] = abr; ab[2 * NG * NP + idx] = abi;
  }
  __syncthreads();
  bf16_t* bbf = (bf16_t*)(P.ws + WS_BBF) + (size_t)(l * NG + g) * 8 * 64 * 8;
  const float* br = P.b_re + (size_t)(l * NG + g) * NP * NCH;
  const float* bi = P.b_im + (size_t)(l * NG + g) * NP * NCH;
  for (int j = 0; j < 16; ++j) {
    const int idx = tid * 16 + j, tile = idx >> 9, lane = (idx >> 3) & 63, e = idx & 7;
    const int pt = tile >> 1, part = tile & 1, p = pt * 16 + (lane & 15), q = lane >> 4, c = q * 8 + e;
    float v = 0.f;
    if (q < 2) { const float a = br[p * NCH + c], b = bi[p * NCH + c]; v = part == 0 ? gre[p] * a - gim[p] * b : gre[p] * b + gim[p] * a; }
    bbf[idx] = (bf16_t)(pk2(v, 0.f) & 0xffff);
  }
  bf16_t* ccf = (bf16_t*)(P.ws + WS_CCF) + (size_t)(l * NG + g) * 4 * 64 * 8;
  const float* cr = P.c_re + (size_t)(l * NG + g) * NCH * NP;
  const float* ci = P.c_im + (size_t)(l * NG + g) * NCH * NP;
  for (int j = 0; j < 8; ++j) {
    const int idx = tid * 8 + j, ks = idx >> 9, lane = (idx >> 3) & 63, e = idx & 7;
    const int c = lane & 15, q = lane >> 4, k = ks * 32 + q * 8 + e, p = k >> 1, part = k & 1;
    const float v = part == 0 ? cr[c * NP + p] : -ci[c * NP + p];
    ccf[idx] = (bf16_t)(pk2(v, 0.f) & 0xffff);
  }
  __syncthreads();
}

constexpr int TW_WIN = 2 * 32 * (NPAD / 64), TW_GLU = 2 * 32 * 32, TW_OUT = 2 * 64 * 32, TW_ALL = TW_WIN + TW_GLU + TW_OUT;
__device__ __forceinline__ void weight_tile_task(const Params& P, int r, float* tl) {
  if (r < TW_WIN) { const int per = 32 * (NPAD / 64), l = r / per; transpose_tile(P.w_in + (size_t)l * DM * INC, DM, INC, (bf16_t*)(P.ws + WS_WIN) + (size_t)l * NPAD * DM, P.norm_w + l * DM, P.norm_w + l * DM, r % per, tl); return; }
  r -= TW_WIN;
  if (r < TW_GLU) { const int per = 32 * 32, l = r / per; transpose_tile(P.glu_w + (size_t)l * 2048 * 2048, 2048, 2048, (bf16_t*)(P.ws + WS_WGLU) + (size_t)l * 2048 * 2048, nullptr, nullptr, r % per, tl); return; }
  r -= TW_GLU;
  { const int per = 64 * 32, l = r / per; transpose_tile(P.w_out + (size_t)l * 4096 * 2048, 4096, 2048, (bf16_t*)(P.ws + WS_WOUT) + (size_t)l * 2048 * 4096, P.s5_norm_w + l * 2048, P.ssd_norm_w + l * 2048, r % per, tl); }
}
__device__ __forceinline__ void deferred_weights(const Params& P, unsigned char* lds) {
  float* tl = (float*)(lds + 64);
  const int grid = gridDim.x, slots = grid >> 3, q = (blockIdx.x & 7) * slots + (blockIdx.x >> 3);
  const int leftover = (34 * 81) % grid;
  int rank = q, n = grid;
  if (leftover != 0) { if (q < leftover) return; rank = q - leftover; n = grid - leftover; }
  __syncthreads();
  for (int r = 32 * (NPAD / 64) + rank; r < TW_ALL; r += n) weight_tile_task(P, r, tl);
}

__device__ __forceinline__ void phase_prep(const Params& P, unsigned char* lds) {
  float* tl = (float*)(lds + 64);
  const int tid = opaque_tid(), lane = tid & 63, wave = tid >> 6;
  {
    float* ss = (float*)(P.ws + WS_SS);
    for (int i = blockIdx.x * 256 + tid; i < 8 * MT; i += gridDim.x * 256) ss[MT + i] = 0.f;
    if (blockIdx.x == 0 && tid < 64) ((int*)(P.ws + WS_CNT))[tid] = 0;
    if (blockIdx.x == 1) for (int i = tid; i < 2 * 3 * 34 * 16; i += 256) ((int*)(P.ws + WS_FLG))[i] = 0;
  }
  constexpr int T_W0 = 32 * (NPAD / 64), T_X = MT / 4, T_S5 = 2 * NG;
  constexpr int T_ALL = T_W0 + T_X + T_S5;
  for (int t = blockIdx.x; t < T_ALL; t += gridDim.x) {
    int r = t;
    if (r < T_W0) { weight_tile_task(P, r, tl); continue; }
    r -= T_W0;
    if (r < T_X) {
      const int row = r * 4 + wave;
      const float* src = row < MP ? P.x_prompt + (size_t)row * DM : P.x_sample + (size_t)(row - MP) * DM;
      bf16_t* dst = (bf16_t*)(P.ws + WS_XB) + (size_t)row * DM;
      float s = 0.f;
#pragma unroll
      for (int j = 0; j < 8; ++j) {
        const f32x4 v = *(const f32x4*)(src + (j * 64 + lane) * 4);
        s += v.x * v.x + v.y * v.y + v.z * v.z + v.w * v.w;
        u32x2 o; o.x = pk2(v.x, v.y); o.y = pk2(v.z, v.w);
        *(u32x2*)(dst + (j * 64 + lane) * 4) = o;
      }
      s = wave_sum(s);
      if (lane == 0) ((float*)(P.ws + WS_SS))[row] = s;
      continue;
    }
    r -= T_X;
    s5_precompute(P, r / NG, r % NG, tl);
  }
}

constexpr int G_IN = 0, G_GLU = 1, G_OUT = 2;

__device__ __forceinline__ bool gemm_unit_of(int v, int NT, int& pm, int& pn) {
  const int total = 34 * NT;
  if (v >= total) return false;
  const int ng = NT >> 3, rem = NT & 7;
  if (v < ng * 272) { const int pg = v / 272, w = v % 272; pm = w >> 3; pn = pg * 8 + (w & 7); }
  else { const int w = v - ng * 272; pm = w / rem; pn = ng * 8 + w % rem; }
  return true;
}

template <int MODE>
__device__ __forceinline__ void gemm_unit(const Params& P, int l, int pm, int pn, unsigned char* lds, int dummy) {
  constexpr int K = MODE == G_OUT ? 4096 : 2048;
  constexpr int NK = K / 32;
  const bf16_t* A = MODE == G_IN ? (const bf16_t*)(P.ws + WS_XB) : MODE == G_GLU ? (const bf16_t*)(P.ws + WS_G) : (const bf16_t*)(P.ws + WS_ACT);
  const bf16_t* Bt = MODE == G_IN ? (const bf16_t*)(P.ws + WS_WIN) + (size_t)l * NPAD * DM
                   : MODE == G_GLU ? (const bf16_t*)(P.ws + WS_WGLU) + (size_t)l * 2048 * 2048
                                   : (const bf16_t*)(P.ws + WS_WOUT) + (size_t)l * 2048 * 4096;
  const int tid = opaque_tid(), lane = tid & 63, wave = tid >> 6, wr = wave >> 1, wc = wave & 1, fr = lane & 15, fq = lane >> 4;
  unsigned char* base = lds + 64;
  const int grow = tid >> 2, gch = (tid & 3) ^ ((((tid >> 2) >> 3) & 1) << 1);
  const bf16_t* Ag = A + (size_t)(pm * 256 + grow) * K + gch * 8;
  const bf16_t* Bg = Bt + (size_t)(pn * 128 + grow) * K + gch * 8;
  const int swz = (fq ^ ((fr >> 3) << 1)) << 4;
  const int a_rd = (wr * 128 + fr) * 64 + swz;
  const int b_rd = 16384 + (wc * 64 + fr) * 64 + swz;

  f32x4 acc[8][4];
#pragma unroll
  for (int mi = 0; mi < 8; ++mi)
#pragma unroll
    for (int ni = 0; ni < 4; ++ni) acc[mi][ni] = (f32x4){0.f, 0.f, 0.f, 0.f};

  auto stage_tile = [&](int kt, unsigned char* st) __attribute__((always_inline)) {
#pragma unroll
    for (int i = 0; i < 4; ++i) __builtin_amdgcn_global_load_lds((const unsigned*)(Ag + (size_t)i * 64 * K + kt * 32), (unsigned*)(st + (tid + i * 256) * 16), 16, 0, 0);
#pragma unroll
    for (int i = 0; i < 2; ++i) __builtin_amdgcn_global_load_lds((const unsigned*)(Bg + (size_t)i * 64 * K + kt * 32), (unsigned*)(st + 16384 + (tid + i * 256) * 16), 16, 0, 0);
  };
  stage_tile(0, base);
  __syncthreads();

  for (int kt = 0; kt < NK; ++kt) {
    unsigned char* cur = base + (kt & 1) * 24576;
    unsigned char* nxt = base + ((kt & 1) ^ 1) * 24576;
    if (kt + 1 < NK) stage_tile(kt + 1, nxt);
    __builtin_amdgcn_sched_barrier(0);
    if (MODE == G_OUT && kt == NK / 2) {
      const float* ssa = (const float*)(P.ws + WS_SS) + (3 + l) * MT;
      const float* sss = (const float*)(P.ws + WS_SS) + (5 + l) * MT;
#pragma unroll
      for (int mi = 0; mi < 8; ++mi) {
        const int row = pm * 256 + wr * 128 + mi * 16 + fr;
        const float ra = rsqrtf(ssa[row] * (1.f / 2048.f) + EPS), rs = rsqrtf(sss[row] * (1.f / 2048.f) + EPS);
        const float ratio = ra / rs;
#pragma unroll
        for (int ni = 0; ni < 4; ++ni) acc[mi][ni] *= ratio;
      }
    }
    bf16x8 af[8], bfr[4];
#pragma unroll
    for (int mi = 0; mi < 8; ++mi) af[mi] = *(const bf16x8*)(cur + a_rd + mi * 1024);
#pragma unroll
    for (int ni = 0; ni < 4; ++ni) bfr[ni] = *(const bf16x8*)(cur + b_rd + ni * 1024);
    __builtin_amdgcn_s_setprio(1);
#pragma unroll
    for (int mi = 0; mi < 8; ++mi)
#pragma unroll
      for (int ni = 0; ni < 4; ++ni) acc[mi][ni] = MFMA16(bfr[ni], af[mi], acc[mi][ni]);
    __builtin_amdgcn_s_setprio(0);
    __syncthreads();
  }

  const int row0 = pm * 256 + wr * 128 + fr, col0 = pn * 128 + wc * 64 + fq * 4;
  if (MODE == G_IN) {
    const float* ssx = (const float*)(P.ws + WS_SS) + l * MT;
    bf16_t* proj = (bf16_t*)(P.ws + WS_PROJ);
    float* dtv = (float*)(P.ws + WS_DTV);
    const bool wt = dummy == 4 && pn >= 32 && pn < 64;
#pragma unroll
    for (int mi = 0; mi < 8; ++mi) {
      const int row = row0 + mi * 16;
      const float rs = rsqrtf(ssx[row] * (1.f / 2048.f) + EPS);
#pragma unroll
      for (int ni = 0; ni < 4; ++ni) {
        const f32x4 v = acc[mi][ni] * rs;
        const int col = col0 + ni * 16;
        if (pn < 80) {
          u32x2 o; o.x = pk2(v.x, v.y); o.y = pk2(v.z, v.w);
          if (wt) st_wt8(proj + (size_t)row * NPROJ + col, o); else *(u32x2*)(proj + (size_t)row * NPROJ + col) = o;
        } else if (col < NPROJ + 32) {
          const f32x4 bb = *(const f32x4*)(P.dt_bias + l * NH + (col - NPROJ));
          f32x4 x = v + bb, o;
          o.x = fmaxf(x.x, 0.f) + log1pf(__expf(-fabsf(x.x))); o.y = fmaxf(x.y, 0.f) + log1pf(__expf(-fabsf(x.y)));
          o.z = fmaxf(x.z, 0.f) + log1pf(__expf(-fabsf(x.z))); o.w = fmaxf(x.w, 0.f) + log1pf(__expf(-fabsf(x.w)));
          *(f32x4*)(dtv + (size_t)row * 32 + (col - NPROJ)) = o;
        }
      }
    }
  } else if (MODE == G_GLU) {
    const bf16_t* gbuf = (const bf16_t*)(P.ws + WS_G);
    const bf16_t* proj = (const bf16_t*)(P.ws + WS_PROJ);
    bf16_t* act = (bf16_t*)(P.ws + WS_ACT);
    float* ssa = (float*)(P.ws + WS_SS) + (dummy ? 7 : 3 + l) * MT;
    const float* gb_ = P.glu_b + l * 2048;
#pragma unroll
    for (int mi = 0; mi < 8; ++mi) {
      const int row = row0 + mi * 16;
      float ss = 0.f;
#pragma unroll
      for (int ni = 0; ni < 4; ++ni) {
        const int col = col0 + ni * 16;
        const f32x4 bv = *(const f32x4*)(gb_ + col);
        const u32x2 gw = *(const u32x2*)(gbuf + (size_t)row * 2048 + col);
        const u32x2 zw = *(const u32x2*)(proj + (size_t)row * NPROJ + 2048 + col);
        const f32x4 a = acc[mi][ni] + bv;
        const float v0 = bflo(gw.x) * sigmoidf_(a.x) * siluf_(bflo(zw.x));
        const float v1 = bfhi(gw.x) * sigmoidf_(a.y) * siluf_(bfhi(zw.x));
        const float v2 = bflo(gw.y) * sigmoidf_(a.z) * siluf_(bflo(zw.y));
        const float v3 = bfhi(gw.y) * sigmoidf_(a.w) * siluf_(bfhi(zw.y));
        ss += v0 * v0 + v1 * v1 + v2 * v2 + v3 * v3;
        u32x2 o; o.x = pk2(v0, v1); o.y = pk2(v2, v3);
        st_wt8(act + (size_t)row * 4096 + col, o);
      }
      ss += __shfl_xor(ss, 16); ss += __shfl_xor(ss, 32);
      if (fq == 0) atomicAdd(ssa + row, ss);
    }
  } else {
    const float* sss = (const float*)(P.ws + WS_SS) + (5 + l) * MT;
    float* ssx = (float*)(P.ws + WS_SS) + (l + 1) * MT;
    float* xres = (float*)(P.ws + WS_XRES);
    bf16_t* xb = (bf16_t*)(P.ws + WS_XB);
#pragma unroll
    for (int mi = 0; mi < 8; ++mi) {
      const int row = row0 + mi * 16;
      const float rs = rsqrtf(sss[row] * (1.f / 2048.f) + EPS);
      const float* xold = l == 0 ? (row < MP ? P.x_prompt + (size_t)row * DM : P.x_sample + (size_t)(row - MP) * DM) : xres + (size_t)row * DM;
      float ss = 0.f;
#pragma unroll
      for (int ni = 0; ni < 4; ++ni) {
        const int col = col0 + ni * 16;
        const f32x4 xo = *(const f32x4*)(xold + col);
        const f32x4 v = xo + acc[mi][ni] * rs;
        ss += v.x * v.x + v.y * v.y + v.z * v.z + v.w * v.w;
        st_wt8(xres + (size_t)row * DM + col, (u32x2){__float_as_uint(v.x), __float_as_uint(v.y)});
        st_wt8(xres + (size_t)row * DM + col + 2, (u32x2){__float_as_uint(v.z), __float_as_uint(v.w)});
        u32x2 o; o.x = pk2(v.x, v.y); o.y = pk2(v.z, v.w);
        st_wt8(xb + (size_t)row * DM + col, o);
      }
      ss += __shfl_xor(ss, 16); ss += __shfl_xor(ss, 32);
      if (fq == 0) atomicAdd(ssx + row, ss);
    }
  }
}

__device__ __forceinline__ int* panel_flag(const Params& P, int l, int kind, int pm);
__device__ __forceinline__ void panel_signal(int* flag);
template <int MODE>
__device__ __forceinline__ void phase_gemm(const Params& P, int l, unsigned char* lds, int dummy = 0) {
  constexpr int NT = MODE == G_IN ? 81 : 16;
  const int slots = gridDim.x >> 3, xcd = blockIdx.x & 7, slot = blockIdx.x >> 3;
  for (int i = 0;; ++i) {
    const int v = (i * 8 + xcd) * slots + slot;
    int pm, pn;
    if (!gemm_unit_of(v, NT, pm, pn)) break;
    gemm_unit<MODE>(P, l, pm, pn, lds, dummy);
    if (MODE == G_IN && dummy == 4 && pn >= 32 && pn < 64) panel_signal(panel_flag(P, 1, 2, pm));
  }
}


__device__ __forceinline__ int* panel_flag(const Params& P, int l, int kind, int pm) { return (int*)(P.ws + WS_FLG) + ((l * 3 + kind) * 34 + pm) * 16; }
__device__ __forceinline__ void panel_wait(int* flag, int need) {
  if (threadIdx.x == 0) { while (__hip_atomic_load(flag, __ATOMIC_RELAXED, __HIP_MEMORY_SCOPE_AGENT) < need) __builtin_amdgcn_s_sleep(4); }
  __syncthreads();
  asm volatile("" ::: "memory");
}
__device__ __forceinline__ void panel_signal(int* flag) {
  asm volatile("s_waitcnt vmcnt(0)" ::: "memory");
  __syncthreads();
  if (threadIdx.x == 0) __hip_atomic_fetch_add(flag, 1, __ATOMIC_RELAXED, __HIP_MEMORY_SCOPE_AGENT);
}
__device__ __forceinline__ void phase_chain(const Params& P, int l, unsigned char* lds) {
  const int nGLU = 34 * 16, nOUT = 34 * 16, nIN = l == 0 ? 34 * 81 : 0, total = nGLU + nOUT + nIN;
  const int slots = gridDim.x >> 3, xcd = blockIdx.x & 7, slot = blockIdx.x >> 3;
  for (int i = 0;; ++i) {
    const int v = (i * 8 + xcd) * slots + slot;
    if (v >= total) break;
    int pm, pn;
    if (v < nGLU) {
      gemm_unit_of(v, 16, pm, pn);
      gemm_unit<G_GLU>(P, l, pm, pn, lds, 0);
      panel_signal(panel_flag(P, l, 0, pm));
    } else if (v < nGLU + nOUT) {
      gemm_unit_of(v - nGLU, 16, pm, pn);
      panel_wait(panel_flag(P, l, 0, pm), 16);
      gemm_unit<G_OUT>(P, l, pm, pn, lds, 0);
      panel_signal(panel_flag(P, l, 1, pm));
    } else {
      gemm_unit_of(v - nGLU - nOUT, 81, pm, pn);
      panel_wait(panel_flag(P, l, 1, pm), 16);
      gemm_unit<G_IN>(P, l + 1, pm, pn, lds, 4);
      if (pn >= 32 && pn < 64) panel_signal(panel_flag(P, l, 2, pm));
    }
  }
}

__device__ __forceinline__ void conv8(const u32x4* r, int i, const f32x4* w, const f32x4* bias, float* o) {
#pragma unroll
  for (int hf = 0; hf < 2; ++hf) {
    f32x4 a = bias[hf];
#pragma unroll
    for (int k = 0; k < 4; ++k) {
      const u32x4 rv = r[i + k];
      const unsigned w0 = hf == 0 ? rv.x : rv.z, w1 = hf == 0 ? rv.y : rv.w;
      const f32x4 wk = w[k * 2 + hf];
      a.x = fmaf(wk.x, bflo(w0), a.x); a.y = fmaf(wk.y, bfhi(w0), a.y);
      a.z = fmaf(wk.z, bflo(w1), a.z); a.w = fmaf(wk.w, bfhi(w1), a.w);
    }
    o[hf * 4 + 0] = siluf_(a.x); o[hf * 4 + 1] = siluf_(a.y); o[hf * 4 + 2] = siluf_(a.z); o[hf * 4 + 3] = siluf_(a.w);
  }
}
__device__ __forceinline__ void store8f(float* dst, u32x4 v) {
  *(f32x4*)dst = (f32x4){bflo(v.x), bfhi(v.x), bflo(v.y), bfhi(v.y)};
  *(f32x4*)(dst + 4) = (f32x4){bflo(v.z), bfhi(v.z), bflo(v.w), bfhi(v.w)};
}

__device__ __forceinline__ void phase_conv(const Params& P, int l, int gated, unsigned char* lds) {
  const int tid = opaque_tid();
  const bf16_t* proj = (const bf16_t*)(P.ws + WS_PROJ);
  bf16_t* xc = (bf16_t*)(P.ws + WS_XC);
  const float* cw = P.conv_w + (size_t)l * 4 * CONVD;
  const float* cb = P.conv_b + (size_t)l * CONVD;
  auto prompt_item = [&](int it) __attribute__((always_inline)) {
    const int ch0 = (it & 511) * 8, row0 = (it >> 9) * 8, t0 = row0 & (SEQ - 1);
    if (gated) {
      panel_wait(panel_flag(P, 1 - l, 2, row0 >> 8), 32);
      if (t0 > 0 && (row0 & 255) == 0) panel_wait(panel_flag(P, 1 - l, 2, (row0 >> 8) - 1), 32);
    }
    u32x4 r[11];
#pragma unroll
    for (int j = 0; j < 11; ++j) {
      r[j] = (u32x4){0u, 0u, 0u, 0u};
      if (t0 - 3 + j >= 0) r[j] = *(const u32x4*)(proj + (size_t)(row0 - 3 + j) * NPROJ + 4096 + ch0);
    }
    f32x4 w[8], bias[2];
#pragma unroll
    for (int k = 0; k < 4; ++k) { w[k * 2] = *(const f32x4*)(cw + k * CONVD + ch0); w[k * 2 + 1] = *(const f32x4*)(cw + k * CONVD + ch0 + 4); }
    bias[0] = *(const f32x4*)(cb + ch0); bias[1] = *(const f32x4*)(cb + ch0 + 4);
#pragma unroll
    for (int i = 0; i < 8; ++i) {
      float o[8]; conv8(r, i, w, bias, o);
      u32x4 q; q.x = pk2(o[0], o[1]); q.y = pk2(o[2], o[3]); q.z = pk2(o[4], o[5]); q.w = pk2(o[6], o[7]);
      *(u32x4*)(xc + (size_t)(row0 + i) * CONVD + ch0) = q;
    }
    if (t0 == SEQ - 8) {
      const int bb = row0 >> 11;
#pragma unroll
      for (int j = 0; j < 3; ++j) store8f(P.out + O_CONVP + ((size_t)(l * NB + bb) * 3 + j) * CONVD + ch0, r[8 + j]);
    }
  };
  auto sample_item = [&](int it) __attribute__((always_inline)) {
    const int ch0 = (it & 511) * 8, bb = it >> 9, row0 = MP + bb * 4;
    if (gated) panel_wait(panel_flag(P, 1 - l, 2, row0 >> 8), 32);
    u32x4 r[7];
#pragma unroll
    for (int j = 0; j < 3; ++j) {
      const float* cp = P.cache_conv + ((size_t)(l * DB + bb) * 3 + j) * CONVD + ch0;
      const f32x4 c0 = *(const f32x4*)cp, c1 = *(const f32x4*)(cp + 4);
      r[j].x = pk2(c0.x, c0.y); r[j].y = pk2(c0.z, c0.w); r[j].z = pk2(c1.x, c1.y); r[j].w = pk2(c1.z, c1.w);
    }
#pragma unroll
    for (int j = 0; j < 4; ++j) r[3 + j] = *(const u32x4*)(proj + (size_t)(row0 + j) * NPROJ + 4096 + ch0);
    f32x4 w[8], bias[2];
#pragma unroll
    for (int k = 0; k < 4; ++k) { w[k * 2] = *(const f32x4*)(cw + k * CONVD + ch0); w[k * 2 + 1] = *(const f32x4*)(cw + k * CONVD + ch0 + 4); }
    bias[0] = *(const f32x4*)(cb + ch0); bias[1] = *(const f32x4*)(cb + ch0 + 4);
#pragma unroll
    for (int i = 0; i < 4; ++i) {
      float o[8]; conv8(r, i, w, bias, o);
      u32x4 q; q.x = pk2(o[0], o[1]); q.y = pk2(o[2], o[3]); q.z = pk2(o[4], o[5]); q.w = pk2(o[6], o[7]);
      *(u32x4*)(xc + (size_t)(row0 + i) * CONVD + ch0) = q;
    }
#pragma unroll
    for (int j = 0; j < 3; ++j) store8f(P.out + O_CONVS + ((size_t)(l * DB + bb) * 3 + j) * CONVD + ch0, r[4 + j]);
  };
  constexpr int NBP = (MP / 8) * 512 / 256, NBS = DB * 512 / 256;
  int* counter = (int*)(P.ws + WS_CNT) + 16 + l;
  int* slot = (int*)lds;
  for (;;) {
    const int t = next_task(counter, slot);
    if (t >= NBP + NBS) break;
    if (t < NBP) prompt_item(t * 256 + tid); else sample_item((t - NBP) * 256 + tid);
  }
}

template <int MODE>
__device__ __forceinline__ void s5_wave(const Params& P, int l, int g, int rowbase, int nchunks, unsigned char* wl, float& hr, float& hi,
                                        const bf16x8 (&bbf)[8], const bf16x8 (&ccf)[4], float ar, float ai) {
  const int lane = opaque_tid() & 63, fr = lane & 15, fq = lane >> 4;
  unsigned char* bu = wl; unsigned char* Hb = wl + 8192;
  const bf16_t* proj = (const bf16_t*)(P.ws + WS_PROJ);
  bf16_t* gbuf = (bf16_t*)(P.ws + WS_G);
  f32x4 dv = {0.f, 0.f, 0.f, 0.f};
  if (MODE != 0) dv = *(const f32x4*)(P.s5_d + l * WA + g * NCH + fq * 4);
  const bf16x8 zero8 = {0, 0, 0, 0, 0, 0, 0, 0};
  bf16x8 uf = zero8;
  if (fq < 2) uf = *(const bf16x8*)(proj + (size_t)(rowbase + fr) * NPROJ + g * NCH + fq * 8);
#pragma unroll 1
  for (int c = 0; c < nchunks; ++c) {
    const int row0 = rowbase + c * 16;
    f32x4 t[8];
#pragma unroll
    for (int i = 0; i < 8; ++i) t[i] = MFMA16(uf, bbf[i], ((f32x4){0.f, 0.f, 0.f, 0.f}));
    u32x2 uw = {0u, 0u};
    if (MODE != 0) uw = *(const u32x2*)(proj + (size_t)(row0 + fr) * NPROJ + g * NCH + fq * 4);
    if (c + 1 < nchunks) { if (fq < 2) uf = *(const bf16x8*)(proj + (size_t)(row0 + 16 + fr) * NPROJ + g * NCH + fq * 8); }
#pragma unroll
    for (int pt = 0; pt < 4; ++pt)
#pragma unroll
      for (int r = 0; r < 4; ++r) {
        f32x2 v; v.x = t[2 * pt][r]; v.y = t[2 * pt + 1][r];
        *(f32x2*)(bu + (fq * 4 + r) * 512 + (pt * 16 + fr) * 8) = v;
      }
    LDS_FENCE();
#pragma unroll
    for (int tt = 0; tt < 16; ++tt) {
      if (MODE == 2 && (tt & 3) == 0) {
        const int b = ((row0 - MP) >> 2) + (tt >> 2);
        hr = P.st_s5_re[((size_t)(l * DB + b) * NG + g) * NP + lane];
        hi = P.st_s5_im[((size_t)(l * DB + b) * NG + g) * NP + lane];
      }
      const f32x2 bv = *(const f32x2*)(bu + tt * 512 + lane * 8);
      const float nr = fmaf(ar, hr, fmaf(-ai, hi, bv.x));
      const float ni = fmaf(ar, hi, fmaf(ai, hr, bv.y));
      hr = nr; hi = ni;
      if (MODE != 0) *(unsigned*)(Hb + tt * 272 + lane * 4) = pk2(hr, hi);
      if (MODE == 2 && (tt & 3) == 3) {
        const int b = ((row0 - MP) >> 2) + (tt >> 2);
        P.out[O_S5RS + ((size_t)(l * DB + b) * NG + g) * NP + lane] = hr;
        P.out[O_S5IS + ((size_t)(l * DB + b) * NG + g) * NP + lane] = hi;
      }
    }
    LDS_FENCE();
    if (MODE != 0) {
      f32x4 y = {0.f, 0.f, 0.f, 0.f};
#pragma unroll
      for (int ks = 0; ks < 4; ++ks) {
        const bf16x8 hf = *(const bf16x8*)(Hb + fr * 272 + ks * 64 + fq * 16);
        y = MFMA16(ccf[ks], hf, y);
      }
      LDS_FENCE();
      const float y0 = gelu_tanh(y.x + dv.x * bflo(uw.x)), y1 = gelu_tanh(y.y + dv.y * bfhi(uw.x));
      const float y2 = gelu_tanh(y.z + dv.z * bflo(uw.y)), y3 = gelu_tanh(y.w + dv.w * bfhi(uw.y));
      u32x2 o; o.x = pk2(y0, y1); o.y = pk2(y2, y3);
      *(u32x2*)(gbuf + (size_t)(row0 + fr) * 2048 + g * NCH + fq * 4) = o;
    }
  }
}

constexpr int L_S5X = 64 + 4 * 12544;
template <bool SAMPLE>
__device__ __forceinline__ void s5_block_task(const Params& P, int l, int g, int b, unsigned char* lds) {
  const int tid = opaque_tid(), lane = tid & 63, wave = tid >> 6;
  const bf16x8* bbp = (const bf16x8*)((const bf16_t*)(P.ws + WS_BBF) + (size_t)(l * NG + g) * 8 * 64 * 8);
  const bf16x8* ccp = (const bf16x8*)((const bf16_t*)(P.ws + WS_CCF) + (size_t)(l * NG + g) * 4 * 64 * 8);
  bf16x8 bbf[8], ccf[4];
#pragma unroll
  for (int i = 0; i < 8; ++i) bbf[i] = bbp[i * 64 + lane];
#pragma unroll
  for (int i = 0; i < 4; ++i) ccf[i] = ccp[i * 64 + lane];
  const float* ab = (const float*)(P.ws + WS_AB);
  const float ar = ab[(l * NG + g) * NP + lane], ai = ab[2 * NG * NP + (l * NG + g) * NP + lane];
  unsigned char* wl = lds + 64 + wave * 12544;
  float hr = 0.f, hi = 0.f;
  if (SAMPLE) {
    s5_wave<2>(P, l, g, MP + wave * 128, 8, wl, hr, hi, bbf, ccf, ar, ai);
  } else {
    const int rowbase = b * SEQ + (wave < 3 ? wave * 448 : 1344), nch = wave < 3 ? 28 : 44;
    if (wave < 3) s5_wave<0>(P, l, g, rowbase, 28, wl, hr, hi, bbf, ccf, ar, ai);
    f32x2* xch = (f32x2*)(lds + L_S5X);
    xch[wave * 64 + lane] = (f32x2){hr, hi};
    float pr = ar, pi = ai;
#pragma unroll
    for (int i = 0; i < 6; ++i) { const float nr = pr * pr - pi * pi, ni = 2.f * pr * pi; pr = nr; pi = ni; }
    const float q64r = pr, q64i = pi;
    { const float nr = pr * pr - pi * pi, ni = 2.f * pr * pi; pr = nr; pi = ni; }
    const float q128r = pr, q128i = pi;
    { const float nr = pr * pr - pi * pi, ni = 2.f * pr * pi; pr = nr; pi = ni; }
    { const float tr = pr * q128r - pi * q128i, ti = pr * q128i + pi * q128r; pr = tr * q64r - ti * q64i; pi = tr * q64i + ti * q64r; }
    __syncthreads();
    hr = 0.f; hi = 0.f;
    for (int j = 0; j < wave; ++j) {
      const f32x2 e = xch[j * 64 + lane];
      const float nr = fmaf(pr, hr, fmaf(-pi, hi, e.x)), ni = fmaf(pr, hi, fmaf(pi, hr, e.y));
      hr = nr; hi = ni;
    }
    s5_wave<1>(P, l, g, rowbase, nch, wl, hr, hi, bbf, ccf, ar, ai);
    if (wave == 3) {
      P.out[O_S5RP + ((size_t)(l * NB + b) * NG + g) * NP + lane] = hr;
      P.out[O_S5IP + ((size_t)(l * NB + b) * NG + g) * NP + lane] = hi;
    }
  }
}

constexpr int L_CN = 64, L_BN = L_CN + 17408, L_BT = L_BN + 17408, L_XT = L_BT + 18432, L_MM = L_XT + 9216, L_DT = L_MM + 9216, L_CS = L_DT + 256;

__device__ __forceinline__ void ssd_prompt_task(const Params& P, int l, int b, int h, unsigned char* lds, int dummy, int c1, int cfull) {
  const int tid = opaque_tid(), lane = tid & 63, wave = tid >> 6, fr = lane & 15, fq = lane >> 4;
  const int gi = h >> 2, pw = wave * 16;
  const bf16_t* proj = (const bf16_t*)(P.ws + WS_PROJ);
  const bf16_t* xc = (const bf16_t*)(P.ws + WS_XC);
  const float* dtvb = (const float*)(P.ws + WS_DTV);
  bf16_t* act = (bf16_t*)(P.ws + WS_ACT);
  float* sss = (float*)(P.ws + WS_SS) + (dummy ? 8 : 5 + l) * MT;
  const float a_h = -expf(P.a_log[l * NH + h]), dsk = P.ssd_d[l * NH + h];
  f32x4 S[8];
#pragma unroll
  for (int i = 0; i < 8; ++i) S[i] = (f32x4){0.f, 0.f, 0.f, 0.f};
  const int crow = tid >> 4, cch = tid & 15;
  u32x4 pc[4], pb[4], px[2]; float pdt;
  {
    const bf16_t* base = xc + (size_t)(b * SEQ) * CONVD;
#pragma unroll
    for (int i = 0; i < 4; ++i) { pc[i] = (u32x4){0u, 0u, 0u, 0u}; if (cfull == 0) pc[i] = *(const u32x4*)(base + (size_t)(i * 16 + crow) * CONVD + 3072 + gi * 128 + cch * 8); }
#pragma unroll
    for (int i = 0; i < 2; ++i) {
      pb[i * 2] = *(const u32x4*)(base + (size_t)((i * 16 + crow) * 2) * CONVD + 2048 + gi * 128 + cch * 8);
      pb[i * 2 + 1] = *(const u32x4*)(base + (size_t)((i * 16 + crow) * 2 + 1) * CONVD + 2048 + gi * 128 + cch * 8);
    }
    px[0] = *(const u32x4*)(base + (size_t)((tid >> 3) * 2) * CONVD + h * 64 + (tid & 7) * 8);
    px[1] = *(const u32x4*)(base + (size_t)((tid >> 3) * 2 + 1) * CONVD + h * 64 + (tid & 7) * 8);
    pdt = dtvb[(size_t)(b * SEQ + lane) * 32 + h];
  }
#pragma unroll 1
  for (int c = 0; c < c1; ++c) {
    const int rowc = b * SEQ + c * 64;
    const bool full = c >= cfull;
    float* DTs = (float*)(lds + L_DT + (c & 1) * 512); float* CSs = DTs + 64;
    {
      float cs = pdt * a_h;
#pragma unroll
      for (int o = 1; o < 64; o <<= 1) { const float v = __shfl_up(cs, o); if (lane >= o) cs += v; }
      if (wave == 0) { DTs[lane] = pdt; CSs[lane] = cs; }
    }
    __syncthreads();
    const float cs_end = CSs[63];
    {
      if (full) {
#pragma unroll
        for (int i = 0; i < 4; ++i) *(u32x4*)(lds + L_CN + (i * 16 + crow) * 272 + cch * 16) = pc[i];
      }
#pragma unroll
      for (int i = 0; i < 2; ++i) {
        const int t0 = (i * 16 + crow) * 2;
        const u32x4 v0 = pb[i * 2], v1 = pb[i * 2 + 1];
        if (full) {
          *(u32x4*)(lds + L_BN + t0 * 272 + cch * 16) = v0;
          *(u32x4*)(lds + L_BN + (t0 + 1) * 272 + cch * 16) = v1;
        }
        const float d0 = __expf(cs_end - CSs[t0]) * DTs[t0], d1 = __expf(cs_end - CSs[t0 + 1]) * DTs[t0 + 1];
        unsigned char* bt = lds + L_BT + (cch * 8) * 144 + t0 * 2;
        *(unsigned*)(bt + 0 * 144) = pk2(bflo(v0.x) * d0, bflo(v1.x) * d1);
        *(unsigned*)(bt + 1 * 144) = pk2(bfhi(v0.x) * d0, bfhi(v1.x) * d1);
        *(unsigned*)(bt + 2 * 144) = pk2(bflo(v0.y) * d0, bflo(v1.y) * d1);
        *(unsigned*)(bt + 3 * 144) = pk2(bfhi(v0.y) * d0, bfhi(v1.y) * d1);
        *(unsigned*)(bt + 4 * 144) = pk2(bflo(v0.z) * d0, bflo(v1.z) * d1);
        *(unsigned*)(bt + 5 * 144) = pk2(bfhi(v0.z) * d0, bfhi(v1.z) * d1);
        *(unsigned*)(bt + 6 * 144) = pk2(bflo(v0.w) * d0, bflo(v1.w) * d1);
        *(unsigned*)(bt + 7 * 144) = pk2(bfhi(v0.w) * d0, bfhi(v1.w) * d1);
      }
      {
        const u32x4 v0 = px[0], v1 = px[1];
        unsigned char* xt = lds + L_XT + ((tid & 7) * 8) * 144 + (tid >> 3) * 4;
        *(unsigned*)(xt + 0 * 144) = (v0.x & 0xffffu) | (v1.x << 16);
        *(unsigned*)(xt + 1 * 144) = (v0.x >> 16) | (v1.x & 0xffff0000u);
        *(unsigned*)(xt + 2 * 144) = (v0.y & 0xffffu) | (v1.y << 16);
        *(unsigned*)(xt + 3 * 144) = (v0.y >> 16) | (v1.y & 0xffff0000u);
        *(unsigned*)(xt + 4 * 144) = (v0.z & 0xffffu) | (v1.z << 16);
        *(unsigned*)(xt + 5 * 144) = (v0.z >> 16) | (v1.z & 0xffff0000u);
        *(unsigned*)(xt + 6 * 144) = (v0.w & 0xffffu) | (v1.w << 16);
        *(unsigned*)(xt + 7 * 144) = (v0.w >> 16) | (v1.w & 0xffff0000u);
      }
    }
    if (c + 1 < c1) {
      const bf16_t* base = xc + (size_t)(rowc + 64) * CONVD;
      if (c + 1 >= cfull) {
#pragma unroll
        for (int i = 0; i < 4; ++i) pc[i] = *(const u32x4*)(base + (size_t)(i * 16 + crow) * CONVD + 3072 + gi * 128 + cch * 8);
      }
#pragma unroll
      for (int i = 0; i < 2; ++i) {
        pb[i * 2] = *(const u32x4*)(base + (size_t)((i * 16 + crow) * 2) * CONVD + 2048 + gi * 128 + cch * 8);
        pb[i * 2 + 1] = *(const u32x4*)(base + (size_t)((i * 16 + crow) * 2 + 1) * CONVD + 2048 + gi * 128 + cch * 8);
      }
      px[0] = *(const u32x4*)(base + (size_t)((tid >> 3) * 2) * CONVD + h * 64 + (tid & 7) * 8);
      px[1] = *(const u32x4*)(base + (size_t)((tid >> 3) * 2 + 1) * CONVD + h * 64 + (tid & 7) * 8);
      pdt = dtvb[(size_t)(rowc + 64 + lane) * 32 + h];
    }
    __syncthreads();
    u32x2 zwv[4];
#pragma unroll
    for (int tt = 0; tt < 4; ++tt) { zwv[tt] = (u32x2){0u, 0u}; if (full) zwv[tt] = *(const u32x2*)(proj + (size_t)(rowc + tt * 16 + fr) * NPROJ + 8192 + h * 64 + pw + fq * 4); }
    if (full) {
      bf16x8 cf[4];
#pragma unroll
      for (int ks = 0; ks < 4; ++ks) cf[ks] = *(const bf16x8*)(lds + L_CN + (wave * 16 + fr) * 272 + ks * 64 + fq * 16);
      const int tcol = wave * 16 + fr; const float cst = CSs[tcol];
#pragma unroll
      for (int st = 0; st < 4; ++st) {
        f32x4 g = {0.f, 0.f, 0.f, 0.f};
#pragma unroll
        for (int ks = 0; ks < 4; ++ks) {
          const bf16x8 bf = *(const bf16x8*)(lds + L_BN + (st * 16 + fr) * 272 + ks * 64 + fq * 16);
          g = MFMA16(bf, cf[ks], g);
        }
        float m[4];
#pragma unroll
        for (int r = 0; r < 4; ++r) {
          const int s_ = st * 16 + fq * 4 + r;
          m[r] = s_ <= tcol ? g[r] * __expf(cst - CSs[s_]) * DTs[s_] : 0.f;
        }
        u32x2 o; o.x = pk2(m[0], m[1]); o.y = pk2(m[2], m[3]);
        *(u32x2*)(lds + L_MM + tcol * 144 + (st * 16 + fq * 4) * 2) = o;
      }
    }
    __syncthreads();
    {
      bf16x8 sf[4];
#pragma unroll
      for (int ks = 0; ks < 4; ++ks) {
        u32x4 v; v.x = pk2(S[2 * ks].x, S[2 * ks].y); v.y = pk2(S[2 * ks].z, S[2 * ks].w); v.z = pk2(S[2 * ks + 1].x, S[2 * ks + 1].y); v.w = pk2(S[2 * ks + 1].z, S[2 * ks + 1].w);
        sf[ks] = __builtin_bit_cast(bf16x8, v);
      }
      bf16x8 xf[2];
#pragma unroll
      for (int k2 = 0; k2 < 2; ++k2) xf[k2] = *(const bf16x8*)(lds + L_XT + (pw + fr) * 144 + k2 * 64 + fq * 16);
      if (full) {
#pragma unroll
      for (int tt = 0; tt < 4; ++tt) {
        const int t = tt * 16 + fr;
        f32x4 y = {0.f, 0.f, 0.f, 0.f};
#pragma unroll
        for (int ks = 0; ks < 4; ++ks) {
          const u32x2 c0 = *(const u32x2*)(lds + L_CN + t * 272 + ((2 * ks) * 16 + fq * 4) * 2);
          const u32x2 c1 = *(const u32x2*)(lds + L_CN + t * 272 + ((2 * ks + 1) * 16 + fq * 4) * 2);
          u32x4 cv; cv.x = c0.x; cv.y = c0.y; cv.z = c1.x; cv.w = c1.y;
          y = MFMA16(sf[ks], __builtin_bit_cast(bf16x8, cv), y);
        }
        y *= __expf(CSs[t]);
#pragma unroll
        for (int k2 = 0; k2 < 2; ++k2) {
          const bf16x8 mf = *(const bf16x8*)(lds + L_MM + t * 144 + k2 * 64 + fq * 16);
          y = MFMA16(xf[k2], mf, y);
        }
        const int row = rowc + t, pc_ = pw + fq * 4;
        const u32x2 zw = zwv[tt];
        const float x0 = bf1(*(const bf16_t*)(lds + L_XT + (pc_ + 0) * 144 + t * 2)), x1 = bf1(*(const bf16_t*)(lds + L_XT + (pc_ + 1) * 144 + t * 2));
        const float x2 = bf1(*(const bf16_t*)(lds + L_XT + (pc_ + 2) * 144 + t * 2)), x3 = bf1(*(const bf16_t*)(lds + L_XT + (pc_ + 3) * 144 + t * 2));
        const float v0 = (y.x + dsk * x0) * siluf_(bflo(zw.x)), v1 = (y.y + dsk * x1) * siluf_(bfhi(zw.x));
        const float v2 = (y.z + dsk * x2) * siluf_(bflo(zw.y)), v3 = (y.w + dsk * x3) * siluf_(bfhi(zw.y));
        u32x2 o; o.x = pk2(v0, v1); o.y = pk2(v2, v3);
        *(u32x2*)(act + (size_t)row * 4096 + 2048 + h * 64 + pc_) = o;
        float ss = v0 * v0 + v1 * v1 + v2 * v2 + v3 * v3;
        ss += __shfl_xor(ss, 16); ss += __shfl_xor(ss, 32);
        if (fq == 0) atomicAdd(sss + row, ss);
      }
      }
      const float dec = __expf(cs_end);
#pragma unroll
      for (int nt = 0; nt < 8; ++nt) {
        S[nt] *= dec;
#pragma unroll
        for (int k2 = 0; k2 < 2; ++k2) {
          const bf16x8 bt = *(const bf16x8*)(lds + L_BT + (nt * 16 + fr) * 144 + k2 * 64 + fq * 16);
          S[nt] = MFMA16(bt, xf[k2], S[nt]);
        }
      }
    }
  }
  if (c1 == SEQ / 64) {
    float* so = P.out + O_SSDP + ((size_t)(l * NB + b) * NH + h) * HD * SN;
#pragma unroll
    for (int nt = 0; nt < 8; ++nt) *(f32x4*)(so + (size_t)(pw + fr) * SN + nt * 16 + fq * 4) = S[nt];
  }
}

struct SampLd { f32x4 st[8]; u32x4 xcv; float dtv; float zt[4]; };
__device__ __forceinline__ void ssd_sample_load(const Params& P, int l, int task, int tid, SampLd& L) {
  const int b = task >> 5, h = task & 31, gi = h >> 2, row0 = MP + b * 4;
  const float* sin_ = P.st_ssd + ((size_t)(l * DB + b) * NH + h) * HD * SN;
#pragma unroll
  for (int j = 0; j < 8; ++j) L.st[j] = *(const f32x4*)(sin_ + (j * 256 + tid) * 4);
  L.xcv = (u32x4){0u, 0u, 0u, 0u}; L.dtv = 0.f;
  if (tid < 160) {
    const int t = tid / 40, q = tid % 40;
    const int ch = q < 8 ? h * 64 + q * 8 : q < 24 ? 2048 + gi * 128 + (q - 8) * 8 : 3072 + gi * 128 + (q - 24) * 8;
    L.xcv = *(const u32x4*)((const bf16_t*)(P.ws + WS_XC) + (size_t)(row0 + t) * CONVD + ch);
  }
  if (tid >= 192 && tid < 196) L.dtv = ((const float*)(P.ws + WS_DTV))[(size_t)(row0 + tid - 192) * 32 + h];
  const int p = tid >> 2;
#pragma unroll
  for (int t = 0; t < 4; ++t) L.zt[t] = bf1(((const bf16_t*)(P.ws + WS_PROJ))[(size_t)(row0 + t) * NPROJ + 8192 + h * 64 + p]);
}

__device__ __forceinline__ void ssd_sample_batch(const Params& P, int l, int batch, unsigned char* lds, int dummy) {
  const int tid = opaque_tid(), lane = tid & 63;
  bf16_t* act = (bf16_t*)(P.ws + WS_ACT);
  float* sss = (float*)(P.ws + WS_SS) + (dummy ? 8 : 5 + l) * MT;
  float* xs = (float*)(lds + 64);
  float* Bs = xs + 256;
  float* Cs = Bs + 512;
  float* dts = Cs + 512;
  float* St0 = dts + 16;
  const int p = tid >> 2, nq = tid & 3, n0 = nq * 32;
  SampLd L;
  ssd_sample_load(P, l, batch * 8, tid, L);
#pragma unroll 1
  for (int i = 0; i < 8; ++i) {
    const int task = batch * 8 + i, b = task >> 5, h = task & 31, row0 = MP + b * 4;
    float* St = St0 + (i & 1) * (64 * 132);
    const float a_h = -expf(P.a_log[l * NH + h]), dsk = P.ssd_d[l * NH + h];
#pragma unroll
    for (int j = 0; j < 8; ++j) { const int f = (j * 256 + tid) * 4; *(f32x4*)(St + (f >> 7) * 132 + (f & 127)) = L.st[j]; }
    if (tid < 160) {
      const int t = tid / 40, q = tid % 40;
      float* dst = q < 8 ? xs + t * 64 + q * 8 : q < 24 ? Bs + t * 128 + (q - 8) * 8 : Cs + t * 128 + (q - 24) * 8;
      const u32x4 v = L.xcv;
      *(f32x4*)dst = (f32x4){bflo(v.x), bfhi(v.x), bflo(v.y), bfhi(v.y)};
      *(f32x4*)(dst + 4) = (f32x4){bflo(v.z), bfhi(v.z), bflo(v.w), bfhi(v.w)};
    }
    if (tid >= 192 && tid < 196) dts[tid - 192] = L.dtv;
    float zt[4];
#pragma unroll
    for (int t = 0; t < 4; ++t) zt[t] = L.zt[t];
    __syncthreads();
    if (i + 1 < 8) ssd_sample_load(P, l, task + 1, tid, L);
    f32x4 hs[8];
#pragma unroll
    for (int j = 0; j < 8; ++j) hs[j] = *(const f32x4*)(St + p * 132 + n0 + j * 4);
#pragma unroll
    for (int t = 0; t < 4; ++t) {
      const float dtv = dts[t], dA = __expf(dtv * a_h), xv = xs[t * 64 + p], xdt = xv * dtv;
      float yp = 0.f;
#pragma unroll
      for (int j = 0; j < 8; ++j) {
        const f32x4 bv = *(const f32x4*)(Bs + t * 128 + n0 + j * 4);
        const f32x4 cv = *(const f32x4*)(Cs + t * 128 + n0 + j * 4);
        hs[j] = hs[j] * dA + bv * xdt;
        yp += hs[j].x * cv.x + hs[j].y * cv.y + hs[j].z * cv.z + hs[j].w * cv.w;
      }
      yp += __shfl_xor(yp, 1); yp += __shfl_xor(yp, 2);
      const int row = row0 + t;
      float v = 0.f;
      if (nq == 0) {
        v = (yp + dsk * xv) * siluf_(zt[t]);
        act[(size_t)row * 4096 + 2048 + h * 64 + p] = (bf16_t)(pk2(v, 0.f) & 0xffff);
      }
      const float ss = wave_sum(v * v);
      if (lane == 0) atomicAdd(sss + row, ss);
    }
#pragma unroll
    for (int j = 0; j < 8; ++j) *(f32x4*)(St + p * 132 + n0 + j * 4) = hs[j];
    __syncthreads();
    float* so = P.out + O_SSDS + ((size_t)(l * DB + b) * NH + h) * HD * SN;
#pragma unroll
    for (int j = 0; j < 8; ++j) { const int f = (j * 256 + tid) * 4; *(f32x4*)(so + f) = *(const f32x4*)(St + (f >> 7) * 132 + (f & 127)); }
  }
}

__device__ __forceinline__ void phase_mix(const Params& P, int l, unsigned char* lds, int dummy = 0) {
  int* counter = (int*)(P.ws + WS_CNT) + l + (dummy ? 8 : 0);
  int* slot = (int*)lds;
  constexpr int T0 = 256, T1 = T0 + 512, T2 = T1 + DB * NH / 8, T3 = T2 + NG;
  for (;;) {
    const int t = next_task(counter, slot);
    if (t >= T3) break;
    const int mask = dummy ? (P.probe >> 4) : 15;
    if (t < T0) { if (mask & 1) { const int q = t & 127; if (t < 128) ssd_prompt_task(P, l, q >> 5, q & 31, lds, dummy, 32, 16); else ssd_prompt_task(P, l, q >> 5, q & 31, lds, dummy, 16, 0); } }
    else if (t < T1) { const int q = t - T0; if (mask & 2) s5_block_task<false>(P, l, q & 127, q >> 7, lds); }
    else if (t < T2) { if (mask & 4) ssd_sample_batch(P, l, t - T1, lds, dummy); }
    else { if (mask & 8) s5_block_task<true>(P, l, t - T2, 0, lds); }
  }
}

__device__ __forceinline__ int* panel_flag(const Params& P, int l, int kind, int pm);
__device__ __forceinline__ void panel_wait(int* flag, int need);
__device__ __forceinline__ void phase_final(const Params& P, int gated) {
  const int tid = opaque_tid(), lane = tid & 63, wave = tid >> 6;
  const float* xres = (const float*)(P.ws + WS_XRES);
  const float* ssx = (const float*)(P.ws + WS_SS) + 2 * MT;
  for (int r4 = blockIdx.x; r4 < MT / 4; r4 += gridDim.x) {
    if (gated) panel_wait(panel_flag(P, 1, 1, (r4 * 4) >> 8), 16);
    const int row = r4 * 4 + wave;
    const float rs = rsqrtf(ssx[row] * (1.f / 2048.f) + EPS);
    float* dst = P.out + (size_t)row * DM;
#pragma unroll
    for (int j = 0; j < 8; ++j) {
      const f32x4 v = *(const f32x4*)(xres + (size_t)row * DM + (j * 64 + lane) * 4);
      const f32x4 w = *(const f32x4*)(P.final_w + (j * 64 + lane) * 4);
      *(f32x4*)(dst + (j * 64 + lane) * 4) = v * rs * w;
    }
  }
}

__global__ void __launch_bounds__(256, 2) hymba_fwd(Params P) {
  extern __shared__ __attribute__((aligned(16))) unsigned char lds[];
  cg::grid_group grid = cg::this_grid();
  for (int ph = P.ph_lo; ph < P.ph_hi; ++ph) {
    if (ph > P.ph_lo) grid.sync();
#ifndef TEST_PH
#define TEST_PH -1
#endif
    if (ph == 0) phase_prep(P, lds);
    else if (ph == 1) { phase_gemm<G_IN>(P, 0, lds, 4); deferred_weights(P, lds); phase_conv(P, 0, 1, lds); }
    else if (ph == 2 || ph == 4) phase_mix(P, ph == 2 ? 0 : 1, lds);
    else if (ph == 3) { phase_chain(P, 0, lds); phase_conv(P, 1, 1, lds); }
    else { phase_chain(P, 1, lds); phase_final(P, 1); }
  }
}

extern "C" void kernel_launch(void* const* d_in, const int* in_sizes, int n_in, void* d_out, int out_size, void* d_ws, size_t ws_size, hipStream_t stream) {
  static int grid_blocks = 0;
  if (!grid_blocks) {
    int dev = 0, cus = 0, per_cu = 0;
    hipGetDevice(&dev);
    hipDeviceGetAttribute(&cus, hipDeviceAttributeMultiprocessorCount, dev);
    hipFuncSetAttribute((const void*)hymba_fwd, hipFuncAttributeMaxDynamicSharedMemorySize, LDS_BYTES);
    hipOccupancyMaxActiveBlocksPerMultiprocessor(&per_cu, (const void*)hymba_fwd, 256, LDS_BYTES);
    if (per_cu > 2) per_cu = 2;
    if (per_cu < 1) per_cu = 1;
    grid_blocks = cus * per_cu;
    if (ws_size < WS_END) fprintf(stderr, "workspace too small: %zu < %zu\n", ws_size, (size_t)WS_END);
  }
  Params p{};
  const float** ip = (const float**)&p;
  for (int i = 0; i < 27; ++i) ip[i] = (const float*)d_in[i];
  p.out = (float*)d_out; p.ws = (unsigned char*)d_ws; p.ph_lo = 0; p.ph_hi = 6; p.probe = PROBE_BITS;
  void* args[] = {&p};
  hipError_t e = hipLaunchCooperativeKernel((const void*)hymba_fwd, dim3(grid_blocks), dim3(256), args, LDS_BYTES, stream);
  if (e != hipSuccess) fprintf(stderr, "cooperative launch failed: %s (grid %d)\n", hipGetErrorString(e), grid_blocks);
}
```
